# Optimizing an MI355X kernel written in HIP

```python
import jax, jax.numpy as jnp
from jax import lax
import numpy as np

D_MODEL = 1024
BATCH = 8
SEQ = 4096
DEPTH = 1

HEAD_DIM = 64
A_HEADS = D_MODEL // (2 * HEAD_DIM)
A_KV_HEADS = max(1, A_HEADS // 4)
A_WINDOW = 128
B_HEADS = D_MODEL // (2 * HEAD_DIM)
B_PATTERNS = ((128, 1), (512, 4), (2048, 16))
BLOCK = 128
ROPE_THETA = 10000.0
EPS = 1e-6
NEG = -1e30

A_WIDTH = A_HEADS * HEAD_DIM
A_KV_WIDTH = A_KV_HEADS * HEAD_DIM
B_WIDTH = B_HEADS * HEAD_DIM
MIX_WIDTH = A_WIDTH + B_WIDTH
IN_SPLITS = (A_WIDTH, A_KV_WIDTH, A_KV_WIDTH, A_WIDTH, B_WIDTH, B_WIDTH, B_WIDTH, B_WIDTH)
IN_WIDTH = sum(IN_SPLITS)

kernel_name = "hybrid_swa_sink_dilated_gated"


def rmsnorm(t, gain):
    tf = t.astype(jnp.float32)
    tf = tf * lax.rsqrt(jnp.mean(tf * tf, axis=-1, keepdims=True) + EPS)
    return (tf * gain.astype(jnp.float32)).astype(t.dtype)


def rope(t, pos):
    half = HEAD_DIM // 2
    inv = ROPE_THETA ** (-jnp.arange(half, dtype=jnp.float32) / half)
    ang = pos.astype(jnp.float32)[:, None] * inv[None, :]
    cos = jnp.cos(ang)[:, None, :]
    sin = jnp.sin(ang)[:, None, :]
    tf = t.astype(jnp.float32)
    t1, t2 = tf[..., :half], tf[..., half:]
    return jnp.concatenate([t1 * cos - t2 * sin, t2 * cos + t1 * sin], axis=-1).astype(t.dtype)


def banded_attention(q, k, v, max_dist, sinks=None):
    n, L, h, d = q.shape
    hkv = k.shape[2]
    g = h // hkv
    nb = -(-L // BLOCK)
    lp = nb * BLOCK
    pad = lp - L
    q = jnp.pad(q, ((0, 0), (0, pad), (0, 0), (0, 0)))
    k = jnp.pad(k, ((0, 0), (BLOCK, pad), (0, 0), (0, 0)))
    v = jnp.pad(v, ((0, 0), (BLOCK, pad), (0, 0), (0, 0)))
    qb = q.reshape(n, nb, BLOCK, hkv, g, d)
    kb = k.reshape(n, nb + 1, BLOCK, hkv, d)
    vb = v.reshape(n, nb + 1, BLOCK, hkv, d)
    kw = jnp.concatenate([kb[:, :-1], kb[:, 1:]], axis=2)
    vw = jnp.concatenate([vb[:, :-1], vb[:, 1:]], axis=2)
    s = jnp.einsum("nbqkgd,nbskd->nbkgqs", qb, kw,
                   preferred_element_type=jnp.float32) * (d ** -0.5)
    qi = jnp.arange(BLOCK)[:, None]
    sj = jnp.arange(2 * BLOCK)[None, :]
    dist = qi - sj + BLOCK
    key_pos = jnp.arange(nb)[:, None] * BLOCK - BLOCK + sj
    valid = ((dist >= 0) & (dist <= max_dist))[None] & (key_pos >= 0)[:, None, :]
    s = jnp.where(valid[None, :, None, None], s, NEG)
    m = s.max(axis=-1)
    if sinks is not None:
        sk = sinks.astype(jnp.float32).reshape(hkv, g)[None, None, :, :, None]
        m = jnp.maximum(m, sk)
    p = jnp.exp(s - m[..., None])
    l = p.sum(axis=-1)
    if sinks is not None:
        l = l + jnp.exp(sk - m)
    o = jnp.einsum("nbkgqs,nbskd->nbqkgd", p, vw.astype(jnp.float32))
    m = m.transpose(0, 1, 4, 2, 3)
    l = l.transpose(0, 1, 4, 2, 3)
    o = o / l[..., None]
    o = o.reshape(n, lp, h, d)[:, :L]
    m = m.reshape(n, lp, h)[:, :L]
    l = l.reshape(n, lp, h)[:, :L]
    return o, m, l


def dilated_attention(q, k, v):
    b, S, h, d = q.shape
    outs, ms, ls = [], [], []
    for window, dil in B_PATTERNS:
        L = S // dil

        def fold(t):
            return t.reshape(b, L, dil, h, d).transpose(0, 2, 1, 3, 4).reshape(b * dil, L, h, d)

        o, m, l = banded_attention(fold(q), fold(k), fold(v), window // dil)
        outs.append(o.reshape(b, dil, L, h, d).transpose(0, 2, 1, 3, 4).reshape(b, S, h, d))
        ms.append(m.reshape(b, dil, L, h).transpose(0, 2, 1, 3).reshape(b, S, h))
        ls.append(l.reshape(b, dil, L, h).transpose(0, 2, 1, 3).reshape(b, S, h))
    o = jnp.stack(outs)
    m = jnp.stack(ms)
    l = jnp.stack(ls)
    w = l * jnp.exp(m - m.max(axis=0, keepdims=True))
    return (w[..., None] * o).sum(axis=0) / w.sum(axis=0)[..., None]


def setup_inputs(seed: int = 0) -> dict:
    key = jax.random.key(seed)
    ks = jax.random.split(key, 10)
    f32 = jnp.float32
    x = jax.random.normal(ks[0], (BATCH, SEQ, D_MODEL), f32)
    norm_gain = 1.0 + 0.1 * jax.random.normal(ks[1], (DEPTH, D_MODEL), f32)
    w_in = jax.random.normal(ks[2], (DEPTH, D_MODEL, IN_WIDTH), f32) * D_MODEL ** -0.5
    q_norm_a = 1.0 + 0.1 * jax.random.normal(ks[3], (DEPTH, HEAD_DIM), f32)
    k_norm_a = 1.0 + 0.1 * jax.random.normal(ks[4], (DEPTH, HEAD_DIM), f32)
    sinks_a = 0.5 * jax.random.normal(ks[5], (DEPTH, A_HEADS), f32)
    q_norm_b = 1.0 + 0.1 * jax.random.normal(ks[6], (DEPTH, HEAD_DIM), f32)
    k_norm_b = 1.0 + 0.1 * jax.random.normal(ks[7], (DEPTH, HEAD_DIM), f32)
    w_out = jax.random.normal(ks[8], (DEPTH, MIX_WIDTH, D_MODEL), f32) * MIX_WIDTH ** -0.5
    return {"x": x, "norm_gain": norm_gain, "w_in": w_in,
            "q_norm_a": q_norm_a, "k_norm_a": k_norm_a, "sinks_a": sinks_a,
            "q_norm_b": q_norm_b, "k_norm_b": k_norm_b, "w_out": w_out}


def reference(x, norm_gain, w_in, q_norm_a, k_norm_a, sinks_a, q_norm_b, k_norm_b, w_out):
    b, S, _ = x.shape
    pos = jnp.arange(S)
    split_at = [int(c) for c in np.cumsum(IN_SPLITS)[:-1]]
    for i in range(DEPTH):
        hdn = rmsnorm(x, norm_gain[i])
        proj = jnp.einsum("bsd,de->bse", hdn, w_in[i])
        q_a, k_a, v_a, g_a, q_b, k_b, v_b, g_b = jnp.split(proj, split_at, axis=-1)

        q_a = rope(rmsnorm(q_a.reshape(b, S, A_HEADS, HEAD_DIM), q_norm_a[i]), pos)
        k_a = rope(rmsnorm(k_a.reshape(b, S, A_KV_HEADS, HEAD_DIM), k_norm_a[i]), pos)
        v_a = v_a.reshape(b, S, A_KV_HEADS, HEAD_DIM)
        o_a, _, _ = banded_attention(q_a, k_a, v_a, A_WINDOW - 1, sinks=sinks_a[i])
        o_a = o_a.reshape(b, S, A_WIDTH).astype(x.dtype) * jax.nn.silu(g_a)

        q_b = rope(rmsnorm(q_b.reshape(b, S, B_HEADS, HEAD_DIM), q_norm_b[i]), pos)
        k_b = rope(rmsnorm(k_b.reshape(b, S, B_HEADS, HEAD_DIM), k_norm_b[i]), pos)
        v_b = v_b.reshape(b, S, B_HEADS, HEAD_DIM)
        o_b = dilated_attention(q_b, k_b, v_b)
        o_b = o_b.reshape(b, S, B_WIDTH).astype(x.dtype) * jax.nn.silu(g_b)

        mixed = jnp.concatenate([o_a, o_b], axis=-1)
        x = x + jnp.einsum("bse,ed->bsd", mixed, w_out[i])
    return x
```

```cpp
#include <hip/hip_runtime.h>
#include <cstdint>
#include <cstdio>

constexpr int BATCH = 8, SEQ = 4096, DM = 1024, M = BATCH * SEQ, NIN = 3328, HD = 64;
constexpr float C2 = 0.18033688011112042f;
constexpr float LOG2E = 1.4426950408889634f;
typedef unsigned short bf16_t;

constexpr size_t MiB = 1u << 20;
constexpr size_t WS_COS = 1 * MiB, WS_SIN = WS_COS + 512 * 1024;
constexpr size_t WS_XN = 16 * MiB;
constexpr size_t WS_QA = 80 * MiB, WS_QB = 112 * MiB, WS_KA = 144 * MiB, WS_VA = 152 * MiB, WS_KB = 160 * MiB, WS_VB = 192 * MiB;
constexpr size_t WS_GA = 224 * MiB, WS_GB = 256 * MiB, WS_MIX = 288 * MiB;

__device__ __forceinline__ bf16_t f2bf(float f) { unsigned u = __float_as_uint(f); u = (u + 0x7fffu + ((u >> 16) & 1u)) >> 16; return (bf16_t)u; }
__device__ __forceinline__ float bf2f(bf16_t b) { return __uint_as_float(((unsigned)b) << 16); }

__device__ __forceinline__ void sincos_d(float ang, float& s, float& c) {
    const double a = (double)ang;
    const double k = rint(a * 0.6366197723675814);
    double y = fma(-k, 1.5707963267948966, a);
    y = fma(-k, 6.123233995736766e-17, y);
    const double y2 = y * y;
    const double sp = y * (1.0 + y2 * (-1.0 / 6 + y2 * (1.0 / 120 + y2 * (-1.0 / 5040 + y2 * (1.0 / 362880 + y2 * (-1.0 / 39916800 + y2 * (1.0 / 6227020800.0)))))));
    const double cp = 1.0 + y2 * (-0.5 + y2 * (1.0 / 24 + y2 * (-1.0 / 720 + y2 * (1.0 / 40320 + y2 * (-1.0 / 3628800 + y2 * (1.0 / 479001600.0 + y2 * (-1.0 / 87178291200.0)))))));
    const int q = ((int)(long long)k) & 3;
    const double ss = (q == 0) ? sp : (q == 1) ? cp : (q == 2) ? -sp : -cp;
    const double cc = (q == 0) ? cp : (q == 1) ? -sp : (q == 2) ? -cp : sp;
    s = (float)ss; c = (float)cc;
}

__global__ void __launch_bounds__(256) n_s0(const float* __restrict__ x, const float* __restrict__ gain, bf16_t* __restrict__ XN, float* __restrict__ cosT, float* __restrict__ sinT) {
    const int gw = (blockIdx.x * 256 + threadIdx.x) >> 6, lane = threadIdx.x & 63, NGW = (gridDim.x * 256) >> 6;
    for (int e = blockIdx.x * 256 + threadIdx.x; e < SEQ * 32; e += gridDim.x * 256) {
        const int t = e >> 5, i = e & 31;
        double r = 1.0; for (int k = 0; k < i; ++k) r *= 0.7498942093324558;
        const float inv = (float)r; const float ang = (float)t * inv;
        float s, c; sincos_d(ang, s, c); cosT[e] = c; sinT[e] = s;
    }
    for (int m = gw; m < M; m += NGW) {
        const float4* xr = (const float4*)(x + (size_t)m * DM) + lane;
        float4 v[4]; float ss = 0.f;
#pragma unroll
        for (int j = 0; j < 4; ++j) { v[j] = xr[64 * j]; ss += v[j].x * v[j].x + v[j].y * v[j].y + v[j].z * v[j].z + v[j].w * v[j].w; }
#pragma unroll
        for (int o = 1; o < 64; o <<= 1) ss += __shfl_xor(ss, o);
        const float rstd = rsqrtf(ss * (1.f / DM) + 1e-6f);
#pragma unroll
        for (int j = 0; j < 4; ++j) {
            const float4 g = ((const float4*)gain)[64 * j + lane];
            ushort4 o; o.x = f2bf(v[j].x * rstd * g.x); o.y = f2bf(v[j].y * rstd * g.y); o.z = f2bf(v[j].z * rstd * g.z); o.w = f2bf(v[j].w * rstd * g.w);
            ((ushort4*)(XN + (size_t)m * DM))[64 * j + lane] = o;
        }
    }
}

struct S1Out { bf16_t *QA, *KA, *VA, *GA, *QB, *KB, *VB, *GB; };
__global__ void __launch_bounds__(256) n_s1(const bf16_t* __restrict__ XN, const float* __restrict__ W, const float* __restrict__ qna, const float* __restrict__ kna,
                                            const float* __restrict__ qnb, const float* __restrict__ knb, const float* __restrict__ cosT, const float* __restrict__ sinT, S1Out O) {
    __shared__ float As[16][68]; __shared__ float Bs[16][68]; __shared__ float Cs[64][65];
    const int g = blockIdx.x, rb = blockIdx.y, tid = threadIdx.x, ty = tid >> 4, tx = tid & 15;
    float acc[4][4] = {};
    for (int k0 = 0; k0 < DM; k0 += 16) {
        { const int r = tid >> 2, kq = (tid & 3) * 4; const ushort4 a = *(const ushort4*)(XN + (size_t)(rb * 64 + r) * DM + k0 + kq);
          As[kq + 0][r] = bf2f(a.x); As[kq + 1][r] = bf2f(a.y); As[kq + 2][r] = bf2f(a.z); As[kq + 3][r] = bf2f(a.w); }
        { const int kk = tid >> 4, c4 = (tid & 15) * 4; const float4 b = *(const float4*)(W + (size_t)(k0 + kk) * NIN + g * 64 + c4);
          Bs[kk][c4] = bf2f(f2bf(b.x)); Bs[kk][c4 + 1] = bf2f(f2bf(b.y)); Bs[kk][c4 + 2] = bf2f(f2bf(b.z)); Bs[kk][c4 + 3] = bf2f(f2bf(b.w)); }
        __syncthreads();
#pragma unroll
        for (int kk = 0; kk < 16; ++kk) {
            float a[4], b[4];
#pragma unroll
            for (int i = 0; i < 4; ++i) { a[i] = As[kk][ty * 4 + i]; b[i] = Bs[kk][tx * 4 + i]; }
#pragma unroll
            for (int i = 0; i < 4; ++i)
#pragma unroll
                for (int j = 0; j < 4; ++j) acc[i][j] += a[i] * b[j];
        }
        __syncthreads();
    }
#pragma unroll
    for (int i = 0; i < 4; ++i)
#pragma unroll
        for (int j = 0; j < 4; ++j) Cs[ty * 4 + i][tx * 4 + j] = acc[i][j];
    __syncthreads();
    const int r = tid >> 2, c0 = (tid & 3) * 16, m = rb * 64 + r, b = m / SEQ, t = m % SEQ;
    int type, head; const float* ng = nullptr; bf16_t* dst; int H = 8; float scale = 1.f;
    if (g < 8) { type = 0; head = g; ng = qna; dst = O.QA; scale = C2; }
    else if (g < 10) { type = 0; head = g - 8; ng = kna; dst = O.KA; H = 2; }
    else if (g < 12) { type = 1; head = g - 10; dst = O.VA; H = 2; }
    else if (g < 20) { type = 2; head = g - 12; dst = O.GA; }
    else if (g < 28) { type = 0; head = g - 20; ng = qnb; dst = O.QB; scale = C2; }
    else if (g < 36) { type = 0; head = g - 28; ng = knb; dst = O.KB; }
    else if (g < 44) { type = 1; head = g - 36; dst = O.VB; }
    else { type = 2; head = g - 44; dst = O.GB; }
    if (type == 0) {
        float ss = 0.f;
        for (int c = 0; c < 64; ++c) ss += Cs[r][c] * Cs[r][c];
        const float rs = rsqrtf(ss * (1.f / 64.f) + 1e-6f);
        for (int j = 0; j < 16; ++j) {
            const int c = c0 + j, i = c & 31;
            const float n1 = Cs[r][i] * rs * ng[i], n2 = Cs[r][i + 32] * rs * ng[i + 32];
            const float cs = cosT[t * 32 + i], sn = sinT[t * 32 + i];
            const float o = (c < 32) ? (n1 * cs - n2 * sn) : (n2 * cs + n1 * sn);
            dst[((size_t)(b * H + head) * SEQ + t) * 64 + c] = f2bf(o * scale);
        }
    } else if (type == 1) {
        for (int j = 0; j < 16; ++j) { const int c = c0 + j; dst[((size_t)(b * H + head) * SEQ + t) * 64 + c] = f2bf(Cs[r][c]); }
    } else {
        for (int j = 0; j < 16; ++j) { const int c = c0 + j; const float v = Cs[r][c]; const float sg = v / (1.f + exp2f(-v * LOG2E)); dst[(size_t)m * 512 + head * 64 + c] = f2bf(sg); }
    }
}

__global__ void __launch_bounds__(256) n_s2(S1Out I, const float* __restrict__ sinks, bf16_t* __restrict__ MIX) {
    const int w = (blockIdx.x * 256 + threadIdx.x) >> 6, lane = threadIdx.x & 63;
    const int m = w >> 4, hs = w & 15, b = m / SEQ, t = m % SEQ;
    if (m >= M) return;
    if (hs < 8) {
        const int h = hs, kv = h >> 2;
        const float q = bf2f(I.QA[((size_t)(b * 8 + h) * SEQ + t) * 64 + lane]);
        const bf16_t* K = I.KA + (size_t)(b * 2 + kv) * SEQ * 64; const bf16_t* V = I.VA + (size_t)(b * 2 + kv) * SEQ * 64;
        float l = 0.f, o = 0.f;
        for (int j = 0; j < 128; ++j) { const int tk = t - j; if (tk < 0) break;
            float s = q * bf2f(K[(size_t)tk * 64 + lane]);
#pragma unroll
            for (int x = 1; x < 64; x <<= 1) s += __shfl_xor(s, x);
            const float p = exp2f(s); l += p; o += p * bf2f(V[(size_t)tk * 64 + lane]); }
        l += exp2f(sinks[h] * LOG2E);
        const float g = bf2f(I.GA[(size_t)m * 512 + h * 64 + lane]);
        MIX[(size_t)m * DM + h * 64 + lane] = f2bf(o / l * g);
    } else {
        const int h = hs - 8;
        const float q = bf2f(I.QB[((size_t)(b * 8 + h) * SEQ + t) * 64 + lane]);
        const bf16_t* K = I.KB + (size_t)(b * 8 + h) * SEQ * 64; const bf16_t* V = I.VB + (size_t)(b * 8 + h) * SEQ * 64;
        float l = 0.f, o = 0.f;
        for (int p3 = 0; p3 < 3; ++p3) { const int dil = (p3 == 0) ? 1 : (p3 == 1) ? 4 : 16;
            for (int j = 0; j <= 128; ++j) { const int tk = t - j * dil; if (tk < 0) break;
                float s = q * bf2f(K[(size_t)tk * 64 + lane]);
#pragma unroll
                for (int x = 1; x < 64; x <<= 1) s += __shfl_xor(s, x);
                const float p = exp2f(s); l += p; o += p * bf2f(V[(size_t)tk * 64 + lane]); } }
        const float g = bf2f(I.GB[(size_t)m * 512 + h * 64 + lane]);
        MIX[(size_t)m * DM + 512 + h * 64 + lane] = f2bf(o / l * g);
    }
}

__global__ void __launch_bounds__(256) n_s3(const bf16_t* __restrict__ MIX, const float* __restrict__ W, const float* __restrict__ x, float* __restrict__ out) {
    __shared__ float As[16][68]; __shared__ float Bs[16][68];
    const int g = blockIdx.x, rb = blockIdx.y, tid = threadIdx.x, ty = tid >> 4, tx = tid & 15;
    float acc[4][4] = {};
    for (int k0 = 0; k0 < DM; k0 += 16) {
        { const int r = tid >> 2, kq = (tid & 3) * 4; const ushort4 a = *(const ushort4*)(MIX + (size_t)(rb * 64 + r) * DM + k0 + kq);
          As[kq + 0][r] = bf2f(a.x); As[kq + 1][r] = bf2f(a.y); As[kq + 2][r] = bf2f(a.z); As[kq + 3][r] = bf2f(a.w); }
        { const int kk = tid >> 4, c4 = (tid & 15) * 4; const float4 b = *(const float4*)(W + (size_t)(k0 + kk) * DM + g * 64 + c4);
          Bs[kk][c4] = bf2f(f2bf(b.x)); Bs[kk][c4 + 1] = bf2f(f2bf(b.y)); Bs[kk][c4 + 2] = bf2f(f2bf(b.z)); Bs[kk][c4 + 3] = bf2f(f2bf(b.w)); }
        __syncthreads();
#pragma unroll
        for (int kk = 0; kk < 16; ++kk) {
            float a[4], b[4];
#pragma unroll
            for (int i = 0; i < 4; ++i) { a[i] = As[kk][ty * 4 + i]; b[i] = Bs[kk][tx * 4 + i]; }
#pragma unroll
            for (int i = 0; i < 4; ++i)
#pragma unroll
                for (int j = 0; j < 4; ++j) acc[i][j] += a[i] * b[j];
        }
        __syncthreads();
    }
#pragma unroll
    for (int i = 0; i < 4; ++i) {
        const size_t off = (size_t)(rb * 64 + ty * 4 + i) * DM + g * 64 + tx * 4;
        const float4 xv = *(const float4*)(x + off);
        float4 o; o.x = xv.x + acc[i][0]; o.y = xv.y + acc[i][1]; o.z = xv.z + acc[i][2]; o.w = xv.w + acc[i][3];
        *(float4*)(out + off) = o;
    }
}

extern "C" void kernel_launch(void* const* d_in, const int* in_sizes, int n_in, void* d_out, int out_size, void* d_ws, size_t ws_size, hipStream_t stream) {
    const float* x = (const float*)d_in[0]; const float* gain = (const float*)d_in[1]; const float* w_in = (const float*)d_in[2];
    const float* qna = (const float*)d_in[3]; const float* kna = (const float*)d_in[4]; const float* sinks = (const float*)d_in[5];
    const float* qnb = (const float*)d_in[6]; const float* knb = (const float*)d_in[7]; const float* w_out = (const float*)d_in[8];
    unsigned char* ws = (unsigned char*)d_ws;
    float* cosT = (float*)(ws + WS_COS); float* sinT = (float*)(ws + WS_SIN);
    bf16_t* XN = (bf16_t*)(ws + WS_XN);
    S1Out O{(bf16_t*)(ws + WS_QA), (bf16_t*)(ws + WS_KA), (bf16_t*)(ws + WS_VA), (bf16_t*)(ws + WS_GA), (bf16_t*)(ws + WS_QB), (bf16_t*)(ws + WS_KB), (bf16_t*)(ws + WS_VB), (bf16_t*)(ws + WS_GB)};
    bf16_t* MIX = (bf16_t*)(ws + WS_MIX);
    hipLaunchKernelGGL(n_s0, dim3(2048), dim3(256), 0, stream, x, gain, XN, cosT, sinT);
    hipLaunchKernelGGL(n_s1, dim3(NIN / 64, M / 64), dim3(256), 0, stream, XN, w_in, qna, kna, qnb, knb, cosT, sinT, O);
    hipLaunchKernelGGL(n_s2, dim3(M * 16 / 4), dim3(256), 0, stream, O, sinks, MIX);
    hipLaunchKernelGGL(n_s3, dim3(DM / 64, M / 64), dim3(256), 0, stream, MIX, w_out, x, (float*)d_out);
}
```

```cpp
#include <hip/hip_runtime.h>
#include <cstdio>
#include <cstdint>
namespace pg8 {
#define PG8_LAS __attribute__((address_space(3)))
typedef unsigned short bf16_t;
typedef short bf16x8 __attribute__((ext_vector_type(8)));
typedef float f32x4 __attribute__((ext_vector_type(4)));
typedef unsigned u32x4 __attribute__((ext_vector_type(4)));
constexpr int BM = 256, BK = 64, HALF = 128, HTB = HALF * BK * 2  , STAGE_BYTES = 8 * HTB, NXCD = 8, WGM = 8;

__host__ __device__ __forceinline__ int lds_byte(int r, int c) { const int st = (r >> 4) * 2 + (c >> 5), rr = r & 15, cc = c & 31, ob = rr * 64 + cc * 2; return st * 1024 + (ob ^ (((ob >> 9) & 1) << 5)); }
__host__ __device__ __forceinline__ void stage_rc(int b, int& R, int& C) { const int st = b / 1024, sb = b % 1024, swz = sb ^ (((sb >> 9) & 1) << 5); R = (st >> 1) * 16 + swz / 64; C = (st & 1) * 32 + (swz % 64) / 2; }
__host__ __device__ __forceinline__ int perm32(int rho) { const int n = rho >> 4, i = rho & 15; return 8 * (i >> 2) + 4 * n + (i & 3); }

struct Unit { int pm, pn; };
struct Gemm { const bf16_t* A; const bf16_t* Bt; int M, N, K; };

struct StaticOrder {
    int nM, nN, nwg, G, c;
    __host__ __device__ void init(int M, int N, int G_, int c_) { nM = M / BM; nN = N / BM; nwg = nM * nN; G = G_; c = c_; }
    __host__ __device__ bool next(int i, Unit& u) const {
        const long L = (long)i * G + c; if (L >= nwg) return false;
        int wgid = (int)L; { const int q = nwg / NXCD, r = nwg % NXCD, xcd = wgid % NXCD, off = wgid / NXCD; wgid = (xcd < r ? xcd * (q + 1) : r * (q + 1) + (xcd - r) * q) + off; }
        const int nig = WGM * nN, gid = wgid / nig, fm = gid * WGM, gsz = (nM - fm) < WGM ? (nM - fm) : WGM;
        u.pm = fm + ((wgid % nig) % gsz); u.pn = (wgid % nig) / gsz; return true;
    }
    __device__ __forceinline__ void a_ready(const Unit&) const {}
    __device__ __forceinline__ void done(const Unit&) const {}
};

__device__ __forceinline__ unsigned cvt_pk_bf16(float lo, float hi) { unsigned r; asm volatile("v_cvt_pk_bf16_f32 %0, %1, %2" : "=v"(r) : "v"(lo), "v"(hi)); return r; }
typedef float f32x2 __attribute__((ext_vector_type(2)));
typedef float f32x2 __attribute__((ext_vector_type(2)));
constexpr int SEQ_ = 4096;
constexpr float C2_ = 0.18033688011112042f, LOG2E_ = 1.4426950408889634f;
__device__ __forceinline__ u32x4 pack8(const f32x4& a, const f32x4& b) { u32x4 w; w.x = cvt_pk_bf16(a[0], a[1]); w.y = cvt_pk_bf16(a[2], a[3]); w.z = cvt_pk_bf16(b[0], b[1]); w.w = cvt_pk_bf16(b[2], b[3]); return w; }
struct EpiIn {
    static constexpr bool PERM = true, AFTER_DRAIN = false;
    bf16_t *QA, *KA, *VA, *GA, *QB, *KB, *VB, *GB;
    const float *qna, *kna, *qnb, *knb, *cosT, *sinT;
    __device__ __forceinline__ void operator()(const f32x4 (&acc)[2][2][4][2], const Unit& u, int wr, int wc, int fr, int fq) const {
        const int g = u.pn * 4 + wc;
        int type, head, H = 8; const float* ng = qna; bf16_t* dst; float scale = 1.f;
        if (g < 8) { type = 0; head = g; ng = qna; dst = QA; scale = C2_; }
        else if (g < 10) { type = 0; head = g - 8; ng = kna; dst = KA; H = 2; }
        else if (g < 12) { type = 1; head = g - 10; dst = VA; H = 2; }
        else if (g < 20) { type = 2; head = g - 12; dst = GA; }
        else if (g < 28) { type = 0; head = g - 20; ng = qnb; dst = QB; scale = C2_; }
        else if (g < 36) { type = 0; head = g - 28; ng = knb; dst = KB; }
        else if (g < 44) { type = 1; head = g - 36; dst = VB; }
        else { type = 2; head = g - 44; dst = GB; }
        const int row0 = u.pm * BM + wr * 64 + fr;
        if (type == 0) {
            f32x4 gv[2][2];
#pragma unroll
            for (int bj = 0; bj < 2; ++bj)
#pragma unroll
                for (int n = 0; n < 2; ++n) gv[bj][n] = *(const f32x4*)(ng + 32 * bj + 8 * fq + 4 * n);
#pragma unroll
            for (int ai = 0; ai < 2; ++ai)
#pragma unroll
                for (int m = 0; m < 4; ++m) {
                    const int row = row0 + ai * HALF + m * 16, b = row >> 12, t = row & (SEQ_ - 1);
                    float ss = 0.f;
#pragma unroll
                    for (int bj = 0; bj < 2; ++bj)
#pragma unroll
                        for (int n = 0; n < 2; ++n) { const f32x4 x = acc[ai][bj][m][n]; ss += (x[0] * x[0] + x[1] * x[1]) + (x[2] * x[2] + x[3] * x[3]); }
                    ss += __shfl_xor(ss, 16); ss += __shfl_xor(ss, 32);
                    const float rs = rsqrtf(ss * (1.f / 64.f) + 1e-6f);
                    f32x4 o1[2], o2[2];
#pragma unroll
                    for (int n = 0; n < 2; ++n) {
                        const f32x4 cs = *(const f32x4*)(cosT + t * 32 + 8 * fq + 4 * n), sn = *(const f32x4*)(sinT + t * 32 + 8 * fq + 4 * n);
                        const f32x4 n1 = acc[ai][0][m][n] * rs * gv[0][n], n2 = acc[ai][1][m][n] * rs * gv[1][n];
                        o1[n] = (n1 * cs - n2 * sn) * scale; o2[n] = (n2 * cs + n1 * sn) * scale;
                    }
                    bf16_t* p = dst + ((size_t)(b * H + head) * SEQ_ + t) * 64 + 8 * fq;
                    *(u32x4*)p = pack8(o1[0], o1[1]); *(u32x4*)(p + 32) = pack8(o2[0], o2[1]);
                }
        } else if (type == 1) {
#pragma unroll
            for (int ai = 0; ai < 2; ++ai)
#pragma unroll
                for (int m = 0; m < 4; ++m) {
                    const int row = row0 + ai * HALF + m * 16, b = row >> 12, t = row & (SEQ_ - 1);
                    bf16_t* p = dst + ((size_t)(b * H + head) * SEQ_ + t) * 64 + 8 * fq;
                    *(u32x4*)p = pack8(acc[ai][0][m][0], acc[ai][0][m][1]); *(u32x4*)(p + 32) = pack8(acc[ai][1][m][0], acc[ai][1][m][1]);
                }
        } else {
#pragma unroll
            for (int ai = 0; ai < 2; ++ai)
#pragma unroll
                for (int m = 0; m < 4; ++m) {
                    const int row = row0 + ai * HALF + m * 16;
                    bf16_t* p = dst + (size_t)row * 512 + head * 64 + 8 * fq;
#pragma unroll
                    for (int bj = 0; bj < 2; ++bj) {
                        f32x4 s[2];
#pragma unroll
                        for (int n = 0; n < 2; ++n) { const f32x4 v = acc[ai][bj][m][n];
#pragma unroll
                            for (int e = 0; e < 4; ++e) s[n][e] = v[e] * __builtin_amdgcn_rcpf(1.f + __builtin_amdgcn_exp2f(-v[e] * LOG2E_)); }
                        *(u32x4*)(p + 32 * bj) = pack8(s[0], s[1]);
                    }
                }
        }
    }
};
struct EpiRes {
    static constexpr bool PERM = true, AFTER_DRAIN = false;
    const float* x; float* out;
    __device__ __forceinline__ void operator()(const f32x4 (&acc)[2][2][4][2], const Unit& u, int wr, int wc, int fr, int fq) const {
        const int row0 = u.pm * BM + wr * 64 + fr, col0 = u.pn * BM + wc * 32 + 8 * fq;
#pragma unroll
        for (int ai = 0; ai < 2; ++ai)
#pragma unroll
            for (int m = 0; m < 4; ++m) {
                const size_t off = (size_t)(row0 + ai * HALF + m * 16) * 1024 + col0;
#pragma unroll
                for (int bj = 0; bj < 2; ++bj) {
                    const f32x4 a = *(const f32x4*)(x + off + bj * HALF), b = *(const f32x4*)(x + off + bj * HALF + 4);
                    *(f32x4*)(out + off + bj * HALF) = a + acc[ai][bj][m][0]; *(f32x4*)(out + off + bj * HALF + 4) = b + acc[ai][bj][m][1];
                }
            }
    }
};
template <class Epi, class Sched, bool ALIGN_EPI = false, bool SP2 = false>
__device__ __forceinline__ void gemm_phase(PG8_LAS unsigned char* lds, const Gemm g, const Sched& S, const Epi& E) {
    const int tid = threadIdx.x, wid = __builtin_amdgcn_readfirstlane(tid >> 6), lane = tid & 63, wr = wid >> 2, wc = wid & 3, fr = lane & 15, fq = lane >> 4;
    const int K = g.K, nt = K / BK;
    unsigned voffA[2], voffB[2];
#pragma unroll
    for (int i = 0; i < 2; ++i) { int R, C; stage_rc(tid * 16 + i * 8192, R, C); const int Rb = Epi::PERM ? ((R & ~31) + perm32(R & 31)) : R;
        voffA[i] = (unsigned)(R * K + C) * 2u; voffB[i] = (unsigned)(Rb * K + C) * 2u; }
    const size_t kstep = (size_t)(BK * 2);
    const size_t hstep = (size_t)HALF * K * 2;
    const size_t tstep = 2 * hstep;
    const unsigned ldsw = (unsigned)wid * 1024u;
    const int aoff = lds_byte(wr * 64 + fr, fq * 8), boff = lds_byte(wc * 32 + fr, fq * 8);
#define PG8_SA(b, h) (((b) * 2 + (h)) * HTB)
#define PG8_SB(b, h) ((4 + (b) * 2 + (h)) * HTB)
#define PG8_STAGE(bufoff, gbase, voff) do { _Pragma("unroll") for (int _i = 0; _i < 2; ++_i) \
        __builtin_amdgcn_global_load_lds((const unsigned*)((const char*)(gbase) + (voff)[_i]), (PG8_LAS unsigned*)(lds + (bufoff) + ldsw + _i * 8192), 16, 0, 0); } while (0)
#define PG8_LDA(dst, b, h) do { _Pragma("unroll") for (int m = 0; m < 4; ++m) _Pragma("unroll") for (int k = 0; k < 2; ++k) dst[m][k] = *(const PG8_LAS bf16x8*)(lds + PG8_SA(b, h) + aoff + m * 2048 + k * 1024); } while (0)
#define PG8_LDB(dst, b, h) do { _Pragma("unroll") for (int n = 0; n < 2; ++n) _Pragma("unroll") for (int k = 0; k < 2; ++k) dst[n][k] = *(const PG8_LAS bf16x8*)(lds + PG8_SB(b, h) + boff + n * 2048 + k * 1024); } while (0)
#define PG8_MMA(ai, bj, At, Bt) do { __builtin_amdgcn_s_setprio(1); _Pragma("unroll") for (int m = 0; m < 4; ++m) _Pragma("unroll") for (int n = 0; n < 2; ++n) _Pragma("unroll") for (int k = 0; k < 2; ++k) \
        acc[ai][bj][m][n] = __builtin_amdgcn_mfma_f32_16x16x32_bf16(Bt[n][k], At[m][k], acc[ai][bj][m][n], 0, 0, 0); __builtin_amdgcn_s_setprio(0); } while (0)
#define PG8_WAIT_V(n) asm volatile("s_waitcnt vmcnt(" #n ")" ::: "memory")
#define PG8_WAIT_L(n) asm volatile("s_waitcnt lgkmcnt(" #n ")" ::: "memory")
#define PG8_BAR __builtin_amdgcn_s_barrier()
#define PG8_SCHED __builtin_amdgcn_sched_barrier(0)
    Unit cur, nxt; int ui = 0;
    if (!S.next(0, cur)) return;
    f32x4 acc[2][2][4][2];
#pragma unroll
    for (int a = 0; a < 2; ++a)
#pragma unroll
        for (int b = 0; b < 2; ++b)
#pragma unroll
            for (int m = 0; m < 4; ++m)
#pragma unroll
                for (int n = 0; n < 2; ++n) acc[a][b][m][n] = (f32x4){0.f, 0.f, 0.f, 0.f};
    bf16x8 At[4][2], B0[2][2], B1[2][2];
    const char* cA = (const char*)g.A + (size_t)cur.pm * tstep; const char* cB = (const char*)g.Bt + (size_t)cur.pn * tstep;
    S.a_ready(cur);
    if constexpr (SP2) {
        PG8_STAGE(PG8_SB(0, 0), cB, voffB); PG8_STAGE(PG8_SB(0, 1), cB + hstep, voffB); PG8_STAGE(PG8_SA(0, 0), cA, voffA); PG8_STAGE(PG8_SA(0, 1), cA + hstep, voffA);
        if (wr == 1) PG8_BAR;
        PG8_WAIT_V(2); PG8_BAR;
        PG8_STAGE(PG8_SB(1, 0), cB + kstep, voffB); PG8_STAGE(PG8_SA(1, 0), cA + kstep, voffA); PG8_STAGE(PG8_SB(1, 1), cB + hstep + kstep, voffB);
        PG8_WAIT_V(6); PG8_BAR;
    } else {
        PG8_STAGE(PG8_SB(0, 0), cB, voffB); PG8_STAGE(PG8_SA(0, 0), cA, voffA); PG8_STAGE(PG8_SB(0, 1), cB + hstep, voffB); PG8_STAGE(PG8_SA(0, 1), cA + hstep, voffA);
        if (wr == 1) PG8_BAR;
        PG8_WAIT_V(4); PG8_BAR;
        PG8_STAGE(PG8_SB(1, 0), cB + kstep, voffB); PG8_STAGE(PG8_SA(1, 0), cA + kstep, voffA); PG8_STAGE(PG8_SB(1, 1), cB + hstep + kstep, voffB);
        PG8_WAIT_V(6); PG8_BAR;
    }
    for (;;) {
        const bool has_next = S.next(ui + 1, nxt);
        const char* nA = has_next ? (const char*)g.A + (size_t)nxt.pm * tstep : cA; const char* nB = has_next ? (const char*)g.Bt + (size_t)nxt.pn * tstep : cB;
        for (int t = 0; t < nt; t += 2) {
            const bool last = (t == nt - 2);
            const char* a1 = cA + (size_t)(t + 1) * kstep;
            const char* a2 = last ? nA : cA + (size_t)(t + 2) * kstep; const char* b2 = last ? nB : cB + (size_t)(t + 2) * kstep;
            const char* a3 = a2 + kstep; const char* b3 = b2 + kstep;
            if (last && has_next) S.a_ready(nxt);
            if constexpr (SP2) {
            PG8_LDB(B0, 0, 0); PG8_LDB(B1, 0, 1); PG8_SCHED; PG8_LDA(At, 0, 0); PG8_STAGE(PG8_SA(1, 1), a1 + hstep, voffA);
            PG8_WAIT_V(8); PG8_WAIT_L(0); PG8_BAR; PG8_MMA(0, 0, At, B0); PG8_MMA(0, 1, At, B1); PG8_BAR; PG8_SCHED;
            PG8_LDA(At, 0, 1); PG8_STAGE(PG8_SB(0, 0), b2, voffB); PG8_STAGE(PG8_SB(0, 1), b2 + hstep, voffB); PG8_STAGE(PG8_SA(0, 0), a2, voffA);
            PG8_WAIT_V(8); PG8_WAIT_L(0); PG8_BAR; PG8_MMA(1, 0, At, B0); PG8_MMA(1, 1, At, B1); PG8_BAR; PG8_SCHED;
            PG8_LDB(B0, 1, 0); PG8_LDB(B1, 1, 1); PG8_SCHED; PG8_LDA(At, 1, 0); PG8_STAGE(PG8_SA(0, 1), a2 + hstep, voffA);
            PG8_WAIT_V(8); PG8_WAIT_L(0); PG8_BAR; PG8_MMA(0, 0, At, B0); PG8_MMA(0, 1, At, B1); PG8_BAR; PG8_SCHED;
            PG8_LDA(At, 1, 1); PG8_STAGE(PG8_SB(1, 0), b3, voffB); PG8_STAGE(PG8_SB(1, 1), b3 + hstep, voffB); PG8_STAGE(PG8_SA(1, 0), a3, voffA);
            PG8_WAIT_V(8); PG8_WAIT_L(0); PG8_BAR; PG8_MMA(1, 0, At, B0); PG8_MMA(1, 1, At, B1); PG8_BAR; PG8_SCHED;
            } else {
            PG8_LDB(B0, 0, 0); PG8_SCHED; PG8_LDA(At, 0, 0); PG8_STAGE(PG8_SA(1, 1), a1 + hstep, voffA);
            PG8_WAIT_L(8); PG8_BAR; PG8_WAIT_L(0); PG8_MMA(0, 0, At, B0); PG8_BAR; PG8_SCHED;
            PG8_LDB(B1, 0, 1); PG8_STAGE(PG8_SB(0, 0), b2, voffB);
            PG8_BAR; PG8_WAIT_L(0); PG8_MMA(0, 1, At, B1); PG8_BAR;
            PG8_LDA(At, 0, 1); PG8_STAGE(PG8_SA(0, 0), a2, voffA);
            PG8_BAR; PG8_WAIT_L(0); PG8_MMA(1, 0, At, B0); PG8_BAR; PG8_SCHED;
            PG8_STAGE(PG8_SB(0, 1), b2 + hstep, voffB);
            PG8_WAIT_V(6); PG8_BAR; PG8_MMA(1, 1, At, B1); PG8_BAR;
            PG8_LDB(B0, 1, 0); PG8_SCHED; PG8_LDA(At, 1, 0); PG8_STAGE(PG8_SA(0, 1), a2 + hstep, voffA);
            PG8_WAIT_L(8); PG8_BAR; PG8_WAIT_L(0); PG8_MMA(0, 0, At, B0); PG8_BAR; PG8_SCHED;
            PG8_LDB(B1, 1, 1); PG8_STAGE(PG8_SB(1, 0), b3, voffB);
            PG8_BAR; PG8_WAIT_L(0); PG8_MMA(0, 1, At, B1); PG8_BAR;
            PG8_LDA(At, 1, 1); PG8_STAGE(PG8_SA(1, 0), a3, voffA);
            PG8_BAR; PG8_WAIT_L(0); PG8_MMA(1, 0, At, B0); PG8_BAR; PG8_SCHED;
            PG8_STAGE(PG8_SB(1, 1), b3 + hstep, voffB);
            PG8_WAIT_V(6); PG8_BAR; PG8_MMA(1, 1, At, B1); PG8_BAR;
            }
        }
        if constexpr (ALIGN_EPI) { if (wr == 0) PG8_BAR; }
        if constexpr (!Epi::AFTER_DRAIN) { E(acc, cur, wr, wc, fr, fq); S.done(cur); }
        if (!has_next) break;
#pragma unroll
        for (int a = 0; a < 2; ++a)
#pragma unroll
            for (int b = 0; b < 2; ++b)
#pragma unroll
                for (int m = 0; m < 4; ++m)
#pragma unroll
                    for (int n = 0; n < 2; ++n) acc[a][b][m][n] = (f32x4){0.f, 0.f, 0.f, 0.f};
        cur = nxt; cA = nA; cB = nB; ++ui;
        if constexpr (ALIGN_EPI) { if (wr == 1) PG8_BAR; }
    }
    PG8_WAIT_V(0);
    if constexpr (!ALIGN_EPI) { if (wr == 0) PG8_BAR; }
    PG8_BAR;
    if constexpr (Epi::AFTER_DRAIN) { E.fused(acc, cur, wr, wc, fr, fq, lds, wid, lane); S.done(cur); }
#undef PG8_SA
#undef PG8_SB
#undef PG8_STAGE
#undef PG8_LDA
#undef PG8_LDB
#undef PG8_MMA
#undef PG8_WAIT_V
#undef PG8_WAIT_L
#undef PG8_BAR
#undef PG8_SCHED
}
}
#ifndef PG8_SP2
#define PG8_SP2 true
#endif
#ifndef PG8_ALIGN
#define PG8_ALIGN true
#endif
constexpr int NWAVES = 8;
constexpr int BATCH = 8, SEQ = 4096, DM = 1024, M = BATCH * SEQ, NIN = 3328, HD = 64;
constexpr float LOG2E = 1.4426950408889634f;
constexpr size_t MiB = 1u << 20;
constexpr size_t WS_CTL = 0, CTL_ZERO_BYTES = 64 * 1024;
constexpr size_t WS_COS = 1 * MiB, WS_SIN = WS_COS + 512 * 1024;
constexpr size_t WS_WIT = 2 * MiB, WS_WOT = 9 * MiB;
constexpr size_t WS_XN = 16 * MiB;
constexpr size_t WS_QA = 80 * MiB, WS_QB = 112 * MiB, WS_KA = 144 * MiB, WS_VA = 152 * MiB, WS_KB = 160 * MiB, WS_VB = 192 * MiB;
constexpr size_t WS_GA = 224 * MiB, WS_GB = 256 * MiB, WS_MIX = 288 * MiB, WS_END = 352 * MiB;
constexpr int CW_BAR = 1024;
constexpr int RING_OFF = 0, RING_BYTES = 131072;
constexpr int LDSCTL_OFF = RING_BYTES, MISC_OFF = LDSCTL_OFF + 320;
constexpr int LDS_BYTES = 147456;
static_assert(MISC_OFF + 128 <= LDS_BYTES, "LDS map");
#define GAS __attribute__((address_space(1)))
#define LAS __attribute__((address_space(3)))
typedef unsigned short bf16;
typedef unsigned v4u __attribute__((ext_vector_type(4)));
typedef float f32x4 __attribute__((ext_vector_type(4)));
typedef short bf16x8 __attribute__((ext_vector_type(8)));
typedef GAS unsigned gu32;
typedef GAS unsigned long long gu64;
#define RLX_AGENT __ATOMIC_RELAXED, __HIP_MEMORY_SCOPE_AGENT
#define LDS_WAIT() asm volatile("s_waitcnt lgkmcnt(0)" ::: "memory")
#define VM_WAIT() asm volatile("s_waitcnt vmcnt(0)" ::: "memory")
__device__ __forceinline__ unsigned long long rt() { return __builtin_amdgcn_s_memrealtime(); }
__device__ __forceinline__ unsigned f2bf(float f) { unsigned u = __builtin_bit_cast(unsigned, f); return (u + 0x7fffu + ((u >> 16) & 1u)) >> 16; }
__device__ __forceinline__ unsigned pk2(float lo, float hi) { return f2bf(lo) | (f2bf(hi) << 16); }

#define XB_TMO      128
#define XB_XCNT(j)  (256  + 64 * (j))
#define XB_XSUB(j)  (1280 + 64 * (j))
#define XB_XGEN(j)  (2304 + 64 * (j))
#define XB_TOP      3328
#define XB_TOPGEN   3392
#define XCD_BAR_WORDS 3456
#define XB_SPIN_CAP (1u << 18)

__device__ __forceinline__ unsigned xb_ld(unsigned* p)              { return __hip_atomic_load(p, __ATOMIC_RELAXED, __HIP_MEMORY_SCOPE_AGENT); }
__device__ __forceinline__ unsigned xb_add(unsigned* p, unsigned v) { return __hip_atomic_fetch_add(p, v, __ATOMIC_RELAXED, __HIP_MEMORY_SCOPE_AGENT); }
__device__ __forceinline__ unsigned xb_xcc_id() { return (unsigned)__builtin_amdgcn_s_getreg((3 << 11) | 20) & 0xFu; }
#define XB_SPIN(cond, bar) do { unsigned _sp = 0; while (cond) { __builtin_amdgcn_s_sleep(1); \
    if ((++_sp & 255u) == 0u) { if (xb_ld(&(bar)[XB_TMO])) break; if (_sp > XB_SPIN_CAP) { atomicAdd(&(bar)[XB_TMO], 1u); break; } } } } while (0)

struct XcdBarrier {
    unsigned* bar; unsigned x;
    volatile LAS unsigned* st;
};

__device__ __forceinline__ XcdBarrier xcd_barrier_post(unsigned* bar, volatile LAS unsigned* st) {
    XcdBarrier b; b.bar = bar; b.x = xb_xcc_id(); b.st = st;
    if (threadIdx.x == 0) (void)xb_add(&bar[XB_XCNT(b.x)], 1u);
    return b;
}
__device__ __forceinline__ void xcd_barrier_complete(unsigned* bar, unsigned x, unsigned& nloc, unsigned& nx) {
    const unsigned G = gridDim.x * gridDim.y * gridDim.z;
    unsigned sum, cnt, mine, sp = 0u;
    for (;;) {
        sum = 0u; cnt = 0u; mine = 0u;
#pragma unroll
        for (unsigned j = 0; j < 16; ++j) { const unsigned c = xb_ld(&bar[XB_XCNT(j)]); sum += c; cnt += (c > 0u) ? 1u : 0u; mine = (j == x) ? c : mine; }
        if (sum == G) break;
        __builtin_amdgcn_s_sleep(1);
        if ((++sp & 255u) == 0u) { if (xb_ld(&bar[XB_TMO])) break; if (sp > XB_SPIN_CAP) { atomicAdd(&bar[XB_TMO], 1u); break; } }
    }
    nloc = mine > 0u ? mine : 1u; nx = cnt > 0u ? cnt : 1u;
}

__device__ __forceinline__ void xcd_barrier(const XcdBarrier& b) {
    asm volatile("s_waitcnt vmcnt(0)" ::: "memory");
    __syncthreads();
    if (threadIdx.x == 0) {
        unsigned* bar = b.bar;
        __builtin_amdgcn_s_waitcnt(0);
        unsigned nloc = b.st[0], nx = b.st[1];
        if (nloc == 0u) { xcd_barrier_complete(bar, b.x, nloc, nx); b.st[0] = nloc; b.st[1] = nx; }
        const unsigned old = xb_add(&bar[XB_XSUB(b.x)], 1u);
        const unsigned gen = old / nloc;
        if (old + 1u == (gen + 1u) * nloc) {
            __builtin_amdgcn_fence(__ATOMIC_RELEASE, "agent");
            asm volatile("s_waitcnt vmcnt(0)" ::: "memory");
            const unsigned og = xb_add(&bar[XB_TOP], 1u);
            const unsigned tg = og / nx;
            if (og + 1u == (tg + 1u) * nx) xb_add(&bar[XB_TOPGEN], 1u);
            else XB_SPIN(xb_ld(&bar[XB_TOPGEN]) == tg, bar);
            __builtin_amdgcn_fence(__ATOMIC_ACQUIRE, "agent");
            xb_add(&bar[XB_XGEN(b.x)], 1u);
            asm volatile("s_waitcnt vmcnt(0)" ::: "memory");
        } else {
            XB_SPIN(xb_ld(&bar[XB_XGEN(b.x)]) == gen, bar);
            __builtin_amdgcn_fence(__ATOMIC_ACQUIRE, "agent");
            asm volatile("s_waitcnt vmcnt(0)" ::: "memory");
        }
    }
    __syncthreads();
}
static_assert((CW_BAR + XCD_BAR_WORDS) * 4 <= (int)CTL_ZERO_BYTES, "barrier words inside the memset region");

struct Frame {
    LAS unsigned char* lds;
    volatile LAS unsigned* MISC;
    gu32* ctl;
    int tid, lane, wave;
    int vcu, G;
};
__device__ __forceinline__ float bf2f(bf16 b) { return __uint_as_float(((unsigned)b) << 16); }
__device__ __forceinline__ float wave_sum(float v) {
#pragma unroll
    for (int o = 1; o < 64; o <<= 1) v += __shfl_xor(v, o);
    return v;
}
__device__ __forceinline__ void sincos_d(float ang, float& s, float& c) {
    const double a = (double)ang;
    const double k = rint(a * 0.6366197723675814);
    double y = fma(-k, 1.5707963267948966, a);
    y = fma(-k, 6.123233995736766e-17, y);
    const double y2 = y * y;
    const double sp = y * (1.0 + y2 * (-1.0 / 6 + y2 * (1.0 / 120 + y2 * (-1.0 / 5040 + y2 * (1.0 / 362880 + y2 * (-1.0 / 39916800 + y2 * (1.0 / 6227020800.0)))))));
    const double cp = 1.0 + y2 * (-0.5 + y2 * (1.0 / 24 + y2 * (-1.0 / 720 + y2 * (1.0 / 40320 + y2 * (-1.0 / 3628800 + y2 * (1.0 / 479001600.0 + y2 * (-1.0 / 87178291200.0)))))));
    const int q = ((int)(long long)k) & 3;
    const double ss = (q == 0) ? sp : (q == 1) ? cp : (q == 2) ? -sp : -cp;
    const double cc = (q == 0) ? cp : (q == 1) ? -sp : (q == 2) ? -cp : sp;
    s = (float)ss; c = (float)cc;
}
__device__ __forceinline__ void p0_transpose_item(const float* W, int K, int N, bf16* WT, int k0, int n0, int d0, LAS float* scr, int lane) {
#pragma unroll 8
    for (int i = 0; i < 32; ++i) { const int kk = 2 * i + (lane >> 5); scr[kk * 33 + (lane & 31)] = W[(size_t)(k0 + kk) * N + n0 + (lane & 31)]; }
    LDS_WAIT(); asm volatile("" ::: "memory");
    const int c = lane & 7;
#pragma unroll
    for (int j = 0; j < 4; ++j) { const int n = (lane >> 3) + 8 * j; const LAS float* s = scr + (8 * c) * 33 + n;
        v4u o; o.x = pk2(s[0 * 33], s[1 * 33]); o.y = pk2(s[2 * 33], s[3 * 33]); o.z = pk2(s[4 * 33], s[5 * 33]); o.w = pk2(s[6 * 33], s[7 * 33]);
        *(GAS v4u*)(WT + (size_t)(d0 + n) * K + k0 + 8 * c) = o; }
    LDS_WAIT(); asm volatile("" ::: "memory");
}
struct Ptrs {
    const float *x, *gain, *w_in, *qna, *kna, *sinks, *qnb, *knb, *w_out; float* out;
    bf16 *WIT, *WOT, *XN, *QA, *KA, *VA, *GA, *QB, *KB, *VB, *GB, *MIX; float *cosT, *sinT;
};
__device__ __forceinline__ void p0_prologue(Frame& F, const Ptrs& P) {
    LAS float* scr = (LAS float*)(F.lds + RING_OFF + F.wave * 16384);
    const int gw = F.vcu * NWAVES + F.wave, NGW = F.G * NWAVES;
    constexpr int I_IN = (DM / 64) * (NIN / 32), I_OUT = (DM / 64) * (DM / 32);
    for (int it = gw; it < I_IN + I_OUT; it += NGW) {
        if (it < I_IN) { const int nblk = NIN / 32, kb = it / nblk, nb = it % nblk, n0 = 32 * nb;
            const int pn = n0 >> 8, rem = n0 & 255, wc = rem >> 6, bjj = (rem >> 5) & 1;
            p0_transpose_item(P.w_in, DM, NIN, P.WIT, 64 * kb, n0, 256 * pn + 128 * bjj + 32 * wc, scr, F.lane); }
        else { const int r = it - I_IN, nblk = DM / 32, kb = r / nblk, nb = r % nblk; p0_transpose_item(P.w_out, DM, DM, P.WOT, 64 * kb, 32 * nb, 32 * nb, scr, F.lane); }
    }
    for (int e = (F.vcu * NWAVES * 64) + F.tid; e < SEQ * 32; e += F.G * NWAVES * 64) {
        const int t = e >> 5, i = e & 31;
        double r = 1.0; for (int k = 0; k < i; ++k) r *= 0.7498942093324558;
        const float inv = (float)r; const float ang = (float)t * inv;
        float s, c; sincos_d(ang, s, c); P.cosT[e] = c; P.sinT[e] = s;
    }
    for (int m = gw; m < M; m += NGW) {
        const GAS f32x4* xr = (const GAS f32x4*)(P.x + (size_t)m * DM) + F.lane;
        f32x4 v[4]; float ss = 0.f;
#pragma unroll
        for (int j = 0; j < 4; ++j) { v[j] = xr[64 * j]; ss += (v[j].x * v[j].x + v[j].y * v[j].y) + (v[j].z * v[j].z + v[j].w * v[j].w); }
        const float rstd = rsqrtf(wave_sum(ss) * (1.f / DM) + 1e-6f);
        GAS unsigned long long* o8 = (GAS unsigned long long*)(P.XN + (size_t)m * DM) + F.lane;
#pragma unroll
        for (int j = 0; j < 4; ++j) { const f32x4 g = ((const GAS f32x4*)P.gain)[64 * j + F.lane];
            o8[64 * j] = (unsigned long long)pk2(v[j].x * rstd * g.x, v[j].y * rstd * g.y) | ((unsigned long long)pk2(v[j].z * rstd * g.z, v[j].w * rstd * g.w) << 32); }
    }
}
__device__ __forceinline__ void p2_attention_naive(Frame& F, const Ptrs& P) {
    const int gw = F.vcu * NWAVES + F.wave, NGW = F.G * NWAVES, lane = F.lane;
    for (int w = gw; w < M * 16; w += NGW) {
        const int m = w >> 4, hs = w & 15, b = m / SEQ, t = m % SEQ;
        if (hs < 8) {
            const int h = hs, kv = h >> 2;
            const float q = bf2f(P.QA[((size_t)(b * 8 + h) * SEQ + t) * 64 + lane]);
            const bf16* K = P.KA + (size_t)(b * 2 + kv) * SEQ * 64; const bf16* V = P.VA + (size_t)(b * 2 + kv) * SEQ * 64;
            float l = 0.f, o = 0.f;
            for (int j = 0; j < 128; ++j) { const int tk = t - j; if (tk < 0) break;
                float s = q * bf2f(K[(size_t)tk * 64 + lane]);
                s = wave_sum(s);
                const float p = __builtin_amdgcn_exp2f(s); l += p; o += p * bf2f(V[(size_t)tk * 64 + lane]); }
            l += __builtin_amdgcn_exp2f(P.sinks[h] * LOG2E);
            const float g = bf2f(P.GA[(size_t)m * 512 + h * 64 + lane]);
            P.MIX[(size_t)m * DM + h * 64 + lane] = (bf16)f2bf(o / l * g);
        } else {
            const int h = hs - 8;
            const float q = bf2f(P.QB[((size_t)(b * 8 + h) * SEQ + t) * 64 + lane]);
            const bf16* K = P.KB + (size_t)(b * 8 + h) * SEQ * 64; const bf16* V = P.VB + (size_t)(b * 8 + h) * SEQ * 64;
            float l = 0.f, o = 0.f;
            for (int p3 = 0; p3 < 3; ++p3) { const int dil = (p3 == 0) ? 1 : (p3 == 1) ? 4 : 16;
                for (int j = 0; j <= 128; ++j) { const int tk = t - j * dil; if (tk < 0) break;
                    float s = q * bf2f(K[(size_t)tk * 64 + lane]);
                    s = wave_sum(s);
                    const float p = __builtin_amdgcn_exp2f(s); l += p; o += p * bf2f(V[(size_t)tk * 64 + lane]); } }
            const float g = bf2f(P.GB[(size_t)m * 512 + h * 64 + lane]);
            P.MIX[(size_t)m * DM + 512 + h * 64 + lane] = (bf16)f2bf(o / l * g);
        }
    }
}

struct Args { const float* in[9]; float* out; unsigned char* ws; };
__global__ void __launch_bounds__(NWAVES * 64, 2) mega_fwd(Args args) {
    extern __shared__ __attribute__((aligned(16))) unsigned char lds[];
    Frame F;
    F.lds = (LAS unsigned char*)lds;
    F.MISC = (volatile LAS unsigned*)(F.lds + MISC_OFF);
    F.tid = threadIdx.x; F.lane = F.tid & 63; F.wave = __builtin_amdgcn_readfirstlane(F.tid >> 6);
    F.G = gridDim.x; { const int bx = blockIdx.x; F.vcu = (F.G % 8 == 0) ? (bx % 8) * (F.G / 8) + bx / 8 : bx; }
    unsigned char* ws = args.ws;
    F.ctl = (gu32*)(ws + WS_CTL);
    Ptrs P;
    P.x = args.in[0]; P.gain = args.in[1]; P.w_in = args.in[2]; P.qna = args.in[3]; P.kna = args.in[4]; P.sinks = args.in[5]; P.qnb = args.in[6]; P.knb = args.in[7]; P.w_out = args.in[8]; P.out = args.out;
    P.WIT = (bf16*)(ws + WS_WIT); P.WOT = (bf16*)(ws + WS_WOT); P.XN = (bf16*)(ws + WS_XN);
    P.QA = (bf16*)(ws + WS_QA); P.KA = (bf16*)(ws + WS_KA); P.VA = (bf16*)(ws + WS_VA); P.GA = (bf16*)(ws + WS_GA);
    P.QB = (bf16*)(ws + WS_QB); P.KB = (bf16*)(ws + WS_KB); P.VB = (bf16*)(ws + WS_VB); P.GB = (bf16*)(ws + WS_GB); P.MIX = (bf16*)(ws + WS_MIX);
    P.cosT = (float*)(ws + WS_COS); P.sinT = (float*)(ws + WS_SIN);
    for (int u = F.tid; u < (LDS_BYTES - LDSCTL_OFF) / 4; u += NWAVES * 64) ((LAS unsigned*)(F.lds + LDSCTL_OFF))[u] = 0u;
    __syncthreads();
    XcdBarrier bar = xcd_barrier_post((unsigned*)(F.ctl + CW_BAR), F.MISC + 8);

    p0_prologue(F, P);
    xcd_barrier(bar);
    {
        pg8::Gemm g{P.XN, P.WIT, M, NIN, DM}; pg8::StaticOrder S; S.init(M, NIN, F.G, (int)blockIdx.x);
        pg8::EpiIn E{P.QA, P.KA, P.VA, P.GA, P.QB, P.KB, P.VB, P.GB, P.qna, P.kna, P.qnb, P.knb, P.cosT, P.sinT};
        pg8::gemm_phase<pg8::EpiIn, pg8::StaticOrder, PG8_ALIGN, PG8_SP2>(F.lds + RING_OFF, g, S, E);
    }
    xcd_barrier(bar);
    p2_attention_naive(F, P);
    xcd_barrier(bar);
    {
        pg8::Gemm g{P.MIX, P.WOT, M, DM, DM}; pg8::StaticOrder S; S.init(M, DM, F.G, (int)blockIdx.x);
        pg8::EpiRes E{P.x, P.out};
        pg8::gemm_phase<pg8::EpiRes, pg8::StaticOrder, PG8_ALIGN, PG8_SP2>(F.lds + RING_OFF, g, S, E);
    }
}

extern "C" void kernel_launch(void* const* d_in, const int* in_sizes, int n_in, void* d_out, int out_size, void* d_ws, size_t ws_size, hipStream_t stream) {
    static int grid = 0;
    if (grid == 0) {
        if (n_in != 9 || out_size != M * DM || ws_size < WS_END) { fprintf(stderr, "kernel_launch: unexpected shapes (n_in %d, out %d, ws %zu); nothing launched\n", n_in, out_size, ws_size); grid = -1; return; }
        int dev = 0, cus = 0;
        if (hipGetDevice(&dev) != hipSuccess || hipDeviceGetAttribute(&cus, hipDeviceAttributeMultiprocessorCount, dev) != hipSuccess) { grid = -1; return; }
        if (hipFuncSetAttribute((const void*)mega_fwd, hipFuncAttributeMaxDynamicSharedMemorySize, LDS_BYTES) != hipSuccess) { fprintf(stderr, "kernel_launch: hipFuncSetAttribute failed\n"); grid = -1; return; }
        (void)hipGetLastError();
        grid = cus;
    }
    if (grid < 0) return;
    if (hipMemsetAsync((char*)d_ws + WS_CTL, 0, CTL_ZERO_BYTES, stream) != hipSuccess) { fprintf(stderr, "kernel_launch: hipMemsetAsync failed\n"); return; }
    Args a{};
    for (int i = 0; i < 9; ++i) a.in[i] = (const float*)d_in[i];
    a.out = (float*)d_out; a.ws = (unsigned char*)d_ws;
    hipLaunchKernelGGL(mega_fwd, dim3(grid), dim3(NWAVES * 64), LDS_BYTES, stream, a);
}
```

```cpp
#include <hip/hip_runtime.h>
#include <cstdio>
#include <cstdint>
#include <cmath>
namespace pg8 {
#define PG8_LAS __attribute__((address_space(3)))
typedef unsigned short bf16_t;
typedef short bf16x8 __attribute__((ext_vector_type(8)));
typedef float f32x4 __attribute__((ext_vector_type(4)));
typedef unsigned u32x4 __attribute__((ext_vector_type(4)));
constexpr int BM = 256, BK = 64, HALF = 128, HTB = HALF * BK * 2  , STAGE_BYTES = 8 * HTB, NXCD = 8, WGM = 8;

__host__ __device__ __forceinline__ int lds_byte(int r, int c) { const int st = (r >> 4) * 2 + (c >> 5), rr = r & 15, cc = c & 31, ob = rr * 64 + cc * 2; return st * 1024 + (ob ^ (((ob >> 9) & 1) << 5)); }
__host__ __device__ __forceinline__ void stage_rc(int b, int& R, int& C) { const int st = b / 1024, sb = b % 1024, swz = sb ^ (((sb >> 9) & 1) << 5); R = (st >> 1) * 16 + swz / 64; C = (st & 1) * 32 + (swz % 64) / 2; }
__host__ __device__ __forceinline__ int perm32(int rho) { const int n = rho >> 4, i = rho & 15; return 8 * (i >> 2) + 4 * n + (i & 3); }

struct Unit { int pm, pn; };
struct Gemm { const bf16_t* A; const bf16_t* Bt; int M, N, K; };

struct StaticOrder {
    int nM, nN, nwg, G, c;
    __host__ __device__ void init(int M, int N, int G_, int c_) { nM = M / BM; nN = N / BM; nwg = nM * nN; G = G_; c = c_; }
    __host__ __device__ bool next(int i, Unit& u) const {
        const long L = (long)i * G + c; if (L >= nwg) return false;
        int wgid = (int)L; { const int q = nwg / NXCD, r = nwg % NXCD, xcd = wgid % NXCD, off = wgid / NXCD; wgid = (xcd < r ? xcd * (q + 1) : r * (q + 1) + (xcd - r) * q) + off; }
        const int nig = WGM * nN, gid = wgid / nig, fm = gid * WGM, gsz = (nM - fm) < WGM ? (nM - fm) : WGM;
        u.pm = fm + ((wgid % nig) % gsz); u.pn = (wgid % nig) / gsz; return true;
    }
    __device__ __forceinline__ void a_ready(const Unit&) const {}
    __device__ __forceinline__ void done(const Unit&) const {}
};

__device__ __forceinline__ unsigned cvt_pk_bf16(float lo, float hi) { unsigned r; asm volatile("v_cvt_pk_bf16_f32 %0, %1, %2" : "=v"(r) : "v"(lo), "v"(hi)); return r; }
typedef float f32x2 __attribute__((ext_vector_type(2)));
typedef float f32x2 __attribute__((ext_vector_type(2)));
constexpr int SEQ_ = 4096;
constexpr float C2_ = 0.18033688011112042f, LOG2E_ = 1.4426950408889634f;
__device__ __forceinline__ u32x4 pack8(const f32x4& a, const f32x4& b) { u32x4 w; w.x = cvt_pk_bf16(a[0], a[1]); w.y = cvt_pk_bf16(a[2], a[3]); w.z = cvt_pk_bf16(b[0], b[1]); w.w = cvt_pk_bf16(b[2], b[3]); return w; }
struct EpiIn {
    static constexpr bool PERM = true, AFTER_DRAIN = false;
    bf16_t *QA, *KA, *VA, *GA, *QB, *KB, *VB, *GB;
    const float *qna, *kna, *qnb, *knb, *cosT, *sinT;
    __device__ __forceinline__ void operator()(const f32x4 (&acc)[2][2][4][2], const Unit& u, int wr, int wc, int fr, int fq) const {
        const int g = u.pn * 4 + wc;
        int type, head, H = 8; const float* ng = qna; bf16_t* dst; float scale = 1.f;
        if (g < 8) { type = 0; head = g; ng = qna; dst = QA; scale = C2_; }
        else if (g < 10) { type = 0; head = g - 8; ng = kna; dst = KA; H = 2; }
        else if (g < 12) { type = 1; head = g - 10; dst = VA; H = 2; }
        else if (g < 20) { type = 2; head = g - 12; dst = GA; }
        else if (g < 28) { type = 0; head = g - 20; ng = qnb; dst = QB; scale = C2_; }
        else if (g < 36) { type = 0; head = g - 28; ng = knb; dst = KB; }
        else if (g < 44) { type = 1; head = g - 36; dst = VB; }
        else { type = 2; head = g - 44; dst = GB; }
        const int row0 = u.pm * BM + wr * 64 + fr;
        if (type == 0) {
            f32x4 gv[2][2];
#pragma unroll
            for (int bj = 0; bj < 2; ++bj)
#pragma unroll
                for (int n = 0; n < 2; ++n) gv[bj][n] = *(const f32x4*)(ng + 32 * bj + 8 * fq + 4 * n);
#pragma unroll
            for (int ai = 0; ai < 2; ++ai)
#pragma unroll
                for (int m = 0; m < 4; ++m) {
                    const int row = row0 + ai * HALF + m * 16, b = row >> 12, t = row & (SEQ_ - 1);
                    float ss = 0.f;
#pragma unroll
                    for (int bj = 0; bj < 2; ++bj)
#pragma unroll
                        for (int n = 0; n < 2; ++n) { const f32x4 x = acc[ai][bj][m][n]; ss += (x[0] * x[0] + x[1] * x[1]) + (x[2] * x[2] + x[3] * x[3]); }
                    ss += __shfl_xor(ss, 16); ss += __shfl_xor(ss, 32);
                    const float rs = rsqrtf(ss * (1.f / 64.f) + 1e-6f);
                    f32x4 o1[2], o2[2];
#pragma unroll
                    for (int n = 0; n < 2; ++n) {
                        const f32x4 cs = *(const f32x4*)(cosT + t * 32 + 8 * fq + 4 * n), sn = *(const f32x4*)(sinT + t * 32 + 8 * fq + 4 * n);
                        const f32x4 n1 = acc[ai][0][m][n] * rs * gv[0][n], n2 = acc[ai][1][m][n] * rs * gv[1][n];
                        o1[n] = (n1 * cs - n2 * sn) * scale; o2[n] = (n2 * cs + n1 * sn) * scale;
                    }
                    bf16_t* p = dst + ((size_t)(b * H + head) * SEQ_ + t) * 64 + 8 * fq;
                    *(u32x4*)p = pack8(o1[0], o1[1]); *(u32x4*)(p + 32) = pack8(o2[0], o2[1]);
                }
        } else if (type == 1) {
#pragma unroll
            for (int ai = 0; ai < 2; ++ai)
#pragma unroll
                for (int m = 0; m < 4; ++m) {
                    const int row = row0 + ai * HALF + m * 16, b = row >> 12, t = row & (SEQ_ - 1);
                    bf16_t* p = dst + ((size_t)(b * H + head) * SEQ_ + t) * 64 + 8 * fq;
                    *(u32x4*)p = pack8(acc[ai][0][m][0], acc[ai][0][m][1]); *(u32x4*)(p + 32) = pack8(acc[ai][1][m][0], acc[ai][1][m][1]);
                }
        } else {
#pragma unroll
            for (int ai = 0; ai < 2; ++ai)
#pragma unroll
                for (int m = 0; m < 4; ++m) {
                    const int row = row0 + ai * HALF + m * 16;
                    bf16_t* p = dst + (size_t)row * 512 + head * 64 + 8 * fq;
#pragma unroll
                    for (int bj = 0; bj < 2; ++bj) {
                        f32x4 s[2];
#pragma unroll
                        for (int n = 0; n < 2; ++n) { const f32x4 v = acc[ai][bj][m][n];
#pragma unroll
                            for (int e = 0; e < 4; ++e) s[n][e] = v[e] * __builtin_amdgcn_rcpf(1.f + __builtin_amdgcn_exp2f(-v[e] * LOG2E_)); }
                        *(u32x4*)(p + 32 * bj) = pack8(s[0], s[1]);
                    }
                }
        }
    }
};
struct EpiRes {
    static constexpr bool PERM = true, AFTER_DRAIN = false;
    const float* x; float* out;
    __device__ __forceinline__ void operator()(const f32x4 (&acc)[2][2][4][2], const Unit& u, int wr, int wc, int fr, int fq) const {
        const int row0 = u.pm * BM + wr * 64 + fr, col0 = u.pn * BM + wc * 32 + 8 * fq;
#pragma unroll
        for (int ai = 0; ai < 2; ++ai)
#pragma unroll
            for (int m = 0; m < 4; ++m) {
                const size_t off = (size_t)(row0 + ai * HALF + m * 16) * 1024 + col0;
#pragma unroll
                for (int bj = 0; bj < 2; ++bj) {
                    const f32x4 a = *(const f32x4*)(x + off + bj * HALF), b = *(const f32x4*)(x + off + bj * HALF + 4);
                    *(f32x4*)(out + off + bj * HALF) = a + acc[ai][bj][m][0]; *(f32x4*)(out + off + bj * HALF + 4) = b + acc[ai][bj][m][1];
                }
            }
    }
};
template <class Epi, class Sched, bool ALIGN_EPI = false, bool SP2 = false>
__device__ __forceinline__ void gemm_phase(PG8_LAS unsigned char* lds, const Gemm g, const Sched& S, const Epi& E) {
    const int tid = threadIdx.x, wid = __builtin_amdgcn_readfirstlane(tid >> 6), lane = tid & 63, wr = wid >> 2, wc = wid & 3, fr = lane & 15, fq = lane >> 4;
    const int K = g.K, nt = K / BK;
    unsigned voffA[2], voffB[2];
#pragma unroll
    for (int i = 0; i < 2; ++i) { int R, C; stage_rc(tid * 16 + i * 8192, R, C); const int Rb = Epi::PERM ? ((R & ~31) + perm32(R & 31)) : R;
        voffA[i] = (unsigned)(R * K + C) * 2u; voffB[i] = (unsigned)(Rb * K + C) * 2u; }
    const size_t kstep = (size_t)(BK * 2);
    const size_t hstep = (size_t)HALF * K * 2;
    const size_t tstep = 2 * hstep;
    const unsigned ldsw = (unsigned)wid * 1024u;
    const int aoff = lds_byte(wr * 64 + fr, fq * 8), boff = lds_byte(wc * 32 + fr, fq * 8);
#define PG8_SA(b, h) (((b) * 2 + (h)) * HTB)
#define PG8_SB(b, h) ((4 + (b) * 2 + (h)) * HTB)
#define PG8_STAGE(bufoff, gbase, voff) do { _Pragma("unroll") for (int _i = 0; _i < 2; ++_i) \
        __builtin_amdgcn_global_load_lds((const unsigned*)((const char*)(gbase) + (voff)[_i]), (PG8_LAS unsigned*)(lds + (bufoff) + ldsw + _i * 8192), 16, 0, 0); } while (0)
#define PG8_LDA(dst, b, h) do { _Pragma("unroll") for (int m = 0; m < 4; ++m) _Pragma("unroll") for (int k = 0; k < 2; ++k) dst[m][k] = *(const PG8_LAS bf16x8*)(lds + PG8_SA(b, h) + aoff + m * 2048 + k * 1024); } while (0)
#define PG8_LDB(dst, b, h) do { _Pragma("unroll") for (int n = 0; n < 2; ++n) _Pragma("unroll") for (int k = 0; k < 2; ++k) dst[n][k] = *(const PG8_LAS bf16x8*)(lds + PG8_SB(b, h) + boff + n * 2048 + k * 1024); } while (0)
#define PG8_MMA(ai, bj, At, Bt) do { __builtin_amdgcn_s_setprio(1); _Pragma("unroll") for (int m = 0; m < 4; ++m) _Pragma("unroll") for (int n = 0; n < 2; ++n) _Pragma("unroll") for (int k = 0; k < 2; ++k) \
        acc[ai][bj][m][n] = __builtin_amdgcn_mfma_f32_16x16x32_bf16(Bt[n][k], At[m][k], acc[ai][bj][m][n], 0, 0, 0); __builtin_amdgcn_s_setprio(0); } while (0)
#define PG8_WAIT_V(n) asm volatile("s_waitcnt vmcnt(" #n ")" ::: "memory")
#define PG8_WAIT_L(n) asm volatile("s_waitcnt lgkmcnt(" #n ")" ::: "memory")
#define PG8_BAR __builtin_amdgcn_s_barrier()
#define PG8_SCHED __builtin_amdgcn_sched_barrier(0)
    Unit cur, nxt; int ui = 0;
    if (!S.next(0, cur)) return;
    f32x4 acc[2][2][4][2];
#pragma unroll
    for (int a = 0; a < 2; ++a)
#pragma unroll
        for (int b = 0; b < 2; ++b)
#pragma unroll
            for (int m = 0; m < 4; ++m)
#pragma unroll
                for (int n = 0; n < 2; ++n) acc[a][b][m][n] = (f32x4){0.f, 0.f, 0.f, 0.f};
    bf16x8 At[4][2], B0[2][2], B1[2][2];
    const char* cA = (const char*)g.A + (size_t)cur.pm * tstep; const char* cB = (const char*)g.Bt + (size_t)cur.pn * tstep;
    S.a_ready(cur);
    if constexpr (SP2) {
        PG8_STAGE(PG8_SB(0, 0), cB, voffB); PG8_STAGE(PG8_SB(0, 1), cB + hstep, voffB); PG8_STAGE(PG8_SA(0, 0), cA, voffA); PG8_STAGE(PG8_SA(0, 1), cA + hstep, voffA);
        if (wr == 1) PG8_BAR;
        PG8_WAIT_V(2); PG8_BAR;
        PG8_STAGE(PG8_SB(1, 0), cB + kstep, voffB); PG8_STAGE(PG8_SA(1, 0), cA + kstep, voffA); PG8_STAGE(PG8_SB(1, 1), cB + hstep + kstep, voffB);
        PG8_WAIT_V(6); PG8_BAR;
    } else {
        PG8_STAGE(PG8_SB(0, 0), cB, voffB); PG8_STAGE(PG8_SA(0, 0), cA, voffA); PG8_STAGE(PG8_SB(0, 1), cB + hstep, voffB); PG8_STAGE(PG8_SA(0, 1), cA + hstep, voffA);
        if (wr == 1) PG8_BAR;
        PG8_WAIT_V(4); PG8_BAR;
        PG8_STAGE(PG8_SB(1, 0), cB + kstep, voffB); PG8_STAGE(PG8_SA(1, 0), cA + kstep, voffA); PG8_STAGE(PG8_SB(1, 1), cB + hstep + kstep, voffB);
        PG8_WAIT_V(6); PG8_BAR;
    }
    for (;;) {
        const bool has_next = S.next(ui + 1, nxt);
        const char* nA = has_next ? (const char*)g.A + (size_t)nxt.pm * tstep : cA; const char* nB = has_next ? (const char*)g.Bt + (size_t)nxt.pn * tstep : cB;
        for (int t = 0; t < nt; t += 2) {
            const bool last = (t == nt - 2);
            const char* a1 = cA + (size_t)(t + 1) * kstep;
            const char* a2 = last ? nA : cA + (size_t)(t + 2) * kstep; const char* b2 = last ? nB : cB + (size_t)(t + 2) * kstep;
            const char* a3 = a2 + kstep; const char* b3 = b2 + kstep;
            if (last && has_next) S.a_ready(nxt);
            if constexpr (SP2) {
            PG8_LDB(B0, 0, 0); PG8_LDB(B1, 0, 1); PG8_SCHED; PG8_LDA(At, 0, 0); PG8_STAGE(PG8_SA(1, 1), a1 + hstep, voffA);
            PG8_WAIT_V(8); PG8_WAIT_L(0); PG8_BAR; PG8_MMA(0, 0, At, B0); PG8_MMA(0, 1, At, B1); PG8_BAR; PG8_SCHED;
            PG8_LDA(At, 0, 1); PG8_STAGE(PG8_SB(0, 0), b2, voffB); PG8_STAGE(PG8_SB(0, 1), b2 + hstep, voffB); PG8_STAGE(PG8_SA(0, 0), a2, voffA);
            PG8_WAIT_V(8); PG8_WAIT_L(0); PG8_BAR; PG8_MMA(1, 0, At, B0); PG8_MMA(1, 1, At, B1); PG8_BAR; PG8_SCHED;
            PG8_LDB(B0, 1, 0); PG8_LDB(B1, 1, 1); PG8_SCHED; PG8_LDA(At, 1, 0); PG8_STAGE(PG8_SA(0, 1), a2 + hstep, voffA);
            PG8_WAIT_V(8); PG8_WAIT_L(0); PG8_BAR; PG8_MMA(0, 0, At, B0); PG8_MMA(0, 1, At, B1); PG8_BAR; PG8_SCHED;
            PG8_LDA(At, 1, 1); PG8_STAGE(PG8_SB(1, 0), b3, voffB); PG8_STAGE(PG8_SB(1, 1), b3 + hstep, voffB); PG8_STAGE(PG8_SA(1, 0), a3, voffA);
            PG8_WAIT_V(8); PG8_WAIT_L(0); PG8_BAR; PG8_MMA(1, 0, At, B0); PG8_MMA(1, 1, At, B1); PG8_BAR; PG8_SCHED;
            } else {
            PG8_LDB(B0, 0, 0); PG8_SCHED; PG8_LDA(At, 0, 0); PG8_STAGE(PG8_SA(1, 1), a1 + hstep, voffA);
            PG8_WAIT_L(8); PG8_BAR; PG8_WAIT_L(0); PG8_MMA(0, 0, At, B0); PG8_BAR; PG8_SCHED;
            PG8_LDB(B1, 0, 1); PG8_STAGE(PG8_SB(0, 0), b2, voffB);
            PG8_BAR; PG8_WAIT_L(0); PG8_MMA(0, 1, At, B1); PG8_BAR;
            PG8_LDA(At, 0, 1); PG8_STAGE(PG8_SA(0, 0), a2, voffA);
            PG8_BAR; PG8_WAIT_L(0); PG8_MMA(1, 0, At, B0); PG8_BAR; PG8_SCHED;
            PG8_STAGE(PG8_SB(0, 1), b2 + hstep, voffB);
            PG8_WAIT_V(6); PG8_BAR; PG8_MMA(1, 1, At, B1); PG8_BAR;
            PG8_LDB(B0, 1, 0); PG8_SCHED; PG8_LDA(At, 1, 0); PG8_STAGE(PG8_SA(0, 1), a2 + hstep, voffA);
            PG8_WAIT_L(8); PG8_BAR; PG8_WAIT_L(0); PG8_MMA(0, 0, At, B0); PG8_BAR; PG8_SCHED;
            PG8_LDB(B1, 1, 1); PG8_STAGE(PG8_SB(1, 0), b3, voffB);
            PG8_BAR; PG8_WAIT_L(0); PG8_MMA(0, 1, At, B1); PG8_BAR;
            PG8_LDA(At, 1, 1); PG8_STAGE(PG8_SA(1, 0), a3, voffA);
            PG8_BAR; PG8_WAIT_L(0); PG8_MMA(1, 0, At, B0); PG8_BAR; PG8_SCHED;
            PG8_STAGE(PG8_SB(1, 1), b3 + hstep, voffB);
            PG8_WAIT_V(6); PG8_BAR; PG8_MMA(1, 1, At, B1); PG8_BAR;
            }
        }
        if constexpr (ALIGN_EPI) { if (wr == 0) PG8_BAR; }
        if constexpr (!Epi::AFTER_DRAIN) { E(acc, cur, wr, wc, fr, fq); S.done(cur); }
        if (!has_next) break;
#pragma unroll
        for (int a = 0; a < 2; ++a)
#pragma unroll
            for (int b = 0; b < 2; ++b)
#pragma unroll
                for (int m = 0; m < 4; ++m)
#pragma unroll
                    for (int n = 0; n < 2; ++n) acc[a][b][m][n] = (f32x4){0.f, 0.f, 0.f, 0.f};
        cur = nxt; cA = nA; cB = nB; ++ui;
        if constexpr (ALIGN_EPI) { if (wr == 1) PG8_BAR; }
    }
    PG8_WAIT_V(0);
    if constexpr (!ALIGN_EPI) { if (wr == 0) PG8_BAR; }
    PG8_BAR;
    if constexpr (Epi::AFTER_DRAIN) { E.fused(acc, cur, wr, wc, fr, fq, lds, wid, lane); S.done(cur); }
#undef PG8_SA
#undef PG8_SB
#undef PG8_STAGE
#undef PG8_LDA
#undef PG8_LDB
#undef PG8_MMA
#undef PG8_WAIT_V
#undef PG8_WAIT_L
#undef PG8_BAR
#undef PG8_SCHED
}
}
namespace att {
typedef short bf16x8 __attribute__((ext_vector_type(8)));
typedef short s16x4 __attribute__((ext_vector_type(4)));
typedef short v4i16_t __attribute__((ext_vector_type(4)));
typedef float f32x16 __attribute__((ext_vector_type(16)));
typedef float f32x4 __attribute__((ext_vector_type(4)));
typedef unsigned u32x4 __attribute__((ext_vector_type(4)));
typedef float f32x2_t __attribute__((ext_vector_type(2))); typedef __bf16 bf16x2_t __attribute__((ext_vector_type(2)));
typedef __attribute__((address_space(3))) unsigned char* lds_ptr;
__device__ __forceinline__ unsigned cvtpk_s(float lo, float hi) { f32x2_t v = {lo, hi}; bf16x2_t b = __builtin_convertvector(v, bf16x2_t); return __builtin_bit_cast(unsigned, b); }
__device__ __forceinline__ int crow(int r, int hi) { return (r & 3) + 8 * (r >> 2) + 4 * hi; }
__device__ __forceinline__ s16x4 vtr(lds_ptr p) { return __builtin_bit_cast(s16x4, __builtin_amdgcn_ds_read_tr16_b64_v4i16((__attribute__((address_space(3))) v4i16_t*)p)); }
#define ATT_WAITV(n) asm volatile("s_waitcnt vmcnt(" #n ")" ::: "memory")
__device__ __forceinline__ void glds16(const void* gsrc, unsigned lds_dst) { unsigned keep;
    asm volatile("s_mov_b32 %0, m0\n\ts_mov_b32 m0, %2\n\ts_nop 0\n\tglobal_load_lds_dwordx4 %1, off\n\ts_mov_b32 m0, %0" : "=&s"(keep) : "v"(gsrc), "s"(lds_dst) : "memory"); }
#define ATT_GLDS(src, dst) glds16((src), (unsigned)__builtin_amdgcn_readfirstlane((int)(dst)))

struct ItemOut {
    unsigned short* po; float* pl;
    const unsigned short* po_a; const unsigned short* po_b; const float* pl_a; const float* pl_b;
    const unsigned short* gate; unsigned short* mix;
    float sinkp;
};
template <int MODE>
__device__ __forceinline__ void attn_item(lds_ptr ring, const unsigned short* Qh, const unsigned short* Kh, const unsigned short* Vh, int dil, int r, int qt, const ItemOut& O, int lane) {
    const int q = lane & 31, hi = lane >> 5;
    const int kt0 = qt >= 4 ? qt - 4 : 0, nt = qt - kt0 + 1;
    const unsigned ring0 = (unsigned)(uintptr_t)ring;
    constexpr int DMIN = (MODE == 0) ? 1 : 0;
    asm volatile("s_waitcnt lgkmcnt(0)" ::: "memory");
    unsigned koff[4], voff[4];
#pragma unroll
    for (int i = 0; i < 4; ++i) {
        const int row = 8 * i + (lane >> 3), chunk = (lane & 7) ^ ((row >> 1) & 7);
        koff[i] = (unsigned)(dil * row) * 128u + (unsigned)chunk * 16u;
        const int vrow = 16 * (i & 1) + (lane >> 2);
        voff[i] = (unsigned)(dil * vrow) * 128u + (unsigned)(i >> 1) * 64u + (unsigned)(lane & 3) * 16u;
    }
    const char* Kb = (const char*)Kh + (size_t)r * 128; const char* Vb = (const char*)Vh + (size_t)r * 128;
    const size_t tstride = (size_t)dil * 32 * 128;
#define ATT_DMA_K(j) do { const char* s_ = Kb + (size_t)(kt0 + (j)) * tstride; const unsigned d_ = ring0 + ((j) & 1) * 8192; \
        ATT_GLDS(s_ + koff[0], d_); ATT_GLDS(s_ + koff[1], d_ + 1024); ATT_GLDS(s_ + koff[2], d_ + 2048); ATT_GLDS(s_ + koff[3], d_ + 3072); } while (0)
#define ATT_DMA_V(j) do { const char* s_ = Vb + (size_t)(kt0 + (j)) * tstride; const unsigned d_ = ring0 + ((j) & 1) * 8192 + 4096; \
        ATT_GLDS(s_ + voff[0], d_); ATT_GLDS(s_ + voff[1], d_ + 1024); ATT_GLDS(s_ + voff[2], d_ + 2048); ATT_GLDS(s_ + voff[3], d_ + 3072); } while (0)
    bf16x8 qr[4];
    { const unsigned short* qrow = Qh + (size_t)(r + dil * (32 * qt + q)) * 64 + hi * 8;
#pragma unroll
      for (int d0 = 0; d0 < 4; ++d0) qr[d0] = *(const bf16x8*)(qrow + d0 * 16); }
    ATT_DMA_K(0); ATT_DMA_V(0);
    asm volatile("" : "+v"(qr[0]), "+v"(qr[1]), "+v"(qr[2]), "+v"(qr[3]));
    if (nt > 1) { ATT_DMA_K(1); ATT_DMA_V(1); }
    const int krow = q * 128, ksw = (q >> 1) & 7;
    const int vb = ((lane >> 4) & 1) * 32 + (lane & 3) * 8 + (4 * hi + ((lane & 15) >> 2)) * 64;
    f32x16 o0 = {}, o1 = {}; float lsum = 0.f;
    for (int j = 0; j < nt; ++j) {
        const int e = nt - 1 - j; lds_ptr slot = ring + (j & 1) * 8192;
        if (e >= 1) ATT_WAITV(12); else ATT_WAITV(4);
        bf16x8 kf[4];
#pragma unroll
        for (int ks = 0; ks < 4; ++ks) kf[ks] = *(const __attribute__((address_space(3))) bf16x8*)(slot + krow + (((2 * ks + hi) ^ ksw) * 16));
        asm volatile("s_waitcnt lgkmcnt(0)" ::: "memory");
        asm volatile("" : "+v"(kf[0]), "+v"(kf[1]), "+v"(kf[2]), "+v"(kf[3]));
        if (e >= 2) ATT_DMA_K(j + 2);
        f32x16 p = {};
#pragma unroll
        for (int ks = 0; ks < 4; ++ks) p = __builtin_amdgcn_mfma_f32_32x32x16_bf16(kf[ks], qr[ks], p, 0, 0, 0);
        const bool first = (kt0 + j == qt - 4), last = (j == nt - 1);
        if (first || last) {
#pragma unroll
            for (int rr = 0; rr < 16; ++rr) { const int kk = crow(rr, hi); const bool bad = (first && kk < q + DMIN) || (last && kk > q); if (bad) p[rr] = -INFINITY; }
        }
        float s = 0.f;
#pragma unroll
        for (int rr = 0; rr < 16; ++rr) { p[rr] = __builtin_amdgcn_exp2f(p[rr]); s += p[rr]; }
        lsum += s;
        u32x4 pw0, pw1;
        pw0[0] = cvtpk_s(p[0], p[1]); pw0[1] = cvtpk_s(p[2], p[3]); pw0[2] = cvtpk_s(p[4], p[5]); pw0[3] = cvtpk_s(p[6], p[7]);
        pw1[0] = cvtpk_s(p[8], p[9]); pw1[1] = cvtpk_s(p[10], p[11]); pw1[2] = cvtpk_s(p[12], p[13]); pw1[3] = cvtpk_s(p[14], p[15]);
        if (e >= 2) ATT_WAITV(12); else if (e == 1) ATT_WAITV(8); else ATT_WAITV(0);
        lds_ptr vp = slot + 4096 + vb;
        s16x4 lo[4], hh[4];
#pragma unroll
        for (int i = 0; i < 4; ++i) { lo[i] = vtr(vp + i * 1024); hh[i] = vtr(vp + i * 1024 + 512); }
#define ATT_VFR(i) (bf16x8){lo[i][0], lo[i][1], lo[i][2], lo[i][3], hh[i][0], hh[i][1], hh[i][2], hh[i][3]}
        o0 = __builtin_amdgcn_mfma_f32_32x32x16_bf16(__builtin_bit_cast(bf16x8, pw0), ATT_VFR(0), o0, 0, 0, 0);
        o0 = __builtin_amdgcn_mfma_f32_32x32x16_bf16(__builtin_bit_cast(bf16x8, pw1), ATT_VFR(1), o0, 0, 0, 0);
        o1 = __builtin_amdgcn_mfma_f32_32x32x16_bf16(__builtin_bit_cast(bf16x8, pw0), ATT_VFR(2), o1, 0, 0, 0);
        o1 = __builtin_amdgcn_mfma_f32_32x32x16_bf16(__builtin_bit_cast(bf16x8, pw1), ATT_VFR(3), o1, 0, 0, 0);
#undef ATT_VFR
        if (e >= 2) { asm volatile("s_waitcnt lgkmcnt(0)" ::: "memory"); ATT_DMA_V(j + 2); }
    }
#undef ATT_DMA_K
#undef ATT_DMA_V
    { auto rr = __builtin_amdgcn_permlane32_swap(__float_as_uint(lsum), __float_as_uint(lsum), false, false); lsum = __uint_as_float(rr[0]) + __uint_as_float(rr[1]); }
    __attribute__((address_space(3))) float* so = (__attribute__((address_space(3))) float*)ring;
    __attribute__((address_space(3))) float* sl = (__attribute__((address_space(3))) float*)(ring + 8192);
    asm volatile("s_waitcnt vmcnt(0) lgkmcnt(0)" ::: "memory");
#pragma unroll
    for (int rr = 0; rr < 16; ++rr) { const int row = crow(rr, hi); so[row * 64 + q] = o0[rr]; so[row * 64 + 32 + q] = o1[rr]; }
    if (hi == 0) sl[q] = lsum;
    asm volatile("s_waitcnt lgkmcnt(0)" ::: "memory");
#pragma unroll
    for (int i = 0; i < 4; ++i) {
        const int row = 8 * i + (lane >> 3), ch = lane & 7;
        const f32x4 a = *(const __attribute__((address_space(3))) f32x4*)(so + row * 64 + ch * 8), b = *(const __attribute__((address_space(3))) f32x4*)(so + row * 64 + ch * 8 + 4);
        float l = sl[row];
        const size_t t = (size_t)(r + dil * (32 * qt + row));
        if (MODE == 1) {
            u32x4 w; w[0] = cvtpk_s(a[0], a[1]); w[1] = cvtpk_s(a[2], a[3]); w[2] = cvtpk_s(b[0], b[1]); w[3] = cvtpk_s(b[2], b[3]);
            *(u32x4*)(O.po + t * 64 + ch * 8) = w;
            if (ch == 0) O.pl[t] = l;
        } else {
            f32x4 va = a, vb2 = b;
            if (MODE == 2) {
                const u32x4 pa = __builtin_nontemporal_load((const u32x4*)(O.po_a + t * 64 + ch * 8)), pb = __builtin_nontemporal_load((const u32x4*)(O.po_b + t * 64 + ch * 8));
                l += __builtin_nontemporal_load(O.pl_a + t) + __builtin_nontemporal_load(O.pl_b + t);
#pragma unroll
                for (int k = 0; k < 4; ++k) {
                    const float x0 = __uint_as_float(pa[k] << 16) + __uint_as_float(pb[k] << 16), x1 = __uint_as_float(pa[k] & 0xffff0000u) + __uint_as_float(pb[k] & 0xffff0000u);
                    if (k < 2) { va[2 * k] += x0; va[2 * k + 1] += x1; } else { vb2[2 * (k - 2)] += x0; vb2[2 * (k - 2) + 1] += x1; }
                }
            } else l += O.sinkp;
            const float rl = 1.0f / l;
            const u32x4 gw = *(const u32x4*)(O.gate + t * 512 + ch * 8);
            float g[8];
#pragma unroll
            for (int k = 0; k < 4; ++k) { g[2 * k] = __uint_as_float(gw[k] << 16); g[2 * k + 1] = __uint_as_float(gw[k] & 0xffff0000u); }
            u32x4 w;
            w[0] = cvtpk_s(va[0] * rl * g[0], va[1] * rl * g[1]); w[1] = cvtpk_s(va[2] * rl * g[2], va[3] * rl * g[3]);
            w[2] = cvtpk_s(vb2[0] * rl * g[4], vb2[1] * rl * g[5]); w[3] = cvtpk_s(vb2[2] * rl * g[6], vb2[3] * rl * g[7]);
            *(u32x4*)(O.mix + t * 1024 + ch * 8) = w;
        }
    }
}
#undef ATT_WAITV
#undef ATT_GLDS
}
#ifndef PG8_SP2
#define PG8_SP2 true
#endif
#ifndef PG8_ALIGN
#define PG8_ALIGN true
#endif
constexpr int NWAVES = 8;
constexpr int BATCH = 8, SEQ = 4096, DM = 1024, M = BATCH * SEQ, NIN = 3328, HD = 64;
constexpr float LOG2E = 1.4426950408889634f;
constexpr size_t MiB = 1u << 20;
constexpr size_t WS_CTL = 0, CTL_ZERO_BYTES = 64 * 1024;
constexpr size_t WS_COS = 1 * MiB, WS_SIN = WS_COS + 512 * 1024;
constexpr size_t WS_WIT = 2 * MiB, WS_WOT = 9 * MiB;
constexpr size_t WS_XN = 16 * MiB;
constexpr size_t WS_QA = 80 * MiB, WS_QB = 112 * MiB, WS_KA = 144 * MiB, WS_VA = 152 * MiB, WS_KB = 160 * MiB, WS_VB = 192 * MiB;
constexpr size_t WS_GA = 224 * MiB, WS_GB = 256 * MiB, WS_MIX = 288 * MiB, WS_PO16 = 352 * MiB, WS_PO4 = 384 * MiB, WS_PL16 = 416 * MiB, WS_PL4 = 417 * MiB, WS_END = 418 * MiB;
constexpr int CW_BAR = 1024;
constexpr int RING_OFF = 0, RING_BYTES = 131072;
constexpr int LDSCTL_OFF = RING_BYTES, MISC_OFF = LDSCTL_OFF + 320;
constexpr int LDS_BYTES = 147456;
static_assert(MISC_OFF + 128 <= LDS_BYTES, "LDS map");
#define GAS __attribute__((address_space(1)))
#define LAS __attribute__((address_space(3)))
typedef unsigned short bf16;
typedef unsigned v4u __attribute__((ext_vector_type(4)));
typedef float f32x4 __attribute__((ext_vector_type(4)));
typedef short bf16x8 __attribute__((ext_vector_type(8)));
typedef GAS unsigned gu32;
typedef GAS unsigned long long gu64;
#define RLX_AGENT __ATOMIC_RELAXED, __HIP_MEMORY_SCOPE_AGENT
#define LDS_WAIT() asm volatile("s_waitcnt lgkmcnt(0)" ::: "memory")
#define VM_WAIT() asm volatile("s_waitcnt vmcnt(0)" ::: "memory")
__device__ __forceinline__ unsigned long long rt() { return __builtin_amdgcn_s_memrealtime(); }
__device__ __forceinline__ unsigned f2bf(float f) { unsigned u = __builtin_bit_cast(unsigned, f); return (u + 0x7fffu + ((u >> 16) & 1u)) >> 16; }
__device__ __forceinline__ unsigned pk2(float lo, float hi) { return f2bf(lo) | (f2bf(hi) << 16); }

#define XB_TMO      128
#define XB_XCNT(j)  (256  + 64 * (j))
#define XB_XSUB(j)  (1280 + 64 * (j))
#define XB_XGEN(j)  (2304 + 64 * (j))
#define XB_TOP      3328
#define XB_TOPGEN   3392
#define XCD_BAR_WORDS 3456
#define XB_SPIN_CAP (1u << 18)

__device__ __forceinline__ unsigned xb_ld(unsigned* p)              { return __hip_atomic_load(p, __ATOMIC_RELAXED, __HIP_MEMORY_SCOPE_AGENT); }
__device__ __forceinline__ unsigned xb_add(unsigned* p, unsigned v) { return __hip_atomic_fetch_add(p, v, __ATOMIC_RELAXED, __HIP_MEMORY_SCOPE_AGENT); }
__device__ __forceinline__ unsigned xb_xcc_id() { return (unsigned)__builtin_amdgcn_s_getreg((3 << 11) | 20) & 0xFu; }
#define XB_SPIN(cond, bar) do { unsigned _sp = 0; while (cond) { __builtin_amdgcn_s_sleep(1); \
    if ((++_sp & 255u) == 0u) { if (xb_ld(&(bar)[XB_TMO])) break; if (_sp > XB_SPIN_CAP) { atomicAdd(&(bar)[XB_TMO], 1u); break; } } } } while (0)

struct XcdBarrier {
    unsigned* bar; unsigned x;
    volatile LAS unsigned* st;
};

__device__ __forceinline__ XcdBarrier xcd_barrier_post(unsigned* bar, volatile LAS unsigned* st) {
    XcdBarrier b; b.bar = bar; b.x = xb_xcc_id(); b.st = st;
    if (threadIdx.x == 0) (void)xb_add(&bar[XB_XCNT(b.x)], 1u);
    return b;
}
__device__ __forceinline__ void xcd_barrier_complete(unsigned* bar, unsigned x, unsigned& nloc, unsigned& nx) {
    const unsigned G = gridDim.x * gridDim.y * gridDim.z;
    unsigned sum, cnt, mine, sp = 0u;
    for (;;) {
        sum = 0u; cnt = 0u; mine = 0u;
#pragma unroll
        for (unsigned j = 0; j < 16; ++j) { const unsigned c = xb_ld(&bar[XB_XCNT(j)]); sum += c; cnt += (c > 0u) ? 1u : 0u; mine = (j == x) ? c : mine; }
        if (sum == G) break;
        __builtin_amdgcn_s_sleep(1);
        if ((++sp & 255u) == 0u) { if (xb_ld(&bar[XB_TMO])) break; if (sp > XB_SPIN_CAP) { atomicAdd(&bar[XB_TMO], 1u); break; } }
    }
    nloc = mine > 0u ? mine : 1u; nx = cnt > 0u ? cnt : 1u;
}

__device__ __forceinline__ void xcd_barrier(const XcdBarrier& b) {
    asm volatile("s_waitcnt vmcnt(0)" ::: "memory");
    __syncthreads();
    if (threadIdx.x == 0) {
        unsigned* bar = b.bar;
        __builtin_amdgcn_s_waitcnt(0);
        unsigned nloc = b.st[0], nx = b.st[1];
        if (nloc == 0u) { xcd_barrier_complete(bar, b.x, nloc, nx); b.st[0] = nloc; b.st[1] = nx; }
        const unsigned old = xb_add(&bar[XB_XSUB(b.x)], 1u);
        const unsigned gen = old / nloc;
        if (old + 1u == (gen + 1u) * nloc) {
            __builtin_amdgcn_fence(__ATOMIC_RELEASE, "agent");
            asm volatile("s_waitcnt vmcnt(0)" ::: "memory");
            const unsigned og = xb_add(&bar[XB_TOP], 1u);
            const unsigned tg = og / nx;
            if (og + 1u == (tg + 1u) * nx) xb_add(&bar[XB_TOPGEN], 1u);
            else XB_SPIN(xb_ld(&bar[XB_TOPGEN]) == tg, bar);
            __builtin_amdgcn_fence(__ATOMIC_ACQUIRE, "agent");
            xb_add(&bar[XB_XGEN(b.x)], 1u);
            asm volatile("s_waitcnt vmcnt(0)" ::: "memory");
        } else {
            XB_SPIN(xb_ld(&bar[XB_XGEN(b.x)]) == gen, bar);
            __builtin_amdgcn_fence(__ATOMIC_ACQUIRE, "agent");
            asm volatile("s_waitcnt vmcnt(0)" ::: "memory");
        }
    }
    __syncthreads();
}
static_assert((CW_BAR + XCD_BAR_WORDS) * 4 <= (int)CTL_ZERO_BYTES, "barrier words inside the memset region");

struct Frame {
    LAS unsigned char* lds;
    volatile LAS unsigned* MISC;
    gu32* ctl;
    int tid, lane, wave;
    int vcu, G;
};
__device__ __forceinline__ float bf2f(bf16 b) { return __uint_as_float(((unsigned)b) << 16); }
__device__ __forceinline__ float wave_sum(float v) {
#pragma unroll
    for (int o = 1; o < 64; o <<= 1) v += __shfl_xor(v, o);
    return v;
}
__device__ __forceinline__ void sincos_d(float ang, float& s, float& c) {
    const double a = (double)ang;
    const double k = rint(a * 0.6366197723675814);
    double y = fma(-k, 1.5707963267948966, a);
    y = fma(-k, 6.123233995736766e-17, y);
    const double y2 = y * y;
    const double sp = y * (1.0 + y2 * (-1.0 / 6 + y2 * (1.0 / 120 + y2 * (-1.0 / 5040 + y2 * (1.0 / 362880 + y2 * (-1.0 / 39916800 + y2 * (1.0 / 6227020800.0)))))));
    const double cp = 1.0 + y2 * (-0.5 + y2 * (1.0 / 24 + y2 * (-1.0 / 720 + y2 * (1.0 / 40320 + y2 * (-1.0 / 3628800 + y2 * (1.0 / 479001600.0 + y2 * (-1.0 / 87178291200.0)))))));
    const int q = ((int)(long long)k) & 3;
    const double ss = (q == 0) ? sp : (q == 1) ? cp : (q == 2) ? -sp : -cp;
    const double cc = (q == 0) ? cp : (q == 1) ? -sp : (q == 2) ? -cp : sp;
    s = (float)ss; c = (float)cc;
}
__device__ __forceinline__ void p0_transpose_item(const float* W, int K, int N, bf16* WT, int k0, int n0, int d0, LAS float* scr, int lane) {
#pragma unroll 8
    for (int i = 0; i < 32; ++i) { const int kk = 2 * i + (lane >> 5); scr[kk * 33 + (lane & 31)] = W[(size_t)(k0 + kk) * N + n0 + (lane & 31)]; }
    LDS_WAIT(); asm volatile("" ::: "memory");
    const int c = lane & 7;
#pragma unroll
    for (int j = 0; j < 4; ++j) { const int n = (lane >> 3) + 8 * j; const LAS float* s = scr + (8 * c) * 33 + n;
        v4u o; o.x = pk2(s[0 * 33], s[1 * 33]); o.y = pk2(s[2 * 33], s[3 * 33]); o.z = pk2(s[4 * 33], s[5 * 33]); o.w = pk2(s[6 * 33], s[7 * 33]);
        *(GAS v4u*)(WT + (size_t)(d0 + n) * K + k0 + 8 * c) = o; }
    LDS_WAIT(); asm volatile("" ::: "memory");
}
struct Ptrs {
    const float *x, *gain, *w_in, *qna, *kna, *sinks, *qnb, *knb, *w_out; float* out;
    bf16 *WIT, *WOT, *XN, *QA, *KA, *VA, *GA, *QB, *KB, *VB, *GB, *MIX, *PO16, *PO4; float *cosT, *sinT, *PL16, *PL4;
};
__device__ __forceinline__ void p0_prologue(Frame& F, const Ptrs& P) {
    LAS float* scr = (LAS float*)(F.lds + RING_OFF + F.wave * 16384);
    const int gw = F.vcu * NWAVES + F.wave, NGW = F.G * NWAVES;
    constexpr int I_IN = (DM / 64) * (NIN / 32), I_OUT = (DM / 64) * (DM / 32);
    for (int it = gw; it < I_IN + I_OUT; it += NGW) {
        if (it < I_IN) { const int nblk = NIN / 32, kb = it / nblk, nb = it % nblk, n0 = 32 * nb;
            const int pn = n0 >> 8, rem = n0 & 255, wc = rem >> 6, bjj = (rem >> 5) & 1;
            p0_transpose_item(P.w_in, DM, NIN, P.WIT, 64 * kb, n0, 256 * pn + 128 * bjj + 32 * wc, scr, F.lane); }
        else { const int r = it - I_IN, nblk = DM / 32, kb = r / nblk, nb = r % nblk; p0_transpose_item(P.w_out, DM, DM, P.WOT, 64 * kb, 32 * nb, 32 * nb, scr, F.lane); }
    }
    for (int e = (F.vcu * NWAVES * 64) + F.tid; e < SEQ * 32; e += F.G * NWAVES * 64) {
        const int t = e >> 5, i = e & 31;
        double r = 1.0; for (int k = 0; k < i; ++k) r *= 0.7498942093324558;
        const float inv = (float)r; const float ang = (float)t * inv;
        float s, c; sincos_d(ang, s, c); P.cosT[e] = c; P.sinT[e] = s;
    }
    for (int m = gw; m < M; m += NGW) {
        const GAS f32x4* xr = (const GAS f32x4*)(P.x + (size_t)m * DM) + F.lane;
        f32x4 v[4]; float ss = 0.f;
#pragma unroll
        for (int j = 0; j < 4; ++j) { v[j] = xr[64 * j]; ss += (v[j].x * v[j].x + v[j].y * v[j].y) + (v[j].z * v[j].z + v[j].w * v[j].w); }
        const float rstd = rsqrtf(wave_sum(ss) * (1.f / DM) + 1e-6f);
        GAS unsigned long long* o8 = (GAS unsigned long long*)(P.XN + (size_t)m * DM) + F.lane;
#pragma unroll
        for (int j = 0; j < 4; ++j) { const f32x4 g = ((const GAS f32x4*)P.gain)[64 * j + F.lane];
            o8[64 * j] = (unsigned long long)pk2(v[j].x * rstd * g.x, v[j].y * rstd * g.y) | ((unsigned long long)pk2(v[j].z * rstd * g.z, v[j].w * rstd * g.w) << 32); }
    }
}
__device__ __forceinline__ void p2_attention(Frame& F, const Ptrs& P) {
    att::lds_ptr ring = (att::lds_ptr)(F.lds + RING_OFF + F.wave * 16384);
    const int lane = F.lane, wave = F.wave;
    const int NBU = BATCH * 8 * 8;
    const int upc = (NBU + F.G - 1) / F.G;
    for (int u = 0; u < upc; ++u) {
        const int uid = F.vcu * upc + u; if (uid >= NBU) break;
        const int b = uid >> 6, h = (uid >> 3) & 7, blk = uid & 7; const size_t hb = (size_t)(b * 8 + h) * SEQ;
        for (int k = 0; k < 4; ++k) {
            const int it = __builtin_amdgcn_readfirstlane(wave * 4 + k);
            att::ItemOut O{};
            if (it < 16) { O.po = P.PO16 + hb * 64; O.pl = P.PL16 + hb; att::attn_item<1>(ring, P.QB + hb * 64, P.KB + hb * 64, P.VB + hb * 64, 16, it, blk, O, lane); }
            else { const int j = it - 16; O.po = P.PO4 + hb * 64; O.pl = P.PL4 + hb; att::attn_item<1>(ring, P.QB + hb * 64, P.KB + hb * 64, P.VB + hb * 64, 4, j & 3, 4 * blk + (j >> 2), O, lane); }
        }
    }
    asm volatile("s_waitcnt vmcnt(0) lgkmcnt(0)\n\ts_barrier" ::: "memory");
    for (int u = 0; u < upc; ++u) {
        const int uid = F.vcu * upc + u; if (uid >= NBU) break;
        const int b = uid >> 6, h = (uid >> 3) & 7, blk = uid & 7; const size_t hb = (size_t)(b * 8 + h) * SEQ;
        for (int k = 0; k < 2; ++k) {
            const int a = __builtin_amdgcn_readfirstlane(wave * 2 + k);
            att::ItemOut O{};
            O.po_a = P.PO16 + hb * 64; O.po_b = P.PO4 + hb * 64; O.pl_a = P.PL16 + hb; O.pl_b = P.PL4 + hb;
            O.gate = P.GB + (size_t)b * SEQ * 512 + h * 64; O.mix = P.MIX + (size_t)b * SEQ * DM + 512 + h * 64;
            att::attn_item<2>(ring, P.QB + hb * 64, P.KB + hb * 64, P.VB + hb * 64, 1, 0, 16 * blk + a, O, lane);
        }
    }
    const int NAI = BATCH * 8 * 128, ipc = (NAI + F.G - 1) / F.G, ipw = (ipc + NWAVES - 1) / NWAVES;
    for (int k = 0; k < ipw; ++k) {
        const int li = wave * ipw + k; if (li >= ipc) break;
        const int aid = __builtin_amdgcn_readfirstlane(F.vcu * ipc + li); if (aid >= NAI) break;
        const int b = aid >> 10, h = (aid >> 7) & 7, qt = aid & 127, kv = h >> 2;
        att::ItemOut O{};
        O.gate = P.GA + (size_t)b * SEQ * 512 + h * 64; O.mix = P.MIX + (size_t)b * SEQ * DM + h * 64; O.sinkp = __builtin_amdgcn_exp2f(P.sinks[h] * LOG2E);
        att::attn_item<0>(ring, P.QA + (size_t)(b * 8 + h) * SEQ * 64, P.KA + (size_t)(b * 2 + kv) * SEQ * 64, P.VA + (size_t)(b * 2 + kv) * SEQ * 64, 1, 0, qt, O, lane);
    }
}

struct Args { const float* in[9]; float* out; unsigned char* ws; };
__global__ void __launch_bounds__(NWAVES * 64, 2) mega_fwd(Args args) {
    extern __shared__ __attribute__((aligned(16))) unsigned char lds[];
    Frame F;
    F.lds = (LAS unsigned char*)lds;
    F.MISC = (volatile LAS unsigned*)(F.lds + MISC_OFF);
    F.tid = threadIdx.x; F.lane = F.tid & 63; F.wave = __builtin_amdgcn_readfirstlane(F.tid >> 6);
    F.G = gridDim.x; { const int bx = blockIdx.x; F.vcu = (F.G % 8 == 0) ? (bx % 8) * (F.G / 8) + bx / 8 : bx; }
    unsigned char* ws = args.ws;
    F.ctl = (gu32*)(ws + WS_CTL);
    Ptrs P;
    P.x = args.in[0]; P.gain = args.in[1]; P.w_in = args.in[2]; P.qna = args.in[3]; P.kna = args.in[4]; P.sinks = args.in[5]; P.qnb = args.in[6]; P.knb = args.in[7]; P.w_out = args.in[8]; P.out = args.out;
    P.WIT = (bf16*)(ws + WS_WIT); P.WOT = (bf16*)(ws + WS_WOT); P.XN = (bf16*)(ws + WS_XN);
    P.QA = (bf16*)(ws + WS_QA); P.KA = (bf16*)(ws + WS_KA); P.VA = (bf16*)(ws + WS_VA); P.GA = (bf16*)(ws + WS_GA);
    P.QB = (bf16*)(ws + WS_QB); P.KB = (bf16*)(ws + WS_KB); P.VB = (bf16*)(ws + WS_VB); P.GB = (bf16*)(ws + WS_GB); P.MIX = (bf16*)(ws + WS_MIX);
    P.cosT = (float*)(ws + WS_COS); P.sinT = (float*)(ws + WS_SIN);
    P.PO16 = (bf16*)(ws + WS_PO16); P.PO4 = (bf16*)(ws + WS_PO4); P.PL16 = (float*)(ws + WS_PL16); P.PL4 = (float*)(ws + WS_PL4);
    for (int u = F.tid; u < (LDS_BYTES - LDSCTL_OFF) / 4; u += NWAVES * 64) ((LAS unsigned*)(F.lds + LDSCTL_OFF))[u] = 0u;
    __syncthreads();
    XcdBarrier bar = xcd_barrier_post((unsigned*)(F.ctl + CW_BAR), F.MISC + 8);

    p0_prologue(F, P);
    xcd_barrier(bar);
    {
        pg8::Gemm g{P.XN, P.WIT, M, NIN, DM}; pg8::StaticOrder S; S.init(M, NIN, F.G, (int)blockIdx.x);
        pg8::EpiIn E{P.QA, P.KA, P.VA, P.GA, P.QB, P.KB, P.VB, P.GB, P.qna, P.kna, P.qnb, P.knb, P.cosT, P.sinT};
        pg8::gemm_phase<pg8::EpiIn, pg8::StaticOrder, PG8_ALIGN, PG8_SP2>(F.lds + RING_OFF, g, S, E);
    }
    xcd_barrier(bar);
    p2_attention(F, P);
    xcd_barrier(bar);
    {
        pg8::Gemm g{P.MIX, P.WOT, M, DM, DM}; pg8::StaticOrder S; S.init(M, DM, F.G, (int)blockIdx.x);
        pg8::EpiRes E{P.x, P.out};
        pg8::gemm_phase<pg8::EpiRes, pg8::StaticOrder, PG8_ALIGN, PG8_SP2>(F.lds + RING_OFF, g, S, E);
    }
}

extern "C" void kernel_launch(void* const* d_in, const int* in_sizes, int n_in, void* d_out, int out_size, void* d_ws, size_t ws_size, hipStream_t stream) {
    static int grid = 0;
    if (grid == 0) {
        if (n_in != 9 || out_size != M * DM || ws_size < WS_END) { fprintf(stderr, "kernel_launch: unexpected shapes (n_in %d, out %d, ws %zu); nothing launched\n", n_in, out_size, ws_size); grid = -1; return; }
        int dev = 0, cus = 0;
        if (hipGetDevice(&dev) != hipSuccess || hipDeviceGetAttribute(&cus, hipDeviceAttributeMultiprocessorCount, dev) != hipSuccess) { grid = -1; return; }
        if (hipFuncSetAttribute((const void*)mega_fwd, hipFuncAttributeMaxDynamicSharedMemorySize, LDS_BYTES) != hipSuccess) { fprintf(stderr, "kernel_launch: hipFuncSetAttribute failed\n"); grid = -1; return; }
        (void)hipGetLastError();
        grid = cus;
    }
    if (grid < 0) return;
    if (hipMemsetAsync((char*)d_ws + WS_CTL, 0, CTL_ZERO_BYTES, stream) != hipSuccess) { fprintf(stderr, "kernel_launch: hipMemsetAsync failed\n"); return; }
    Args a{};
    for (int i = 0; i < 9; ++i) a.in[i] = (const float*)d_in[i];
    a.out = (float*)d_out; a.ws = (unsigned char*)d_ws;
    hipLaunchKernelGGL(mega_fwd, dim3(grid), dim3(NWAVES * 64), LDS_BYTES, stream, a);
}
```

```cpp
#include <hip/hip_runtime.h>
#include <cstdio>
#include <cstdint>
#include <cmath>
#define KSWZ 1
namespace pg8 {
#define PG8_LAS __attribute__((address_space(3)))
typedef unsigned short bf16_t;
typedef short bf16x8 __attribute__((ext_vector_type(8)));
typedef float f32x4 __attribute__((ext_vector_type(4)));
typedef unsigned u32x4 __attribute__((ext_vector_type(4)));
constexpr int BM = 256, BK = 64, HALF = 128, HTB = HALF * BK * 2  , STAGE_BYTES = 8 * HTB, NXCD = 8, WGM = 8;

__host__ __device__ __forceinline__ int lds_byte(int r, int c) { const int st = (r >> 4) * 2 + (c >> 5), rr = r & 15, cc = c & 31, ob = rr * 64 + cc * 2; return st * 1024 + (ob ^ (((ob >> 9) & 1) << 5)); }
__host__ __device__ __forceinline__ void stage_rc(int b, int& R, int& C) { const int st = b / 1024, sb = b % 1024, swz = sb ^ (((sb >> 9) & 1) << 5); R = (st >> 1) * 16 + swz / 64; C = (st & 1) * 32 + (swz % 64) / 2; }
__host__ __device__ __forceinline__ int perm32(int rho) { const int n = rho >> 4, i = rho & 15; return 8 * (i >> 2) + 4 * n + (i & 3); }

struct Unit { int pm, pn; };
struct Gemm { const bf16_t* A; const bf16_t* Bt; int M, N, K; };

struct StaticOrder {
    int nM, nN, nwg, G, c;
    __host__ __device__ void init(int M, int N, int G_, int c_) { nM = M / BM; nN = N / BM; nwg = nM * nN; G = G_; c = c_; }
    __host__ __device__ bool next(int i, Unit& u) const {
        const long L = (long)i * G + c; if (L >= nwg) return false;
        int wgid = (int)L; { const int q = nwg / NXCD, r = nwg % NXCD, xcd = wgid % NXCD, off = wgid / NXCD; wgid = (xcd < r ? xcd * (q + 1) : r * (q + 1) + (xcd - r) * q) + off; }
        const int nig = WGM * nN, gid = wgid / nig, fm = gid * WGM, gsz = (nM - fm) < WGM ? (nM - fm) : WGM;
        u.pm = fm + ((wgid % nig) % gsz); u.pn = (wgid % nig) / gsz; return true;
    }
    __device__ __forceinline__ void a_ready(const Unit&) const {}
    __device__ __forceinline__ void done(const Unit&) const {}
};

__device__ __forceinline__ unsigned cvt_pk_bf16(float lo, float hi) { unsigned r; asm volatile("v_cvt_pk_bf16_f32 %0, %1, %2" : "=v"(r) : "v"(lo), "v"(hi)); return r; }
typedef float f32x2 __attribute__((ext_vector_type(2)));
typedef float f32x2 __attribute__((ext_vector_type(2)));
constexpr int SEQ_ = 4096;
constexpr float C2_ = 0.18033688011112042f, LOG2E_ = 1.4426950408889634f;
__device__ __forceinline__ u32x4 pack8(const f32x4& a, const f32x4& b) { u32x4 w; w.x = cvt_pk_bf16(a[0], a[1]); w.y = cvt_pk_bf16(a[2], a[3]); w.z = cvt_pk_bf16(b[0], b[1]); w.w = cvt_pk_bf16(b[2], b[3]); return w; }
struct EpiIn {
    static constexpr bool PERM = true, AFTER_DRAIN = false;
    bf16_t *QA, *KA, *VA, *GA, *QB, *KB, *VB, *GB;
    const float *qna, *kna, *qnb, *knb, *cosT, *sinT;
    __device__ __forceinline__ void init(f32x4 (&acc)[2][2][4][2], const Unit&, int, int, int, int) const {
#pragma unroll
        for (int a = 0; a < 2; ++a)
#pragma unroll
            for (int b = 0; b < 2; ++b)
#pragma unroll
                for (int m = 0; m < 4; ++m)
#pragma unroll
                    for (int n = 0; n < 2; ++n) acc[a][b][m][n] = (f32x4){0.f, 0.f, 0.f, 0.f};
    }
    __device__ __forceinline__ void operator()(const f32x4 (&acc)[2][2][4][2], const Unit& u, int wr, int wc, int fr, int fq) const {
        const int g = u.pn * 4 + wc;
        int type, head, H = 8; const float* ng = qna; bf16_t* dst; float scale = 1.f;
        if (g < 8) { type = 0; head = g; ng = qna; dst = QA; scale = C2_; }
        else if (g < 10) { type = 0; head = g - 8; ng = kna; dst = KA; H = 2; }
        else if (g < 12) { type = 1; head = g - 10; dst = VA; H = 2; }
        else if (g < 20) { type = 2; head = g - 12; dst = GA; }
        else if (g < 28) { type = 0; head = g - 20; ng = qnb; dst = QB; scale = C2_; }
        else if (g < 36) { type = 0; head = g - 28; ng = knb; dst = KB; }
        else if (g < 44) { type = 1; head = g - 36; dst = VB; }
        else { type = 2; head = g - 44; dst = GB; }
        const int row0 = u.pm * BM + wr * 64 + fr;
        if (type == 0) {
            f32x4 gv[2][2];
#pragma unroll
            for (int bj = 0; bj < 2; ++bj)
#pragma unroll
                for (int n = 0; n < 2; ++n) gv[bj][n] = *(const f32x4*)(ng + 32 * bj + 8 * fq + 4 * n);
#pragma unroll
            for (int ai = 0; ai < 2; ++ai)
#pragma unroll
                for (int m = 0; m < 4; ++m) {
                    const int row = row0 + ai * HALF + m * 16, b = row >> 12, t = row & (SEQ_ - 1);
                    float ss = 0.f;
#pragma unroll
                    for (int bj = 0; bj < 2; ++bj)
#pragma unroll
                        for (int n = 0; n < 2; ++n) { const f32x4 x = acc[ai][bj][m][n]; ss += (x[0] * x[0] + x[1] * x[1]) + (x[2] * x[2] + x[3] * x[3]); }
                    ss += __shfl_xor(ss, 16); ss += __shfl_xor(ss, 32);
                    const float rs = rsqrtf(ss * (1.f / 64.f) + 1e-6f);
                    f32x4 o1[2], o2[2];
#pragma unroll
                    for (int n = 0; n < 2; ++n) {
                        const f32x4 cs = *(const f32x4*)(cosT + t * 32 + 8 * fq + 4 * n), sn = *(const f32x4*)(sinT + t * 32 + 8 * fq + 4 * n);
                        const f32x4 n1 = acc[ai][0][m][n] * rs * gv[0][n], n2 = acc[ai][1][m][n] * rs * gv[1][n];
                        o1[n] = (n1 * cs - n2 * sn) * scale; o2[n] = (n2 * cs + n1 * sn) * scale;
                    }
                    bf16_t* p = dst + ((size_t)(b * H + head) * SEQ_ + t) * 64 + 8 * fq;
                    *(u32x4*)p = pack8(o1[0], o1[1]); *(u32x4*)(p + 32) = pack8(o2[0], o2[1]);
                }
        } else if (type == 1) {
#pragma unroll
            for (int ai = 0; ai < 2; ++ai)
#pragma unroll
                for (int m = 0; m < 4; ++m) {
                    const int row = row0 + ai * HALF + m * 16, b = row >> 12, t = row & (SEQ_ - 1);
                    bf16_t* p = dst + ((size_t)(b * H + head) * SEQ_ + t) * 64 + 8 * fq;
                    *(u32x4*)p = pack8(acc[ai][0][m][0], acc[ai][0][m][1]); *(u32x4*)(p + 32) = pack8(acc[ai][1][m][0], acc[ai][1][m][1]);
                }
        } else {
#pragma unroll
            for (int ai = 0; ai < 2; ++ai)
#pragma unroll
                for (int m = 0; m < 4; ++m) {
                    const int row = row0 + ai * HALF + m * 16;
                    bf16_t* p = dst + (size_t)row * 512 + head * 64 + 8 * fq;
#pragma unroll
                    for (int bj = 0; bj < 2; ++bj) {
                        f32x4 s[2];
#pragma unroll
                        for (int n = 0; n < 2; ++n) { const f32x4 v = acc[ai][bj][m][n];
#pragma unroll
                            for (int e = 0; e < 4; ++e) s[n][e] = v[e] * __builtin_amdgcn_rcpf(1.f + __builtin_amdgcn_exp2f(-v[e] * LOG2E_)); }
                        *(u32x4*)(p + 32 * bj) = pack8(s[0], s[1]);
                    }
                }
        }
    }
};
struct EpiRes {
    static constexpr bool PERM = true, AFTER_DRAIN = false;
    const float* x; float* out;
    __device__ __forceinline__ void init(f32x4 (&acc)[2][2][4][2], const Unit&, int, int, int, int) const {
#pragma unroll
        for (int a = 0; a < 2; ++a)
#pragma unroll
            for (int b = 0; b < 2; ++b)
#pragma unroll
                for (int m = 0; m < 4; ++m)
#pragma unroll
                    for (int n = 0; n < 2; ++n) acc[a][b][m][n] = (f32x4){0.f, 0.f, 0.f, 0.f};
    }
    __device__ __forceinline__ void operator()(const f32x4 (&acc)[2][2][4][2], const Unit& u, int wr, int wc, int fr, int fq) const {
        const int row0 = u.pm * BM + wr * 64 + fr, col0 = u.pn * BM + wc * 32 + 8 * fq;
#pragma unroll
        for (int ai = 0; ai < 2; ++ai)
#pragma unroll
            for (int m = 0; m < 4; ++m) {
                const size_t off = (size_t)(row0 + ai * HALF + m * 16) * 1024 + col0;
#pragma unroll
                for (int bj = 0; bj < 2; ++bj) {
                    const f32x4 a = *(const f32x4*)(x + off + bj * HALF), b = *(const f32x4*)(x + off + bj * HALF + 4);
                    *(f32x4*)(out + off + bj * HALF) = a + acc[ai][bj][m][0]; *(f32x4*)(out + off + bj * HALF + 4) = b + acc[ai][bj][m][1];
                }
            }
    }
};
template <class Epi, class Sched, bool ALIGN_EPI = false, bool SP2 = false>
__device__ __forceinline__ void gemm_phase(PG8_LAS unsigned char* lds, const Gemm g, const Sched& S, const Epi& E) {
    int tid_ = threadIdx.x; asm volatile("" : "+v"(tid_));
    const int tid = tid_, wid = __builtin_amdgcn_readfirstlane(tid >> 6), lane = tid & 63, wr = wid >> 2, wc = wid & 3, fr = lane & 15, fq = lane >> 4;
    const int K = g.K, nt = K / BK;
    unsigned voffA[2], voffB[2];
#pragma unroll
    for (int i = 0; i < 2; ++i) { int R, C; stage_rc(tid * 16 + i * 8192, R, C); const int Rb = Epi::PERM ? ((R & ~31) + perm32(R & 31)) : R;
        voffA[i] = (unsigned)(R * K + C) * 2u; voffB[i] = (unsigned)(Rb * K + C) * 2u; }
    const size_t kstep = (size_t)(BK * 2);
    const size_t hstep = (size_t)HALF * K * 2;
    const size_t tstep = 2 * hstep;
    const unsigned ldsw = (unsigned)wid * 1024u;
    const int aoff = lds_byte(wr * 64 + fr, fq * 8), boff = lds_byte(wc * 32 + fr, fq * 8);
#define PG8_SA(b, h) (((b) * 2 + (h)) * HTB)
#define PG8_SB(b, h) ((4 + (b) * 2 + (h)) * HTB)
#define PG8_STAGE(bufoff, gbase, voff) do { _Pragma("unroll") for (int _i = 0; _i < 2; ++_i) \
        __builtin_amdgcn_global_load_lds((const unsigned*)((const char*)(gbase) + (voff)[_i]), (PG8_LAS unsigned*)(lds + (bufoff) + ldsw + _i * 8192), 16, 0, 0); } while (0)
#define PG8_LDA(dst, b, h) do { _Pragma("unroll") for (int m = 0; m < 4; ++m) _Pragma("unroll") for (int k = 0; k < 2; ++k) dst[m][k] = *(const PG8_LAS bf16x8*)(lds + PG8_SA(b, h) + aoff + m * 2048 + k * 1024); } while (0)
#define PG8_LDB(dst, b, h) do { _Pragma("unroll") for (int n = 0; n < 2; ++n) _Pragma("unroll") for (int k = 0; k < 2; ++k) dst[n][k] = *(const PG8_LAS bf16x8*)(lds + PG8_SB(b, h) + boff + n * 2048 + k * 1024); } while (0)
#define PG8_MMA(ai, bj, At, Bt) do { __builtin_amdgcn_s_setprio(1); _Pragma("unroll") for (int m = 0; m < 4; ++m) _Pragma("unroll") for (int n = 0; n < 2; ++n) _Pragma("unroll") for (int k = 0; k < 2; ++k) \
        acc[ai][bj][m][n] = __builtin_amdgcn_mfma_f32_16x16x32_bf16(Bt[n][k], At[m][k], acc[ai][bj][m][n], 0, 0, 0); __builtin_amdgcn_s_setprio(0); } while (0)
#define PG8_WAIT_V(n) asm volatile("s_waitcnt vmcnt(" #n ")" ::: "memory")
#define PG8_WAIT_L(n) asm volatile("s_waitcnt lgkmcnt(" #n ")" ::: "memory")
#define PG8_BAR __builtin_amdgcn_s_barrier()
#define PG8_SCHED __builtin_amdgcn_sched_barrier(0)
    Unit cur, nxt; int ui = 0;
    if (!S.next(0, cur)) return;
    f32x4 acc[2][2][4][2];
    E.init(acc, cur, wr, wc, fr, fq);
    bf16x8 At[4][2], B0[2][2], B1[2][2];
    const char* cA = (const char*)g.A + (size_t)cur.pm * tstep; const char* cB = (const char*)g.Bt + (size_t)cur.pn * tstep;
    S.a_ready(cur);
    if constexpr (SP2) {
        PG8_STAGE(PG8_SB(0, 0), cB, voffB); PG8_STAGE(PG8_SB(0, 1), cB + hstep, voffB); PG8_STAGE(PG8_SA(0, 0), cA, voffA); PG8_STAGE(PG8_SA(0, 1), cA + hstep, voffA);
        if (wr == 1) PG8_BAR;
        PG8_WAIT_V(2); PG8_BAR;
        PG8_STAGE(PG8_SB(1, 0), cB + kstep, voffB); PG8_STAGE(PG8_SA(1, 0), cA + kstep, voffA); PG8_STAGE(PG8_SB(1, 1), cB + hstep + kstep, voffB);
        PG8_WAIT_V(6); PG8_BAR;
    } else {
        PG8_STAGE(PG8_SB(0, 0), cB, voffB); PG8_STAGE(PG8_SA(0, 0), cA, voffA); PG8_STAGE(PG8_SB(0, 1), cB + hstep, voffB); PG8_STAGE(PG8_SA(0, 1), cA + hstep, voffA);
        if (wr == 1) PG8_BAR;
        PG8_WAIT_V(4); PG8_BAR;
        PG8_STAGE(PG8_SB(1, 0), cB + kstep, voffB); PG8_STAGE(PG8_SA(1, 0), cA + kstep, voffA); PG8_STAGE(PG8_SB(1, 1), cB + hstep + kstep, voffB);
        PG8_WAIT_V(6); PG8_BAR;
    }
    for (;;) {
        const bool has_next = S.next(ui + 1, nxt);
        const char* nA = has_next ? (const char*)g.A + (size_t)nxt.pm * tstep : cA; const char* nB = has_next ? (const char*)g.Bt + (size_t)nxt.pn * tstep : cB;
        for (int t = 0; t < nt; t += 2) {
            const bool last = (t == nt - 2);
            const char* a1 = cA + (size_t)(t + 1) * kstep;
            const char* a2 = last ? nA : cA + (size_t)(t + 2) * kstep; const char* b2 = last ? nB : cB + (size_t)(t + 2) * kstep;
            const char* a3 = a2 + kstep; const char* b3 = b2 + kstep;
            if (last && has_next) S.a_ready(nxt);
            if constexpr (SP2) {
            PG8_LDB(B0, 0, 0); PG8_LDB(B1, 0, 1); PG8_SCHED; PG8_LDA(At, 0, 0); PG8_STAGE(PG8_SA(1, 1), a1 + hstep, voffA);
            PG8_WAIT_V(8); PG8_WAIT_L(0); PG8_BAR; PG8_MMA(0, 0, At, B0); PG8_MMA(0, 1, At, B1); PG8_BAR; PG8_SCHED;
            PG8_LDA(At, 0, 1); PG8_STAGE(PG8_SB(0, 0), b2, voffB); PG8_STAGE(PG8_SB(0, 1), b2 + hstep, voffB); PG8_STAGE(PG8_SA(0, 0), a2, voffA);
            PG8_WAIT_V(8); PG8_WAIT_L(0); PG8_BAR; PG8_MMA(1, 0, At, B0); PG8_MMA(1, 1, At, B1); PG8_BAR; PG8_SCHED;
            PG8_LDB(B0, 1, 0); PG8_LDB(B1, 1, 1); PG8_SCHED; PG8_LDA(At, 1, 0); PG8_STAGE(PG8_SA(0, 1), a2 + hstep, voffA);
            PG8_WAIT_V(8); PG8_WAIT_L(0); PG8_BAR; PG8_MMA(0, 0, At, B0); PG8_MMA(0, 1, At, B1); PG8_BAR; PG8_SCHED;
            PG8_LDA(At, 1, 1); PG8_STAGE(PG8_SB(1, 0), b3, voffB); PG8_STAGE(PG8_SB(1, 1), b3 + hstep, voffB); PG8_STAGE(PG8_SA(1, 0), a3, voffA);
            PG8_WAIT_V(8); PG8_WAIT_L(0); PG8_BAR; PG8_MMA(1, 0, At, B0); PG8_MMA(1, 1, At, B1); PG8_BAR; PG8_SCHED;
            } else {
            PG8_LDB(B0, 0, 0); PG8_SCHED; PG8_LDA(At, 0, 0); PG8_STAGE(PG8_SA(1, 1), a1 + hstep, voffA);
            PG8_WAIT_L(8); PG8_BAR; PG8_WAIT_L(0); PG8_MMA(0, 0, At, B0); PG8_BAR; PG8_SCHED;
            PG8_LDB(B1, 0, 1); PG8_STAGE(PG8_SB(0, 0), b2, voffB);
            PG8_BAR; PG8_WAIT_L(0); PG8_MMA(0, 1, At, B1); PG8_BAR;
            PG8_LDA(At, 0, 1); PG8_STAGE(PG8_SA(0, 0), a2, voffA);
            PG8_BAR; PG8_WAIT_L(0); PG8_MMA(1, 0, At, B0); PG8_BAR; PG8_SCHED;
            PG8_STAGE(PG8_SB(0, 1), b2 + hstep, voffB);
            PG8_WAIT_V(6); PG8_BAR; PG8_MMA(1, 1, At, B1); PG8_BAR;
            PG8_LDB(B0, 1, 0); PG8_SCHED; PG8_LDA(At, 1, 0); PG8_STAGE(PG8_SA(0, 1), a2 + hstep, voffA);
            PG8_WAIT_L(8); PG8_BAR; PG8_WAIT_L(0); PG8_MMA(0, 0, At, B0); PG8_BAR; PG8_SCHED;
            PG8_LDB(B1, 1, 1); PG8_STAGE(PG8_SB(1, 0), b3, voffB);
            PG8_BAR; PG8_WAIT_L(0); PG8_MMA(0, 1, At, B1); PG8_BAR;
            PG8_LDA(At, 1, 1); PG8_STAGE(PG8_SA(1, 0), a3, voffA);
            PG8_BAR; PG8_WAIT_L(0); PG8_MMA(1, 0, At, B0); PG8_BAR; PG8_SCHED;
            PG8_STAGE(PG8_SB(1, 1), b3 + hstep, voffB);
            PG8_WAIT_V(6); PG8_BAR; PG8_MMA(1, 1, At, B1); PG8_BAR;
            }
        }
        if constexpr (ALIGN_EPI) { if (wr == 0) PG8_BAR; }
        if constexpr (!Epi::AFTER_DRAIN) { E(acc, cur, wr, wc, fr, fq); S.done(cur); }
        if (!has_next) break;
        E.init(acc, nxt, wr, wc, fr, fq);
        cur = nxt; cA = nA; cB = nB; ++ui;
        if constexpr (ALIGN_EPI) { if (wr == 1) PG8_BAR; }
    }
    PG8_WAIT_V(0);
    if constexpr (!ALIGN_EPI) { if (wr == 0) PG8_BAR; }
    PG8_BAR;
    if constexpr (Epi::AFTER_DRAIN) { E.fused(acc, cur, wr, wc, fr, fq, lds, wid, lane); S.done(cur); }
#undef PG8_SA
#undef PG8_SB
#undef PG8_STAGE
#undef PG8_LDA
#undef PG8_LDB
#undef PG8_MMA
#undef PG8_WAIT_V
#undef PG8_WAIT_L
#undef PG8_BAR
#undef PG8_SCHED
}
}
namespace att {
#ifndef KSWZ
#define KSWZ 0
#endif
typedef short bf16x8 __attribute__((ext_vector_type(8)));
typedef short s16x4 __attribute__((ext_vector_type(4)));
typedef short v4i16_t __attribute__((ext_vector_type(4)));
typedef float f32x16 __attribute__((ext_vector_type(16)));
typedef float f32x4 __attribute__((ext_vector_type(4)));
typedef unsigned u32x4 __attribute__((ext_vector_type(4)));
typedef float f32x2_t __attribute__((ext_vector_type(2))); typedef __bf16 bf16x2_t __attribute__((ext_vector_type(2)));
typedef __attribute__((address_space(3))) unsigned char* lds_ptr;
__device__ __forceinline__ unsigned cvtpk_s(float lo, float hi) { f32x2_t v = {lo, hi}; bf16x2_t b = __builtin_convertvector(v, bf16x2_t); return __builtin_bit_cast(unsigned, b); }
__device__ __forceinline__ int crow(int r, int hi) { return (r & 3) + 8 * (r >> 2) + 4 * hi; }
__device__ __forceinline__ s16x4 vtr(lds_ptr p) { return __builtin_bit_cast(s16x4, __builtin_amdgcn_ds_read_tr16_b64_v4i16((__attribute__((address_space(3))) v4i16_t*)p)); }
#define ATT_WAITV(n) asm volatile("s_waitcnt vmcnt(" #n ")" ::: "memory")
__device__ __forceinline__ void glds16(const void* gsrc, unsigned lds_dst) { unsigned keep;
    asm volatile("s_mov_b32 %0, m0\n\ts_mov_b32 m0, %2\n\ts_nop 0\n\tglobal_load_lds_dwordx4 %1, off\n\ts_mov_b32 m0, %0" : "=&s"(keep) : "v"(gsrc), "s"(lds_dst) : "memory"); }
#define ATT_GLDS(src, dst) glds16((src), (unsigned)__builtin_amdgcn_readfirstlane((int)(dst)))

struct Desc {
    const unsigned short *Q0, *Q1, *K, *V;
    int dil, r, qt0, qt1;
    unsigned short* po; float* pl;
    const unsigned short *po_a, *po_b; const float *pl_a, *pl_b;
    const unsigned short *gate0, *gate1; unsigned short *mix0, *mix1;
    float sink0, sink1;
};
struct LaneK { unsigned koff[4], voff[4]; };
__device__ __forceinline__ LaneK lane_offsets(int dil, int lane) {
    LaneK L;
#pragma unroll
    for (int i = 0; i < 4; ++i) {
        const int row = 8 * i + (lane >> 3), chunk = (lane & 7) ^ (KSWZ ? ((row >> 1) & 7) : 0);
        L.koff[i] = (unsigned)(dil * row) * 128u + (unsigned)chunk * 16u;
        const int vrow = 16 * (i & 1) + (lane >> 2);
        L.voff[i] = (unsigned)(dil * vrow) * 128u + (unsigned)(i >> 1) * 64u + (unsigned)(lane & 3) * 16u;
    }
    return L;
}
#define ATT_DMA_K(D, L, ktlo, j) do { const char* s_ = (const char*)(D).K + (size_t)(D).r * 128 + (size_t)((ktlo) + (j)) * ((size_t)(D).dil * 4096); const unsigned d_ = ring0 + ((j) & 1) * 8192; \
        ATT_GLDS(s_ + (L).koff[0], d_); ATT_GLDS(s_ + (L).koff[1], d_ + 1024); ATT_GLDS(s_ + (L).koff[2], d_ + 2048); ATT_GLDS(s_ + (L).koff[3], d_ + 3072); } while (0)
#define ATT_DMA_V(D, L, ktlo, j) do { const char* s_ = (const char*)(D).V + (size_t)(D).r * 128 + (size_t)((ktlo) + (j)) * ((size_t)(D).dil * 4096); const unsigned d_ = ring0 + ((j) & 1) * 8192 + 4096; \
        ATT_GLDS(s_ + (L).voff[0], d_); ATT_GLDS(s_ + (L).voff[1], d_ + 1024); ATT_GLDS(s_ + (L).voff[2], d_ + 2048); ATT_GLDS(s_ + (L).voff[3], d_ + 3072); } while (0)
template <int DRY = 0>
__device__ __forceinline__ void prefetch(const Desc& D, unsigned ring0, bf16x8 (&qr)[2][4], int lane) {
    const int q = lane & 31, hi = lane >> 5;
    const int ktlo = D.qt0 >= 4 ? D.qt0 - 4 : 0, nt = D.qt1 - ktlo + 1;
    const LaneK L = lane_offsets(D.dil, lane);
    { const unsigned short* q0 = D.Q0 + (size_t)(D.r + D.dil * (32 * D.qt0 + q)) * 64 + hi * 8; const unsigned short* q1 = D.Q1 + (size_t)(D.r + D.dil * (32 * D.qt1 + q)) * 64 + hi * 8;
#pragma unroll
      for (int d0 = 0; d0 < 4; ++d0) { qr[0][d0] = *(const bf16x8*)(q0 + d0 * 16); qr[1][d0] = *(const bf16x8*)(q1 + d0 * 16); } }
    asm volatile("s_waitcnt lgkmcnt(0)" ::: "memory");
    if (DRY != 2) { ATT_DMA_K(D, L, ktlo, 0); ATT_DMA_V(D, L, ktlo, 0);
    if (nt > 1) { ATT_DMA_K(D, L, ktlo, 1); ATT_DMA_V(D, L, ktlo, 1); } }
}
template <int MODE, int DRY = 0>
__device__ __forceinline__ void attn_item(lds_ptr ring, lds_ptr stage, const Desc& D, bool has_next, const Desc& N, bf16x8 (&qr)[2][4], int lane) {
    const int q = lane & 31, hi = lane >> 5;
    const int ktlo = D.qt0 >= 4 ? D.qt0 - 4 : 0, nt = D.qt1 - ktlo + 1;
    constexpr int DMIN = (MODE == 0) ? 1 : 0;
    const unsigned ring0 = (unsigned)(uintptr_t)ring;
    const LaneK L = lane_offsets(D.dil, lane);
    const int krow = q * 128, ksw = KSWZ ? ((q >> 1) & 7) : 0;
    const int vb = ((lane >> 4) & 1) * 32 + (lane & 3) * 8 + (4 * hi + ((lane & 15) >> 2)) * 64;
    f32x16 o00 = {}, o01 = {}, o10 = {}, o11 = {}; float ls0 = 0.f, ls1 = 0.f;
    asm volatile("s_waitcnt vmcnt(0)" ::: "memory");
    asm volatile("" : "+v"(qr[0][0]), "+v"(qr[0][1]), "+v"(qr[0][2]), "+v"(qr[0][3]), "+v"(qr[1][0]), "+v"(qr[1][1]), "+v"(qr[1][2]), "+v"(qr[1][3]));
    for (int j = 0; j < nt; ++j) {
        const int e = nt - 1 - j, kt = ktlo + j; lds_ptr slot = ring + (j & 1) * 8192;
        const bool act0 = (kt <= D.qt0), act1 = (kt >= D.qt1 - 4);
        if (DRY != 2) { if (e >= 1) ATT_WAITV(12); else ATT_WAITV(4); }
        bf16x8 kf[4];
        if (DRY != 1) {
#pragma unroll
        for (int ks = 0; ks < 4; ++ks) kf[ks] = *(const __attribute__((address_space(3))) bf16x8*)(slot + krow + (((2 * ks + hi) ^ ksw) * 16));
        asm volatile("s_waitcnt lgkmcnt(0)" ::: "memory");
        asm volatile("" : "+v"(kf[0]), "+v"(kf[1]), "+v"(kf[2]), "+v"(kf[3]));
        }
        if (DRY != 2 && e >= 2) ATT_DMA_K(D, L, ktlo, j + 2);
        u32x4 pa0 = {}, pa1 = {}, pb0 = {}, pb1 = {};
#define ATT_SCORE(S, QT, ACT, LS, PW0, PW1) if (ACT) { f32x16 p = {}; \
            _Pragma("unroll") for (int ks = 0; ks < 4; ++ks) p = __builtin_amdgcn_mfma_f32_32x32x16_bf16(kf[ks], qr[S][ks], p, 0, 0, 0); \
            const bool first = (kt == (QT) - 4), last = (kt == (QT)); \
            if (first || last) { _Pragma("unroll") for (int rr = 0; rr < 16; ++rr) { const int kk = crow(rr, hi); const bool bad = (first && kk < q + DMIN) || (last && kk > q); if (bad) p[rr] = -INFINITY; } } \
            float s_ = 0.f; \
            _Pragma("unroll") for (int rr = 0; rr < 16; ++rr) { p[rr] = __builtin_amdgcn_exp2f(p[rr]); s_ += p[rr]; } \
            LS += s_; \
            PW0[0] = cvtpk_s(p[0], p[1]); PW0[1] = cvtpk_s(p[2], p[3]); PW0[2] = cvtpk_s(p[4], p[5]); PW0[3] = cvtpk_s(p[6], p[7]); \
            PW1[0] = cvtpk_s(p[8], p[9]); PW1[1] = cvtpk_s(p[10], p[11]); PW1[2] = cvtpk_s(p[12], p[13]); PW1[3] = cvtpk_s(p[14], p[15]); }
        if (DRY != 1) {
        ATT_SCORE(0, D.qt0, act0, ls0, pa0, pa1)
        ATT_SCORE(1, D.qt1, act1, ls1, pb0, pb1)
        }
#undef ATT_SCORE
        if (DRY != 2) { if (e >= 2) ATT_WAITV(12); else if (e == 1) ATT_WAITV(8); else ATT_WAITV(0); }
        if (DRY != 1) {
        lds_ptr vp = slot + 4096 + vb;
        s16x4 lo[4], hh[4];
#pragma unroll
        for (int i = 0; i < 4; ++i) { lo[i] = vtr(vp + i * 1024); hh[i] = vtr(vp + i * 1024 + 512); }
#define ATT_VFR(i) (bf16x8){lo[i][0], lo[i][1], lo[i][2], lo[i][3], hh[i][0], hh[i][1], hh[i][2], hh[i][3]}
        if (act0) {
            o00 = __builtin_amdgcn_mfma_f32_32x32x16_bf16(__builtin_bit_cast(bf16x8, pa0), ATT_VFR(0), o00, 0, 0, 0);
            o00 = __builtin_amdgcn_mfma_f32_32x32x16_bf16(__builtin_bit_cast(bf16x8, pa1), ATT_VFR(1), o00, 0, 0, 0);
            o01 = __builtin_amdgcn_mfma_f32_32x32x16_bf16(__builtin_bit_cast(bf16x8, pa0), ATT_VFR(2), o01, 0, 0, 0);
            o01 = __builtin_amdgcn_mfma_f32_32x32x16_bf16(__builtin_bit_cast(bf16x8, pa1), ATT_VFR(3), o01, 0, 0, 0);
        }
        if (act1) {
            o10 = __builtin_amdgcn_mfma_f32_32x32x16_bf16(__builtin_bit_cast(bf16x8, pb0), ATT_VFR(0), o10, 0, 0, 0);
            o10 = __builtin_amdgcn_mfma_f32_32x32x16_bf16(__builtin_bit_cast(bf16x8, pb1), ATT_VFR(1), o10, 0, 0, 0);
            o11 = __builtin_amdgcn_mfma_f32_32x32x16_bf16(__builtin_bit_cast(bf16x8, pb0), ATT_VFR(2), o11, 0, 0, 0);
            o11 = __builtin_amdgcn_mfma_f32_32x32x16_bf16(__builtin_bit_cast(bf16x8, pb1), ATT_VFR(3), o11, 0, 0, 0);
        }
#undef ATT_VFR
        }
        asm volatile("s_waitcnt lgkmcnt(0)" ::: "memory");
        if (DRY != 2 && e >= 2) ATT_DMA_V(D, L, ktlo, j + 2);
    }
    __attribute__((address_space(3))) unsigned short* st = (__attribute__((address_space(3))) unsigned short*)stage;
    u32x4 g0[4], a0[4], b0[4]; float la0[4], lb0[4];
#define ATT_EPI_T(QT, pp) ((size_t)(D.r + D.dil * (32 * (QT) + 16 * ((pp) >> 1) + 8 * ((pp) & 1) + (lane >> 3))))
#define ATT_EPI_LOAD(QT, G, A, B, LA, LB, GATE) do { _Pragma("unroll") for (int pp = 0; pp < 4; ++pp) { const size_t t = ATT_EPI_T(QT, pp); const int ch = lane & 7; \
        G[pp] = *(const u32x4*)((GATE) + t * 512 + ch * 8); \
        if (MODE == 2) { A[pp] = __builtin_nontemporal_load((const u32x4*)(D.po_a + t * 64 + ch * 8)); B[pp] = __builtin_nontemporal_load((const u32x4*)(D.po_b + t * 64 + ch * 8)); \
                         LA[pp] = __builtin_nontemporal_load(D.pl_a + t); LB[pp] = __builtin_nontemporal_load(D.pl_b + t); } } } while (0)
#define ATT_EPI_TOUCH(G, A, B, LA, LB) do { asm volatile("" : "+v"(G[0]), "+v"(G[1]), "+v"(G[2]), "+v"(G[3])); \
        if (MODE == 2) { asm volatile("" : "+v"(A[0]), "+v"(A[1]), "+v"(A[2]), "+v"(A[3]), "+v"(B[0]), "+v"(B[1]), "+v"(B[2]), "+v"(B[3])); \
                         asm volatile("" : "+v"(LA[0]), "+v"(LA[1]), "+v"(LA[2]), "+v"(LA[3]), "+v"(LB[0]), "+v"(LB[1]), "+v"(LB[2]), "+v"(LB[3])); } } while (0)
#define ATT_EPI_PROC(QT, OA, OB, LS, G, A, B, LA, LB, MIX, SINK) do { \
        { auto sw_ = __builtin_amdgcn_permlane32_swap(__float_as_uint(LS), __float_as_uint(LS), false, false); LS = __uint_as_float(sw_[0]) + __uint_as_float(sw_[1]); } \
        _Pragma("unroll") for (int hf = 0; hf < 2; ++hf) { \
            _Pragma("unroll") for (int i8 = 0; i8 < 8; ++i8) { const int rl = crow(i8, hi); \
                st[rl * 64 + q] = (unsigned short)(cvtpk_s(OA[8 * hf + i8], 0.f) & 0xffffu); st[rl * 64 + 32 + q] = (unsigned short)(cvtpk_s(OB[8 * hf + i8], 0.f) & 0xffffu); } \
            _Pragma("unroll") for (int i2 = 0; i2 < 2; ++i2) { \
                const int pp = 2 * hf + i2, rl = 8 * i2 + (lane >> 3), ch = lane & 7, row = 16 * hf + rl; \
                const u32x4 ow = *(const __attribute__((address_space(3))) u32x4*)(st + rl * 64 + ch * 8); \
                float l = __shfl(LS, row); \
                const size_t t = ATT_EPI_T(QT, pp); \
                if (MODE == 1) { *(u32x4*)(D.po + t * 64 + ch * 8) = ow; if (ch == 0) D.pl[t] = l; } \
                else { \
                    float v[8]; \
                    _Pragma("unroll") for (int k = 0; k < 4; ++k) { v[2 * k] = __uint_as_float(ow[k] << 16); v[2 * k + 1] = __uint_as_float(ow[k] & 0xffff0000u); } \
                    if (MODE == 2) { \
                        l += LA[pp] + LB[pp]; \
                        _Pragma("unroll") for (int k = 0; k < 4; ++k) { v[2 * k] += __uint_as_float(A[pp][k] << 16) + __uint_as_float(B[pp][k] << 16); v[2 * k + 1] += __uint_as_float(A[pp][k] & 0xffff0000u) + __uint_as_float(B[pp][k] & 0xffff0000u); } \
                    } else l += (SINK); \
                    const float rl_ = 1.0f / l; \
                    u32x4 w; \
                    _Pragma("unroll") for (int k = 0; k < 4; ++k) w[k] = cvtpk_s(v[2 * k] * rl_ * __uint_as_float(G[pp][k] << 16), v[2 * k + 1] * rl_ * __uint_as_float(G[pp][k] & 0xffff0000u)); \
                    *(u32x4*)((MIX) + t * 1024 + ch * 8) = w; \
                } \
            } \
        } } while (0)
    if (DRY != 0) {
        asm volatile("" :: "v"(o00), "v"(o01), "v"(o10), "v"(o11), "v"(ls0), "v"(ls1));
        if (has_next) prefetch<DRY>(N, ring0, qr, lane);
    } else if (MODE == 1) {
        if (has_next) prefetch(N, ring0, qr, lane);
        ATT_EPI_PROC(D.qt0, o00, o01, ls0, g0, a0, b0, la0, lb0, D.mix0, D.sink0);
        ATT_EPI_PROC(D.qt1, o10, o11, ls1, g0, a0, b0, la0, lb0, D.mix1, D.sink1);
    } else {
        ATT_EPI_LOAD(D.qt0, g0, a0, b0, la0, lb0, D.gate0);
        __builtin_amdgcn_sched_barrier(0);
        ATT_EPI_TOUCH(g0, a0, b0, la0, lb0);
        __builtin_amdgcn_sched_barrier(0);
        ATT_EPI_PROC(D.qt0, o00, o01, ls0, g0, a0, b0, la0, lb0, D.mix0, D.sink0);
        __builtin_amdgcn_sched_barrier(0);
        ATT_EPI_LOAD(D.qt1, g0, a0, b0, la0, lb0, D.gate1);
        __builtin_amdgcn_sched_barrier(0);
        if (has_next) prefetch(N, ring0, qr, lane);
        __builtin_amdgcn_sched_barrier(0);
        ATT_EPI_TOUCH(g0, a0, b0, la0, lb0);
        __builtin_amdgcn_sched_barrier(0);
        ATT_EPI_PROC(D.qt1, o10, o11, ls1, g0, a0, b0, la0, lb0, D.mix1, D.sink1);
    }
#undef ATT_EPI_T
#undef ATT_EPI_LOAD
#undef ATT_EPI_TOUCH
#undef ATT_EPI_PROC
}
#undef ATT_DMA_K
#undef ATT_DMA_V
#undef ATT_WAITV
#undef ATT_GLDS
}
#ifndef PG8_SP2
#define PG8_SP2 true
#endif
#ifndef PG8_ALIGN
#define PG8_ALIGN true
#endif
constexpr int NWAVES = 8;
constexpr int BATCH = 8, SEQ = 4096, DM = 1024, M = BATCH * SEQ, NIN = 3328, HD = 64;
constexpr float LOG2E = 1.4426950408889634f;
constexpr size_t MiB = 1u << 20;
constexpr size_t WS_CTL = 0, CTL_ZERO_BYTES = 64 * 1024;
constexpr size_t WS_COS = 1 * MiB, WS_SIN = WS_COS + 512 * 1024;
constexpr size_t WS_WIT = 2 * MiB, WS_WOT = 9 * MiB;
constexpr size_t WS_XN = 16 * MiB;
constexpr size_t WS_QA = 80 * MiB, WS_QB = 112 * MiB, WS_KA = 144 * MiB, WS_VA = 152 * MiB, WS_KB = 160 * MiB, WS_VB = 192 * MiB;
constexpr size_t WS_GA = 224 * MiB, WS_GB = 256 * MiB, WS_MIX = 288 * MiB, WS_PO16 = 352 * MiB, WS_PO4 = 384 * MiB, WS_PL16 = 416 * MiB, WS_PL4 = 417 * MiB, WS_END = 418 * MiB;
constexpr int CW_BAR = 1024;
constexpr int RING_OFF = 0, RING_BYTES = 131072;
constexpr int LDSCTL_OFF = RING_BYTES + 16384, MISC_OFF = LDSCTL_OFF + 320;
constexpr int LDS_BYTES = 149504;
static_assert(MISC_OFF + 128 <= LDS_BYTES, "LDS map");
#define GAS __attribute__((address_space(1)))
#define LAS __attribute__((address_space(3)))
typedef unsigned short bf16;
typedef unsigned v4u __attribute__((ext_vector_type(4)));
typedef float f32x4 __attribute__((ext_vector_type(4)));
typedef short bf16x8 __attribute__((ext_vector_type(8)));
typedef GAS unsigned gu32;
typedef GAS unsigned long long gu64;
#define RLX_AGENT __ATOMIC_RELAXED, __HIP_MEMORY_SCOPE_AGENT
#define LDS_WAIT() asm volatile("s_waitcnt lgkmcnt(0)" ::: "memory")
#define VM_WAIT() asm volatile("s_waitcnt vmcnt(0)" ::: "memory")
__device__ __forceinline__ unsigned long long rt() { return __builtin_amdgcn_s_memrealtime(); }
__device__ __forceinline__ unsigned f2bf(float f) { unsigned u = __builtin_bit_cast(unsigned, f); return (u + 0x7fffu + ((u >> 16) & 1u)) >> 16; }
__device__ __forceinline__ unsigned pk2(float lo, float hi) { return f2bf(lo) | (f2bf(hi) << 16); }

#define XB_TMO      128
#define XB_XCNT(j)  (256  + 64 * (j))
#define XB_XSUB(j)  (1280 + 64 * (j))
#define XB_XGEN(j)  (2304 + 64 * (j))
#define XB_TOP      3328
#define XB_TOPGEN   3392
#define XCD_BAR_WORDS 3456
#define XB_SPIN_CAP (1u << 18)

__device__ __forceinline__ unsigned xb_ld(unsigned* p)              { return __hip_atomic_load(p, __ATOMIC_RELAXED, __HIP_MEMORY_SCOPE_AGENT); }
__device__ __forceinline__ unsigned xb_add(unsigned* p, unsigned v) { return __hip_atomic_fetch_add(p, v, __ATOMIC_RELAXED, __HIP_MEMORY_SCOPE_AGENT); }
__device__ __forceinline__ unsigned xb_xcc_id() { return (unsigned)__builtin_amdgcn_s_getreg((3 << 11) | 20) & 0xFu; }
#define XB_SPIN(cond, bar) do { unsigned _sp = 0; while (cond) { __builtin_amdgcn_s_sleep(1); \
    if ((++_sp & 255u) == 0u) { if (xb_ld(&(bar)[XB_TMO])) break; if (_sp > XB_SPIN_CAP) { atomicAdd(&(bar)[XB_TMO], 1u); break; } } } } while (0)

struct XcdBarrier {
    unsigned* bar; unsigned x;
    volatile LAS unsigned* st;
};

__device__ __forceinline__ XcdBarrier xcd_barrier_post(unsigned* bar, volatile LAS unsigned* st) {
    XcdBarrier b; b.bar = bar; b.x = xb_xcc_id(); b.st = st;
    if (threadIdx.x == 0) (void)xb_add(&bar[XB_XCNT(b.x)], 1u);
    return b;
}
__device__ __forceinline__ void xcd_barrier_complete(unsigned* bar, unsigned x, unsigned& nloc, unsigned& nx) {
    const unsigned G = gridDim.x * gridDim.y * gridDim.z;
    unsigned sum, cnt, mine, sp = 0u;
    for (;;) {
        sum = 0u; cnt = 0u; mine = 0u;
#pragma unroll
        for (unsigned j = 0; j < 16; ++j) { const unsigned c = xb_ld(&bar[XB_XCNT(j)]); sum += c; cnt += (c > 0u) ? 1u : 0u; mine = (j == x) ? c : mine; }
        if (sum == G) break;
        __builtin_amdgcn_s_sleep(1);
        if ((++sp & 255u) == 0u) { if (xb_ld(&bar[XB_TMO])) break; if (sp > XB_SPIN_CAP) { atomicAdd(&bar[XB_TMO], 1u); break; } }
    }
    nloc = mine > 0u ? mine : 1u; nx = cnt > 0u ? cnt : 1u;
}

__device__ __forceinline__ void xcd_barrier(const XcdBarrier& b) {
    asm volatile("s_waitcnt vmcnt(0)" ::: "memory");
    __syncthreads();
    if (threadIdx.x == 0) {
        unsigned* bar = b.bar;
        __builtin_amdgcn_s_waitcnt(0);
        unsigned nloc = b.st[0], nx = b.st[1];
        if (nloc == 0u) { xcd_barrier_complete(bar, b.x, nloc, nx); b.st[0] = nloc; b.st[1] = nx; }
        const unsigned old = xb_add(&bar[XB_XSUB(b.x)], 1u);
        const unsigned gen = old / nloc;
        if (old + 1u == (gen + 1u) * nloc) {
            __builtin_amdgcn_fence(__ATOMIC_RELEASE, "agent");
            asm volatile("s_waitcnt vmcnt(0)" ::: "memory");
            const unsigned og = xb_add(&bar[XB_TOP], 1u);
            const unsigned tg = og / nx;
            if (og + 1u == (tg + 1u) * nx) xb_add(&bar[XB_TOPGEN], 1u);
            else XB_SPIN(xb_ld(&bar[XB_TOPGEN]) == tg, bar);
            __builtin_amdgcn_fence(__ATOMIC_ACQUIRE, "agent");
            xb_add(&bar[XB_XGEN(b.x)], 1u);
            asm volatile("s_waitcnt vmcnt(0)" ::: "memory");
        } else {
            XB_SPIN(xb_ld(&bar[XB_XGEN(b.x)]) == gen, bar);
            __builtin_amdgcn_fence(__ATOMIC_ACQUIRE, "agent");
            asm volatile("s_waitcnt vmcnt(0)" ::: "memory");
        }
    }
    __syncthreads();
}
static_assert((CW_BAR + XCD_BAR_WORDS) * 4 <= (int)CTL_ZERO_BYTES, "barrier words inside the memset region");

struct Frame {
    LAS unsigned char* lds;
    volatile LAS unsigned* MISC;
    gu32* ctl;
    int tid, lane, wave;
    int vcu, G;
};
__device__ __forceinline__ float bf2f(bf16 b) { return __uint_as_float(((unsigned)b) << 16); }
__device__ __forceinline__ float wave_sum(float v) {
#pragma unroll
    for (int o = 1; o < 64; o <<= 1) v += __shfl_xor(v, o);
    return v;
}
__device__ __forceinline__ void sincos_d(float ang, float& s, float& c) {
    const double a = (double)ang;
    const double k = rint(a * 0.6366197723675814);
    double y = fma(-k, 1.5707963267948966, a);
    y = fma(-k, 6.123233995736766e-17, y);
    const double y2 = y * y;
    const double sp = y * (1.0 + y2 * (-1.0 / 6 + y2 * (1.0 / 120 + y2 * (-1.0 / 5040 + y2 * (1.0 / 362880 + y2 * (-1.0 / 39916800 + y2 * (1.0 / 6227020800.0)))))));
    const double cp = 1.0 + y2 * (-0.5 + y2 * (1.0 / 24 + y2 * (-1.0 / 720 + y2 * (1.0 / 40320 + y2 * (-1.0 / 3628800 + y2 * (1.0 / 479001600.0 + y2 * (-1.0 / 87178291200.0)))))));
    const int q = ((int)(long long)k) & 3;
    const double ss = (q == 0) ? sp : (q == 1) ? cp : (q == 2) ? -sp : -cp;
    const double cc = (q == 0) ? cp : (q == 1) ? -sp : (q == 2) ? -cp : sp;
    s = (float)ss; c = (float)cc;
}
__device__ __forceinline__ void p0_transpose_item(const float* W, int K, int N, bf16* WT, int k0, int n0, int d0, LAS float* scr, int lane) {
#pragma unroll 8
    for (int i = 0; i < 32; ++i) { const int kk = 2 * i + (lane >> 5); scr[kk * 33 + (lane & 31)] = W[(size_t)(k0 + kk) * N + n0 + (lane & 31)]; }
    LDS_WAIT(); asm volatile("" ::: "memory");
    const int c = lane & 7;
#pragma unroll
    for (int j = 0; j < 4; ++j) { const int n = (lane >> 3) + 8 * j; const LAS float* s = scr + (8 * c) * 33 + n;
        v4u o; o.x = pk2(s[0 * 33], s[1 * 33]); o.y = pk2(s[2 * 33], s[3 * 33]); o.z = pk2(s[4 * 33], s[5 * 33]); o.w = pk2(s[6 * 33], s[7 * 33]);
        *(GAS v4u*)(WT + (size_t)(d0 + n) * K + k0 + 8 * c) = o; }
    LDS_WAIT(); asm volatile("" ::: "memory");
}
struct Ptrs {
    const float *x, *gain, *w_in, *qna, *kna, *sinks, *qnb, *knb, *w_out; float* out;
    bf16 *WIT, *WOT, *XN, *QA, *KA, *VA, *GA, *QB, *KB, *VB, *GB, *MIX, *PO16, *PO4; float *cosT, *sinT, *PL16, *PL4;
};
__device__ __forceinline__ void p0_prologue(Frame& F, const Ptrs& P) {
    LAS float* scr = (LAS float*)(F.lds + RING_OFF + F.wave * 16384);
    const int gw = F.vcu * NWAVES + F.wave, NGW = F.G * NWAVES;
    constexpr int I_IN = (DM / 64) * (NIN / 32), I_OUT = (DM / 64) * (DM / 32);
    for (int it = gw; it < I_IN + I_OUT; it += NGW) {
        if (it < I_IN) { const int nblk = NIN / 32, kb = it / nblk, nb = it % nblk, n0 = 32 * nb;
            const int pn = n0 >> 8, rem = n0 & 255, wc = rem >> 6, bjj = (rem >> 5) & 1;
            p0_transpose_item(P.w_in, DM, NIN, P.WIT, 64 * kb, n0, 256 * pn + 128 * bjj + 32 * wc, scr, F.lane); }
        else { const int r = it - I_IN, nblk = DM / 32, kb = r / nblk, nb = r % nblk; p0_transpose_item(P.w_out, DM, DM, P.WOT, 64 * kb, 32 * nb, 32 * nb, scr, F.lane); }
    }
    for (int e = (F.vcu * NWAVES * 64) + F.tid; e < SEQ * 32; e += F.G * NWAVES * 64) {
        const int t = e >> 5, i = e & 31;
        double r = 1.0; for (int k = 0; k < i; ++k) r *= 0.7498942093324558;
        const float inv = (float)r; const float ang = (float)t * inv;
        float s, c; sincos_d(ang, s, c); P.cosT[e] = c; P.sinT[e] = s;
    }
    for (int m = gw; m < M; m += NGW) {
        const GAS f32x4* xr = (const GAS f32x4*)(P.x + (size_t)m * DM) + F.lane;
        f32x4 v[4]; float ss = 0.f;
#pragma unroll
        for (int j = 0; j < 4; ++j) { v[j] = xr[64 * j]; ss += (v[j].x * v[j].x + v[j].y * v[j].y) + (v[j].z * v[j].z + v[j].w * v[j].w); }
        const float rstd = rsqrtf(wave_sum(ss) * (1.f / DM) + 1e-6f);
        GAS unsigned long long* o8 = (GAS unsigned long long*)(P.XN + (size_t)m * DM) + F.lane;
#pragma unroll
        for (int j = 0; j < 4; ++j) { const f32x4 g = ((const GAS f32x4*)P.gain)[64 * j + F.lane];
            o8[64 * j] = (unsigned long long)pk2(v[j].x * rstd * g.x, v[j].y * rstd * g.y) | ((unsigned long long)pk2(v[j].z * rstd * g.z, v[j].w * rstd * g.w) << 32); }
    }
}
constexpr int STAGE_OFF = RING_BYTES;
__device__ __forceinline__ att::Desc b_desc(const Ptrs& P, int uid, int mode, int wave, int k) {
    const int b = uid >> 5, h = (uid >> 2) & 7, blk = uid & 3; const size_t hb = (size_t)(b * 8 + h) * SEQ;
    att::Desc D{};
    D.Q0 = P.QB + hb * 64; D.Q1 = D.Q0; D.K = P.KB + hb * 64; D.V = P.VB + hb * 64;
    if (mode == 1) {
        if (wave < 4) { D.dil = 16; D.r = 4 * wave + k; D.qt0 = 2 * blk; D.po = P.PO16 + hb * 64; D.pl = P.PL16 + hb; }
        else { D.dil = 4; D.r = wave - 4; D.qt0 = 8 * blk + 2 * k; D.po = P.PO4 + hb * 64; D.pl = P.PL4 + hb; }
    } else {
        D.dil = 1; D.r = 0; D.qt0 = 32 * blk + 2 * (2 * wave + k);
        D.po_a = P.PO16 + hb * 64; D.po_b = P.PO4 + hb * 64; D.pl_a = P.PL16 + hb; D.pl_b = P.PL4 + hb;
        D.gate0 = P.GB + (size_t)b * SEQ * 512 + h * 64; D.gate1 = D.gate0; D.mix0 = P.MIX + (size_t)b * SEQ * DM + 512 + h * 64; D.mix1 = D.mix0;
    }
    D.qt1 = D.qt0 + 1;
    return D;
}
__device__ __forceinline__ att::Desc a_desc(const Ptrs& P, int aid) {
    const int b = aid >> 9, hp = (aid >> 7) & 3, qt = aid & 127, kv = hp >> 1, h0 = 2 * hp;
    att::Desc D{};
    D.Q0 = P.QA + (size_t)(b * 8 + h0) * SEQ * 64; D.Q1 = D.Q0 + (size_t)SEQ * 64;
    D.K = P.KA + (size_t)(b * 2 + kv) * SEQ * 64; D.V = P.VA + (size_t)(b * 2 + kv) * SEQ * 64;
    D.dil = 1; D.r = 0; D.qt0 = qt; D.qt1 = qt;
    D.gate0 = P.GA + (size_t)b * SEQ * 512 + h0 * 64; D.gate1 = D.gate0 + 64; D.mix0 = P.MIX + (size_t)b * SEQ * DM + h0 * 64; D.mix1 = D.mix0 + 64;
    D.sink0 = __builtin_amdgcn_exp2f(P.sinks[h0] * LOG2E); D.sink1 = __builtin_amdgcn_exp2f(P.sinks[h0 + 1] * LOG2E);
    return D;
}
#ifndef REP_2A
#define REP_2A 1
#define REP_2B 1
#define REP_2C 1
#endif
__device__ __forceinline__ void p2_attention(Frame& F, const Ptrs& P, const XcdBarrier& bar) {
    att::lds_ptr ring = (att::lds_ptr)(F.lds + RING_OFF + F.wave * 16384), stage = (att::lds_ptr)(F.lds + STAGE_OFF + F.wave * 2048);
    int lane_ = F.lane; asm volatile("" : "+v"(lane_));
    const int lane = lane_, wave = F.wave, uid = F.vcu;
    const unsigned ring0 = (unsigned)(uintptr_t)ring;
    att::bf16x8 qr[2][4];
    att::Desc D, N;
#ifdef DRY_PASS
    D = b_desc(P, uid, 1, wave, 0);
    att::prefetch<DRY_PASS>(D, ring0, qr, lane);
    for (int k = 0; k < 4; ++k) {
        N = b_desc(P, uid, 1, wave, (k + 1) & 3);
        att::attn_item<1, DRY_PASS>(ring, stage, D, k < 3, N, qr, lane); D = N;
    }
    asm volatile("s_waitcnt vmcnt(0) lgkmcnt(0)" ::: "memory");
#endif
#pragma unroll
    for (int rep = 0; rep < REP_2A; ++rep) {
    D = b_desc(P, uid, 1, wave, 0);
    att::prefetch(D, ring0, qr, lane);
    for (int k = 0; k < 4; ++k) {
        N = b_desc(P, uid, 1, wave, (k + 1) & 3);
        att::attn_item<1>(ring, stage, D, k < 3, N, qr, lane); D = N;
    }
    }
    asm volatile("s_waitcnt vmcnt(0) lgkmcnt(0)\n\ts_barrier" ::: "memory");
#pragma unroll
    for (int rep = 0; rep < REP_2B; ++rep) {
    D = b_desc(P, uid, 2, wave, 0);
    att::prefetch(D, ring0, qr, lane);
    for (int k = 0; k < 2; ++k) {
        N = b_desc(P, uid, 2, wave, 1);
        att::attn_item<2>(ring, stage, D, k < 1, N, qr, lane); D = N;
    }
    }
#pragma unroll
    for (int rep = 0; rep < REP_2C; ++rep) {
    D = a_desc(P, __builtin_amdgcn_readfirstlane(uid * 16 + wave * 2));
    att::prefetch(D, ring0, qr, lane);
    for (int k = 0; k < 2; ++k) {
        N = a_desc(P, __builtin_amdgcn_readfirstlane(uid * 16 + wave * 2 + 1));
        att::attn_item<0>(ring, stage, D, k < 1, N, qr, lane); D = N;
    }
    }
}

struct Args { const float* in[9]; float* out; unsigned char* ws; };
__global__ void __launch_bounds__(NWAVES * 64, 2) mega_fwd(Args args) {
    extern __shared__ __attribute__((aligned(16))) unsigned char lds[];
    Frame F;
    F.lds = (LAS unsigned char*)lds;
    F.MISC = (volatile LAS unsigned*)(F.lds + MISC_OFF);
    F.tid = threadIdx.x; F.lane = F.tid & 63; F.wave = __builtin_amdgcn_readfirstlane(F.tid >> 6);
    F.G = gridDim.x; { const int bx = blockIdx.x; F.vcu = (F.G % 8 == 0) ? (bx % 8) * (F.G / 8) + bx / 8 : bx; }
    unsigned char* ws = args.ws;
    F.ctl = (gu32*)(ws + WS_CTL);
    Ptrs P;
    P.x = args.in[0]; P.gain = args.in[1]; P.w_in = args.in[2]; P.qna = args.in[3]; P.kna = args.in[4]; P.sinks = args.in[5]; P.qnb = args.in[6]; P.knb = args.in[7]; P.w_out = args.in[8]; P.out = args.out;
    P.WIT = (bf16*)(ws + WS_WIT); P.WOT = (bf16*)(ws + WS_WOT); P.XN = (bf16*)(ws + WS_XN);
    P.QA = (bf16*)(ws + WS_QA); P.KA = (bf16*)(ws + WS_KA); P.VA = (bf16*)(ws + WS_VA); P.GA = (bf16*)(ws + WS_GA);
    P.QB = (bf16*)(ws + WS_QB); P.KB = (bf16*)(ws + WS_KB); P.VB = (bf16*)(ws + WS_VB); P.GB = (bf16*)(ws + WS_GB); P.MIX = (bf16*)(ws + WS_MIX);
    P.cosT = (float*)(ws + WS_COS); P.sinT = (float*)(ws + WS_SIN);
    P.PO16 = (bf16*)(ws + WS_PO16); P.PO4 = (bf16*)(ws + WS_PO4); P.PL16 = (float*)(ws + WS_PL16); P.PL4 = (float*)(ws + WS_PL4);
    for (int u = F.tid; u < (LDS_BYTES - LDSCTL_OFF) / 4; u += NWAVES * 64) ((LAS unsigned*)(F.lds + LDSCTL_OFF))[u] = 0u;
    __syncthreads();
    XcdBarrier bar = xcd_barrier_post((unsigned*)(F.ctl + CW_BAR), F.MISC + 8);

#ifndef PROBE_TS
#define PROBE_TS 0
#endif
    unsigned long long ts0 = 0, ts1 = 0, ts2 = 0, ts3 = 0, ts4 = 0;
    if (PROBE_TS) ts0 = rt();
#ifndef REP_P0
#define REP_P0 1
#define REP_P1 1
#define REP_P2 1
#define REP_P3 1
#endif
#pragma unroll
    for (int rep = 0; rep < REP_P0; ++rep) {
    p0_prologue(F, P);
    xcd_barrier(bar);
    }
    if (PROBE_TS) ts1 = rt();
#pragma unroll
    for (int rep = 0; rep < REP_P1; ++rep) {
        pg8::Gemm g{P.XN, P.WIT, M, NIN, DM}; pg8::StaticOrder S; S.init(M, NIN, F.G, (int)blockIdx.x);
        pg8::EpiIn E{P.QA, P.KA, P.VA, P.GA, P.QB, P.KB, P.VB, P.GB, P.qna, P.kna, P.qnb, P.knb, P.cosT, P.sinT};
        pg8::gemm_phase<pg8::EpiIn, pg8::StaticOrder, PG8_ALIGN, PG8_SP2>(F.lds + RING_OFF, g, S, E);
    xcd_barrier(bar);
    }
    if (PROBE_TS) ts2 = rt();
#pragma unroll
    for (int rep = 0; rep < REP_P2; ++rep) {
    p2_attention(F, P, bar);
    xcd_barrier(bar);
    }
    if (PROBE_TS) ts3 = rt();
#pragma unroll
    for (int rep = 0; rep < REP_P3; ++rep) {
        pg8::Gemm g{P.MIX, P.WOT, M, DM, DM}; pg8::StaticOrder S; S.init(M, DM, F.G, (int)blockIdx.x);
        pg8::EpiRes E{P.x, P.out};
        pg8::gemm_phase<pg8::EpiRes, pg8::StaticOrder, PG8_ALIGN, PG8_SP2>(F.lds + RING_OFF, g, S, E);
    }
    if (PROBE_TS) {
        ts4 = rt();
        if (blockIdx.x == 0 && F.tid == 0) {
            const float dA = (PROBE_TS == 1) ? (float)(ts2 - ts1) * 0.01f : (float)(ts1 - ts0) * 0.01f;
            const float dB = (PROBE_TS == 1) ? (float)(ts3 - ts2) * 0.01f : (float)(ts4 - ts3) * 0.01f;
            asm volatile("s_waitcnt vmcnt(0)" ::: "memory");
            P.out[0] += dA; P.out[1] += dB;
        }
    }
}

extern "C" void kernel_launch(void* const* d_in, const int* in_sizes, int n_in, void* d_out, int out_size, void* d_ws, size_t ws_size, hipStream_t stream) {
    static int grid = 0;
    if (grid == 0) {
        if (n_in != 9 || out_size != M * DM || ws_size < WS_END) { fprintf(stderr, "kernel_launch: unexpected shapes (n_in %d, out %d, ws %zu); nothing launched\n", n_in, out_size, ws_size); grid = -1; return; }
        int dev = 0, cus = 0;
        if (hipGetDevice(&dev) != hipSuccess || hipDeviceGetAttribute(&cus, hipDeviceAttributeMultiprocessorCount, dev) != hipSuccess) { grid = -1; return; }
        if (hipFuncSetAttribute((const void*)mega_fwd, hipFuncAttributeMaxDynamicSharedMemorySize, LDS_BYTES) != hipSuccess) { fprintf(stderr, "kernel_launch: hipFuncSetAttribute failed\n"); grid = -1; return; }
        (void)hipGetLastError();
        grid = cus;
    }
    if (grid < 0) return;
    if (hipMemsetAsync((char*)d_ws + WS_CTL, 0, CTL_ZERO_BYTES, stream) != hipSuccess) { fprintf(stderr, "kernel_launch: hipMemsetAsync failed\n"); return; }
    Args a{};
    for (int i = 0; i < 9; ++i) a.in[i] = (const float*)d_in[i];
    a.out = (float*)d_out; a.ws = (unsigned char*)d_ws;
    hipLaunchKernelGGL(mega_fwd, dim3(grid), dim3(NWAVES * 64), LDS_BYTES, stream, a);
}
```

```cpp
#include <hip/hip_runtime.h>
#include <cstdio>
#include <cstdint>
#include <cmath>
#define KSWZ 1
namespace pg8 {
#define PG8_LAS __attribute__((address_space(3)))
typedef unsigned short bf16_t;
typedef short bf16x8 __attribute__((ext_vector_type(8)));
typedef float f32x4 __attribute__((ext_vector_type(4)));
typedef unsigned u32x4 __attribute__((ext_vector_type(4)));
constexpr int BM = 256, BK = 64, HALF = 128, HTB = HALF * BK * 2  , STAGE_BYTES = 8 * HTB, NXCD = 8, WGM = 8;

__host__ __device__ __forceinline__ int lds_byte(int r, int c) { const int st = (r >> 4) * 2 + (c >> 5), rr = r & 15, cc = c & 31, ob = rr * 64 + cc * 2; return st * 1024 + (ob ^ (((ob >> 9) & 1) << 5)); }
__host__ __device__ __forceinline__ void stage_rc(int b, int& R, int& C) { const int st = b / 1024, sb = b % 1024, swz = sb ^ (((sb >> 9) & 1) << 5); R = (st >> 1) * 16 + swz / 64; C = (st & 1) * 32 + (swz % 64) / 2; }
__host__ __device__ __forceinline__ int perm32(int rho) { const int n = rho >> 4, i = rho & 15; return 8 * (i >> 2) + 4 * n + (i & 3); }

struct Unit { int pm, pn; };
struct Gemm { const bf16_t* A; const bf16_t* Bt; int M, N, K; };

struct StaticOrder {
    int nM, nN, nwg, G, c;
    __host__ __device__ void init(int M, int N, int G_, int c_) { nM = M / BM; nN = N / BM; nwg = nM * nN; G = G_; c = c_; }
    __host__ __device__ bool next(int i, Unit& u) const {
        const long L = (long)i * G + c; if (L >= nwg) return false;
        int wgid = (int)L; { const int q = nwg / NXCD, r = nwg % NXCD, xcd = wgid % NXCD, off = wgid / NXCD; wgid = (xcd < r ? xcd * (q + 1) : r * (q + 1) + (xcd - r) * q) + off; }
        const int nig = WGM * nN, gid = wgid / nig, fm = gid * WGM, gsz = (nM - fm) < WGM ? (nM - fm) : WGM;
        u.pm = fm + ((wgid % nig) % gsz); u.pn = (wgid % nig) / gsz; return true;
    }
    __device__ __forceinline__ void a_ready(const Unit&) const {}
    __device__ __forceinline__ void done(const Unit&) const {}
};
__device__ __forceinline__ unsigned cvt_pk_bf16(float lo, float hi) { unsigned r; asm volatile("v_cvt_pk_bf16_f32 %0, %1, %2" : "=v"(r) : "v"(lo), "v"(hi)); return r; }
typedef float f32x2 __attribute__((ext_vector_type(2)));
typedef float f32x2 __attribute__((ext_vector_type(2)));
constexpr int SEQ_ = 4096;
constexpr float C2_ = 0.18033688011112042f, LOG2E_ = 1.4426950408889634f;
__device__ __forceinline__ u32x4 pack8(const f32x4& a, const f32x4& b) { u32x4 w; w.x = cvt_pk_bf16(a[0], a[1]); w.y = cvt_pk_bf16(a[2], a[3]); w.z = cvt_pk_bf16(b[0], b[1]); w.w = cvt_pk_bf16(b[2], b[3]); return w; }
__device__ __forceinline__ void store_row_pair(bf16_t* rowp, size_t pitch, int fr, u32x4 w0, u32x4 w1) {
    const bool odd = fr & 1;
    const u32x4 snd = odd ? w0 : w1;
    u32x4 rcv;
#pragma unroll
    for (int k = 0; k < 4; ++k) rcv[k] = (unsigned)__shfl_xor((int)snd[k], 1);
    const u32x4 A = odd ? rcv : w0, B = odd ? w1 : rcv;
    bf16_t* pa = odd ? rowp - pitch + 32 : rowp;
    bf16_t* pb = odd ? rowp + 32 : rowp + pitch;
    *(u32x4*)pa = A; *(u32x4*)pb = B;
}
struct EpiIn {
    static constexpr bool PERM = true, AFTER_DRAIN = false, REPME = true; static constexpr int NSTORE = 16;
    bf16_t *QA, *KA, *VA, *GA, *QB, *KB, *VB, *GB;
    const float *qna, *kna, *qnb, *knb, *cosT, *sinT;
    __device__ __forceinline__ void init(f32x4 (&acc)[2][2][4][2], const Unit&, int, int, int, int) const {
#pragma unroll
        for (int a = 0; a < 2; ++a)
#pragma unroll
            for (int b = 0; b < 2; ++b)
#pragma unroll
                for (int m = 0; m < 4; ++m)
#pragma unroll
                    for (int n = 0; n < 2; ++n) acc[a][b][m][n] = (f32x4){0.f, 0.f, 0.f, 0.f};
    }
    __device__ __forceinline__ void operator()(const f32x4 (&acc)[2][2][4][2], const Unit& u, int wr, int wc, int fr, int fq) const {
        const int g = u.pn * 4 + wc;
        int type, head, H = 8; const float* ng = qna; bf16_t* dst; float scale = 1.f;
        if (g < 8) { type = 0; head = g; ng = qna; dst = QA; scale = C2_; }
        else if (g < 10) { type = 0; head = g - 8; ng = kna; dst = KA; H = 2; }
        else if (g < 12) { type = 1; head = g - 10; dst = VA; H = 2; }
        else if (g < 20) { type = 2; head = g - 12; dst = GA; }
        else if (g < 28) { type = 0; head = g - 20; ng = qnb; dst = QB; scale = C2_; }
        else if (g < 36) { type = 0; head = g - 28; ng = knb; dst = KB; }
        else if (g < 44) { type = 1; head = g - 36; dst = VB; }
        else { type = 2; head = g - 44; dst = GB; }
        const int row0 = u.pm * BM + wr * 64 + fr;
        if (type == 0) {
            f32x4 gv[2][2], c16[2], s16[2], cb[2][2], sb[2][2];
            const int tb = (row0 & (SEQ_ - 1));
#pragma unroll
            for (int n = 0; n < 2; ++n) {
                c16[n] = *(const f32x4*)(cosT + 16 * 32 + 8 * fq + 4 * n); s16[n] = *(const f32x4*)(sinT + 16 * 32 + 8 * fq + 4 * n);
#pragma unroll
                for (int ai = 0; ai < 2; ++ai) { cb[ai][n] = *(const f32x4*)(cosT + (tb + ai * HALF) * 32 + 8 * fq + 4 * n); sb[ai][n] = *(const f32x4*)(sinT + (tb + ai * HALF) * 32 + 8 * fq + 4 * n); }
#pragma unroll
                for (int bj = 0; bj < 2; ++bj) gv[bj][n] = *(const f32x4*)(ng + 32 * bj + 8 * fq + 4 * n);
            }
#pragma unroll
            for (int ai = 0; ai < 2; ++ai) {
                f32x4 cs[2] = {cb[ai][0], cb[ai][1]}, sn[2] = {sb[ai][0], sb[ai][1]};
#pragma unroll
                for (int m = 0; m < 4; ++m) {
                    const int row = row0 + ai * HALF + m * 16, b = row >> 12, t = row & (SEQ_ - 1);
                    float ss = 0.f;
#pragma unroll
                    for (int bj = 0; bj < 2; ++bj)
#pragma unroll
                        for (int n = 0; n < 2; ++n) { const f32x4 x = acc[ai][bj][m][n]; ss += (x[0] * x[0] + x[1] * x[1]) + (x[2] * x[2] + x[3] * x[3]); }
                    ss += __shfl_xor(ss, 16); ss += __shfl_xor(ss, 32);
                    const float rs = rsqrtf(ss * (1.f / 64.f) + 1e-6f) * scale;
                    f32x4 o1[2], o2[2];
#pragma unroll
                    for (int n = 0; n < 2; ++n) {
                        const f32x4 n1 = acc[ai][0][m][n] * rs * gv[0][n], n2 = acc[ai][1][m][n] * rs * gv[1][n];
                        o1[n] = n1 * cs[n] - n2 * sn[n]; o2[n] = n2 * cs[n] + n1 * sn[n];
                        const f32x4 cn = cs[n] * c16[n] - sn[n] * s16[n], sn2 = sn[n] * c16[n] + cs[n] * s16[n];
                        cs[n] = cn; sn[n] = sn2;
                    }
                    bf16_t* p = dst + ((size_t)(b * H + head) * SEQ_ + t) * 64 + 8 * fq;
                    *(u32x4*)p = pack8(o1[0], o1[1]); *(u32x4*)(p + 32) = pack8(o2[0], o2[1]);
                }
            }
        } else if (type == 1) {
#pragma unroll
            for (int ai = 0; ai < 2; ++ai)
#pragma unroll
                for (int m = 0; m < 4; ++m) {
                    const int row = row0 + ai * HALF + m * 16, b = row >> 12, t = row & (SEQ_ - 1);
                    bf16_t* p = dst + ((size_t)(b * H + head) * SEQ_ + t) * 64 + 8 * fq;
                    *(u32x4*)p = pack8(acc[ai][0][m][0], acc[ai][0][m][1]); *(u32x4*)(p + 32) = pack8(acc[ai][1][m][0], acc[ai][1][m][1]);
                }
        } else {
#pragma unroll
            for (int ai = 0; ai < 2; ++ai)
#pragma unroll
                for (int m = 0; m < 4; ++m) {
                    const int row = row0 + ai * HALF + m * 16;
                    bf16_t* p = dst + (size_t)row * 512 + head * 64 + 8 * fq;
                    u32x4 wq[2];
#pragma unroll
                    for (int bj = 0; bj < 2; ++bj) {
                        f32x4 s[2];
#pragma unroll
                        for (int n = 0; n < 2; ++n) { const f32x4 v = acc[ai][bj][m][n];
#pragma unroll
                            for (int e = 0; e < 4; ++e) s[n][e] = v[e] * __builtin_amdgcn_rcpf(1.f + __builtin_amdgcn_exp2f(-v[e] * LOG2E_)); }
                        wq[bj] = pack8(s[0], s[1]);
                    }
                    *(u32x4*)p = wq[0]; *(u32x4*)(p + 32) = wq[1];
                }
        }
    }
};
struct EpiRes {
    static constexpr bool PERM = true, AFTER_DRAIN = false, REPME = false; static constexpr int NSTORE = 32;
    const float* x; float* out;
    __device__ __forceinline__ void init(f32x4 (&acc)[2][2][4][2], const Unit&, int, int, int, int) const {
#pragma unroll
        for (int a = 0; a < 2; ++a)
#pragma unroll
            for (int b = 0; b < 2; ++b)
#pragma unroll
                for (int m = 0; m < 4; ++m)
#pragma unroll
                    for (int n = 0; n < 2; ++n) acc[a][b][m][n] = (f32x4){0.f, 0.f, 0.f, 0.f};
    }
    __device__ __forceinline__ void operator()(const f32x4 (&acc)[2][2][4][2], const Unit& u, int wr, int wc, int fr, int fq) const {
        const int row0 = u.pm * BM + wr * 64 + fr, col0 = u.pn * BM + wc * 32 + 8 * fq;
#pragma unroll
        for (int ai = 0; ai < 2; ++ai)
#pragma unroll
            for (int m = 0; m < 4; ++m) {
                const size_t off = (size_t)(row0 + ai * HALF + m * 16) * 1024 + col0;
#pragma unroll
                for (int bj = 0; bj < 2; ++bj) {
                    const f32x4 a = *(const f32x4*)(x + off + bj * HALF), b = *(const f32x4*)(x + off + bj * HALF + 4);
                    *(f32x4*)(out + off + bj * HALF) = a + acc[ai][bj][m][0]; *(f32x4*)(out + off + bj * HALF + 4) = b + acc[ai][bj][m][1];
                }
            }
    }
};

struct EpiNone {
    static constexpr bool PERM = true, AFTER_DRAIN = false, REPME = false; static constexpr int NSTORE = 0;
    __device__ __forceinline__ void init(f32x4 (&acc)[2][2][4][2], const Unit&, int, int, int, int) const {
#pragma unroll
        for (int a = 0; a < 2; ++a)
#pragma unroll
            for (int b = 0; b < 2; ++b)
#pragma unroll
                for (int m = 0; m < 4; ++m)
#pragma unroll
                    for (int n = 0; n < 2; ++n) acc[a][b][m][n] = (f32x4){0.f, 0.f, 0.f, 0.f};
    }
    __device__ __forceinline__ void operator()(const f32x4 (&acc)[2][2][4][2], const Unit&, int, int, int, int) const {
#pragma unroll
        for (int a = 0; a < 2; ++a)
#pragma unroll
            for (int b = 0; b < 2; ++b)
#pragma unroll
                for (int m = 0; m < 4; ++m)
#pragma unroll
                    for (int n = 0; n < 2; ++n) asm volatile("" :: "v"(acc[a][b][m][n]));
    }
};
struct SameTileOrder : StaticOrder {
    __host__ __device__ bool next(int i, Unit& u) const { if (!StaticOrder::next(i, u)) return false; u.pm = 0; u.pn = 0; return true; }
};
template <class Epi, class Sched, bool ALIGN_EPI = false, bool SP2 = false>
__device__ __forceinline__ void gemm_phase(PG8_LAS unsigned char* lds, const Gemm g, const Sched& S, const Epi& E) {
    int tid_ = threadIdx.x; asm volatile("" : "+v"(tid_));
    const int tid = tid_, wid = __builtin_amdgcn_readfirstlane(tid >> 6), lane = tid & 63, wr = wid >> 2, wc = wid & 3, fr = lane & 15, fq = lane >> 4;
    const int K = g.K, nt = K / BK;
    unsigned voffA[2], voffB[2];
#pragma unroll
    for (int i = 0; i < 2; ++i) { int R, C; stage_rc(tid * 16 + i * 8192, R, C); const int Rb = Epi::PERM ? ((R & ~31) + perm32(R & 31)) : R;
        voffA[i] = (unsigned)(R * K + C) * 2u; voffB[i] = (unsigned)(Rb * K + C) * 2u; }
    const size_t kstep = (size_t)(BK * 2);
    const size_t hstep = (size_t)HALF * K * 2;
    const size_t tstep = 2 * hstep;
    const unsigned ldsw = (unsigned)wid * 1024u;
    const int aoff = lds_byte(wr * 64 + fr, fq * 8), boff = lds_byte(wc * 32 + fr, fq * 8);
#define PG8_SA(b, h) (((b) * 2 + (h)) * HTB)
#define PG8_SB(b, h) ((4 + (b) * 2 + (h)) * HTB)
#define PG8_STAGE(bufoff, gbase, voff) do { _Pragma("unroll") for (int _i = 0; _i < 2; ++_i) \
        __builtin_amdgcn_global_load_lds((const unsigned*)((const char*)(gbase) + (voff)[_i]), (PG8_LAS unsigned*)(lds + (bufoff) + ldsw + _i * 8192), 16, 0, 0); } while (0)
#define PG8_LDA(dst, b, h) do { _Pragma("unroll") for (int m = 0; m < 4; ++m) _Pragma("unroll") for (int k = 0; k < 2; ++k) dst[m][k] = *(const PG8_LAS bf16x8*)(lds + PG8_SA(b, h) + aoff + m * 2048 + k * 1024); } while (0)
#define PG8_LDB(dst, b, h) do { _Pragma("unroll") for (int n = 0; n < 2; ++n) _Pragma("unroll") for (int k = 0; k < 2; ++k) dst[n][k] = *(const PG8_LAS bf16x8*)(lds + PG8_SB(b, h) + boff + n * 2048 + k * 1024); } while (0)
#define PG8_MMA(ai, bj, At, Bt) do { __builtin_amdgcn_s_setprio(1); _Pragma("unroll") for (int m = 0; m < 4; ++m) _Pragma("unroll") for (int n = 0; n < 2; ++n) _Pragma("unroll") for (int k = 0; k < 2; ++k) \
        acc[ai][bj][m][n] = __builtin_amdgcn_mfma_f32_16x16x32_bf16(Bt[n][k], At[m][k], acc[ai][bj][m][n], 0, 0, 0); __builtin_amdgcn_s_setprio(0); } while (0)
#define PG8_WAIT_V(n) asm volatile("s_waitcnt vmcnt(" #n ")" ::: "memory")
#define PG8_WAIT_V8S() do { if (Epi::NSTORE == 16) PG8_WAIT_V(24); else if (Epi::NSTORE == 32) PG8_WAIT_V(40); else PG8_WAIT_V(8); } while (0)
#define PG8_WAIT_L(n) asm volatile("s_waitcnt lgkmcnt(" #n ")" ::: "memory")
#define PG8_BAR __builtin_amdgcn_s_barrier()
#define PG8_SCHED __builtin_amdgcn_sched_barrier(0)
    Unit cur, nxt; int ui = 0;
    if (!S.next(0, cur)) return;
    f32x4 acc[2][2][4][2];
    E.init(acc, cur, wr, wc, fr, fq);
    bf16x8 At[4][2], B0[2][2], B1[2][2];
    const char* cA = (const char*)g.A + (size_t)cur.pm * tstep; const char* cB = (const char*)g.Bt + (size_t)cur.pn * tstep;
    S.a_ready(cur);
    if constexpr (SP2) {
        PG8_STAGE(PG8_SB(0, 0), cB, voffB); PG8_STAGE(PG8_SB(0, 1), cB + hstep, voffB); PG8_STAGE(PG8_SA(0, 0), cA, voffA); PG8_STAGE(PG8_SA(0, 1), cA + hstep, voffA);
        if (wr == 1) PG8_BAR;
        PG8_WAIT_V(2); PG8_BAR;
        PG8_STAGE(PG8_SB(1, 0), cB + kstep, voffB); PG8_STAGE(PG8_SA(1, 0), cA + kstep, voffA); PG8_STAGE(PG8_SB(1, 1), cB + hstep + kstep, voffB);
        PG8_WAIT_V(6); PG8_BAR;
    } else {
        PG8_STAGE(PG8_SB(0, 0), cB, voffB); PG8_STAGE(PG8_SA(0, 0), cA, voffA); PG8_STAGE(PG8_SB(0, 1), cB + hstep, voffB); PG8_STAGE(PG8_SA(0, 1), cA + hstep, voffA);
        if (wr == 1) PG8_BAR;
        PG8_WAIT_V(4); PG8_BAR;
        PG8_STAGE(PG8_SB(1, 0), cB + kstep, voffB); PG8_STAGE(PG8_SA(1, 0), cA + kstep, voffA); PG8_STAGE(PG8_SB(1, 1), cB + hstep + kstep, voffB);
        PG8_WAIT_V(6); PG8_BAR;
    }
    for (;;) {
        const bool has_next = S.next(ui + 1, nxt);
        const char* nA = has_next ? (const char*)g.A + (size_t)nxt.pm * tstep : cA; const char* nB = has_next ? (const char*)g.Bt + (size_t)nxt.pn * tstep : cB;
        for (int t = 0; t < nt; t += 2) {
            const bool last = (t == nt - 2);
            const char* a1 = cA + (size_t)(t + 1) * kstep;
            const char* a2 = last ? nA : cA + (size_t)(t + 2) * kstep; const char* b2 = last ? nB : cB + (size_t)(t + 2) * kstep;
            const char* a3 = a2 + kstep; const char* b3 = b2 + kstep;
            if (last && has_next) S.a_ready(nxt);
            if constexpr (SP2) {
            PG8_LDB(B0, 0, 0); PG8_LDB(B1, 0, 1); PG8_SCHED; PG8_LDA(At, 0, 0); PG8_STAGE(PG8_SA(1, 1), a1 + hstep, voffA);
            PG8_WAIT_V(8); PG8_WAIT_L(0); PG8_BAR; PG8_MMA(0, 0, At, B0); PG8_MMA(0, 1, At, B1); PG8_BAR; PG8_SCHED;
            PG8_LDA(At, 0, 1); PG8_STAGE(PG8_SB(0, 0), b2, voffB); PG8_STAGE(PG8_SB(0, 1), b2 + hstep, voffB); PG8_STAGE(PG8_SA(0, 0), a2, voffA);
            PG8_WAIT_V(8); PG8_WAIT_L(0); PG8_BAR; PG8_MMA(1, 0, At, B0); PG8_MMA(1, 1, At, B1); PG8_BAR; PG8_SCHED;
            PG8_LDB(B0, 1, 0); PG8_LDB(B1, 1, 1); PG8_SCHED; PG8_LDA(At, 1, 0); PG8_STAGE(PG8_SA(0, 1), a2 + hstep, voffA);
            PG8_WAIT_V(8); PG8_WAIT_L(0); PG8_BAR; PG8_MMA(0, 0, At, B0); PG8_MMA(0, 1, At, B1); PG8_BAR; PG8_SCHED;
            PG8_LDA(At, 1, 1); PG8_STAGE(PG8_SB(1, 0), b3, voffB); PG8_STAGE(PG8_SB(1, 1), b3 + hstep, voffB); PG8_STAGE(PG8_SA(1, 0), a3, voffA);
            PG8_WAIT_V(8); PG8_WAIT_L(0); PG8_BAR; PG8_MMA(1, 0, At, B0); PG8_MMA(1, 1, At, B1); PG8_BAR; PG8_SCHED;
            } else {
            PG8_LDB(B0, 0, 0); PG8_SCHED; PG8_LDA(At, 0, 0); PG8_STAGE(PG8_SA(1, 1), a1 + hstep, voffA);
            PG8_WAIT_L(8); PG8_BAR; PG8_WAIT_L(0); PG8_MMA(0, 0, At, B0); PG8_BAR; PG8_SCHED;
            PG8_LDB(B1, 0, 1); PG8_STAGE(PG8_SB(0, 0), b2, voffB);
            PG8_BAR; PG8_WAIT_L(0); PG8_MMA(0, 1, At, B1); PG8_BAR;
            PG8_LDA(At, 0, 1); PG8_STAGE(PG8_SA(0, 0), a2, voffA);
            PG8_BAR; PG8_WAIT_L(0); PG8_MMA(1, 0, At, B0); PG8_BAR; PG8_SCHED;
            PG8_STAGE(PG8_SB(0, 1), b2 + hstep, voffB);
            PG8_WAIT_V(6); PG8_BAR; PG8_MMA(1, 1, At, B1); PG8_BAR;
            PG8_LDB(B0, 1, 0); PG8_SCHED; PG8_LDA(At, 1, 0); PG8_STAGE(PG8_SA(0, 1), a2 + hstep, voffA);
            PG8_WAIT_L(8); PG8_BAR; PG8_WAIT_L(0); PG8_MMA(0, 0, At, B0); PG8_BAR; PG8_SCHED;
            PG8_LDB(B1, 1, 1); PG8_STAGE(PG8_SB(1, 0), b3, voffB);
            PG8_BAR; PG8_WAIT_L(0); PG8_MMA(0, 1, At, B1); PG8_BAR;
            PG8_LDA(At, 1, 1); PG8_STAGE(PG8_SA(1, 0), a3, voffA);
            PG8_BAR; PG8_WAIT_L(0); PG8_MMA(1, 0, At, B0); PG8_BAR; PG8_SCHED;
            PG8_STAGE(PG8_SB(1, 1), b3 + hstep, voffB);
            PG8_WAIT_V(6); PG8_BAR; PG8_MMA(1, 1, At, B1); PG8_BAR;
            }
        }
        if constexpr (ALIGN_EPI) { if (wr == 0) PG8_BAR; }
        if constexpr (!Epi::AFTER_DRAIN) { E(acc, cur, wr, wc, fr, fq); S.done(cur); }
        if (!has_next) break;
        E.init(acc, nxt, wr, wc, fr, fq);
        cur = nxt; cA = nA; cB = nB; ++ui;
        if constexpr (ALIGN_EPI) { if (wr == 1) PG8_BAR; }
    }
    PG8_WAIT_V(0);
    if constexpr (!ALIGN_EPI) { if (wr == 0) PG8_BAR; }
    PG8_BAR;
    if constexpr (Epi::AFTER_DRAIN) { E.fused(acc, cur, wr, wc, fr, fq, lds, wid, lane); S.done(cur); }
#undef PG8_SA
#undef PG8_SB
#undef PG8_STAGE
#undef PG8_LDA
#undef PG8_LDB
#undef PG8_MMA
#undef PG8_WAIT_V
#undef PG8_WAIT_V8S
#undef PG8_WAIT_L
#undef PG8_BAR
#undef PG8_SCHED
}
}
namespace att {
#ifndef KSWZ
#define KSWZ 0
#endif
typedef short bf16x8 __attribute__((ext_vector_type(8)));
typedef short s16x4 __attribute__((ext_vector_type(4)));
typedef short v4i16_t __attribute__((ext_vector_type(4)));
typedef float f32x16 __attribute__((ext_vector_type(16)));
typedef float f32x4 __attribute__((ext_vector_type(4)));
typedef unsigned u32x4 __attribute__((ext_vector_type(4)));
typedef float f32x2_t __attribute__((ext_vector_type(2))); typedef __bf16 bf16x2_t __attribute__((ext_vector_type(2)));
typedef __attribute__((address_space(3))) unsigned char* lds_ptr;
__device__ __forceinline__ unsigned cvtpk_s(float lo, float hi) { f32x2_t v = {lo, hi}; bf16x2_t b = __builtin_convertvector(v, bf16x2_t); return __builtin_bit_cast(unsigned, b); }
__device__ __forceinline__ int crow(int r, int hi) { return (r & 3) + 8 * (r >> 2) + 4 * hi; }
__device__ __forceinline__ s16x4 vtr(lds_ptr p) { return __builtin_bit_cast(s16x4, __builtin_amdgcn_ds_read_tr16_b64_v4i16((__attribute__((address_space(3))) v4i16_t*)p)); }
#define ATT_WAITV(n) asm volatile("s_waitcnt vmcnt(" #n ")" ::: "memory")
__device__ __forceinline__ void glds16(const void* gsrc, unsigned lds_dst) { unsigned keep;
    asm volatile("s_mov_b32 %0, m0\n\ts_mov_b32 m0, %2\n\ts_nop 0\n\tglobal_load_lds_dwordx4 %1, off\n\ts_mov_b32 m0, %0" : "=&s"(keep) : "v"(gsrc), "s"(lds_dst) : "memory"); }
#define ATT_GLDS(src, dst) glds16((src), (unsigned)__builtin_amdgcn_readfirstlane((int)(dst)))

struct Desc {
    const unsigned short *Q0, *Q1, *K, *V;
    int dil, r, qt0, qt1;
    unsigned short* po; float* pl;
    const unsigned short *po_a, *po_b; const float *pl_a, *pl_b;
    const unsigned short *gate0, *gate1; unsigned short *mix0, *mix1;
    float sink0, sink1;
};
struct LaneK { unsigned koff[4], voff[4]; };
__device__ __forceinline__ LaneK lane_offsets(int dil, int lane) {
    LaneK L;
#pragma unroll
    for (int i = 0; i < 4; ++i) {
        const int row = 8 * i + (lane >> 3), chunk = (lane & 7) ^ (KSWZ ? ((row >> 1) & 7) : 0);
        L.koff[i] = (unsigned)(dil * row) * 128u + (unsigned)chunk * 16u;
        const int vrow = 16 * (i & 1) + (lane >> 2);
        L.voff[i] = (unsigned)(dil * vrow) * 128u + (unsigned)(i >> 1) * 64u + (unsigned)(lane & 3) * 16u;
    }
    return L;
}
#define ATT_DMA_K(D, L, ktlo, j, sl) do { const char* s_ = (const char*)(D).K + (size_t)(D).r * 128 + (size_t)((ktlo) + (j)) * ((size_t)(D).dil * 4096); const unsigned d_ = ring0 + ((sl) & 1) * 8192; \
        ATT_GLDS(s_ + (L).koff[0], d_); ATT_GLDS(s_ + (L).koff[1], d_ + 1024); ATT_GLDS(s_ + (L).koff[2], d_ + 2048); ATT_GLDS(s_ + (L).koff[3], d_ + 3072); } while (0)
#define ATT_DMA_V(D, L, ktlo, j, sl) do { const char* s_ = (const char*)(D).V + (size_t)(D).r * 128 + (size_t)((ktlo) + (j)) * ((size_t)(D).dil * 4096); const unsigned d_ = ring0 + ((sl) & 1) * 8192 + 4096; \
        ATT_GLDS(s_ + (L).voff[0], d_); ATT_GLDS(s_ + (L).voff[1], d_ + 1024); ATT_GLDS(s_ + (L).voff[2], d_ + 2048); ATT_GLDS(s_ + (L).voff[3], d_ + 3072); } while (0)
template <int DRY = 0>
__device__ __forceinline__ void prefetch(const Desc& D, unsigned ring0, bf16x8 (&qr)[2][4], int lane, int par = 0) {
    const int q = lane & 31, hi = lane >> 5;
    const int ktlo = D.qt0 >= 4 ? D.qt0 - 4 : 0, nt = D.qt1 - ktlo + 1;
    const LaneK L = lane_offsets(D.dil, lane);
    { const unsigned short* q0 = D.Q0 + (size_t)(D.r + D.dil * (32 * D.qt0 + q)) * 64 + hi * 8; const unsigned short* q1 = D.Q1 + (size_t)(D.r + D.dil * (32 * D.qt1 + q)) * 64 + hi * 8;
#pragma unroll
      for (int d0 = 0; d0 < 4; ++d0) { qr[0][d0] = *(const bf16x8*)(q0 + d0 * 16); qr[1][d0] = *(const bf16x8*)(q1 + d0 * 16); } }
    asm volatile("s_waitcnt lgkmcnt(0)" ::: "memory");
    if (DRY != 2) { ATT_DMA_K(D, L, ktlo, 0, par); ATT_DMA_V(D, L, ktlo, 0, par);
    if (nt > 1) { ATT_DMA_K(D, L, ktlo, 1, par + 1); ATT_DMA_V(D, L, ktlo, 1, par + 1); } }
}
template <int MODE, int DRY = 0>
__device__ __forceinline__ void attn_item(lds_ptr ring, lds_ptr stage, const Desc& D, bool has_next, const Desc& N, bf16x8 (&qx)[2][4], int& par, int lane) {
    const int q = lane & 31, hi = lane >> 5;
    const int ktlo = D.qt0 >= 4 ? D.qt0 - 4 : 0, nt = D.qt1 - ktlo + 1;
    constexpr int DMIN = (MODE == 0) ? 1 : 0;
    const unsigned ring0 = (unsigned)(uintptr_t)ring;
    const LaneK L = lane_offsets(D.dil, lane);
    const int krow = q * 128, ksw = KSWZ ? ((q >> 1) & 7) : 0;
    const int vb = ((lane >> 4) & 1) * 32 + (lane & 3) * 8 + (4 * hi + ((lane & 15) >> 2)) * 64;
    f32x16 o00 = {}, o01 = {}, o10 = {}, o11 = {}; float ls0 = 0.f, ls1 = 0.f;
    asm volatile("s_waitcnt vmcnt(0)" ::: "memory");
    bf16x8 qr[2][4];
#pragma unroll
    for (int s_ = 0; s_ < 2; ++s_)
#pragma unroll
        for (int d0 = 0; d0 < 4; ++d0) qr[s_][d0] = qx[s_][d0];
    asm volatile("" : "+v"(qr[0][0]), "+v"(qr[0][1]), "+v"(qr[0][2]), "+v"(qr[0][3]), "+v"(qr[1][0]), "+v"(qr[1][1]), "+v"(qr[1][2]), "+v"(qr[1][3]));
    const int Nktlo = N.qt0 >= 4 ? N.qt0 - 4 : 0, Nnt = N.qt1 - Nktlo + 1;
    const bool ext = (DRY == 0) && has_next && nt >= 2 && N.dil == D.dil;
    const int nx = ext ? (Nnt < 2 ? Nnt : 2) : 0;
    for (int j = 0; j < nt; ++j) {
        const int e = nt - 1 - j + nx, kt = ktlo + j; lds_ptr slot = ring + ((j + par) & 1) * 8192;
        const bool act0 = (kt <= D.qt0), act1 = (kt >= D.qt1 - 4);
        if (DRY != 2) { if (e >= 1) ATT_WAITV(12); else ATT_WAITV(4); }
        bf16x8 kf[4];
        if (DRY != 1) {
#pragma unroll
        for (int ks = 0; ks < 4; ++ks) kf[ks] = *(const __attribute__((address_space(3))) bf16x8*)(slot + krow + (((2 * ks + hi) ^ ksw) * 16));
        asm volatile("s_waitcnt lgkmcnt(0)" ::: "memory");
        asm volatile("" : "+v"(kf[0]), "+v"(kf[1]), "+v"(kf[2]), "+v"(kf[3]));
        }
        if (DRY != 2 && e >= 2) { if (j + 2 < nt) ATT_DMA_K(D, L, ktlo, j + 2, j + par); else ATT_DMA_K(N, L, Nktlo, j + 2 - nt, j + par); }
        u32x4 pa0 = {}, pa1 = {}, pb0 = {}, pb1 = {};
#define ATT_SCORE(S, QT, ACT, LS, PW0, PW1) if (ACT) { f32x16 p = {}; \
            _Pragma("unroll") for (int ks = 0; ks < 4; ++ks) p = __builtin_amdgcn_mfma_f32_32x32x16_bf16(kf[ks], qr[S][ks], p, 0, 0, 0); \
            const bool first = (kt == (QT) - 4), last = (kt == (QT)); \
            if (first || last) { _Pragma("unroll") for (int rr = 0; rr < 16; ++rr) { const int kk = crow(rr, hi); const bool bad = (first && kk < q + DMIN) || (last && kk > q); if (bad) p[rr] = -INFINITY; } } \
            float s_ = 0.f; \
            _Pragma("unroll") for (int rr = 0; rr < 16; ++rr) { p[rr] = __builtin_amdgcn_exp2f(p[rr]); s_ += p[rr]; } \
            LS += s_; \
            PW0[0] = cvtpk_s(p[0], p[1]); PW0[1] = cvtpk_s(p[2], p[3]); PW0[2] = cvtpk_s(p[4], p[5]); PW0[3] = cvtpk_s(p[6], p[7]); \
            PW1[0] = cvtpk_s(p[8], p[9]); PW1[1] = cvtpk_s(p[10], p[11]); PW1[2] = cvtpk_s(p[12], p[13]); PW1[3] = cvtpk_s(p[14], p[15]); }
        if (DRY != 1) {
        ATT_SCORE(0, D.qt0, act0, ls0, pa0, pa1)
        ATT_SCORE(1, D.qt1, act1, ls1, pb0, pb1)
        }
#undef ATT_SCORE
        if (DRY != 2) { if (e >= 2) ATT_WAITV(12); else if (e == 1) ATT_WAITV(8); else ATT_WAITV(0); }
        if (DRY != 1) {
        lds_ptr vp = slot + 4096 + vb;
        s16x4 lo[4], hh[4];
#pragma unroll
        for (int i = 0; i < 4; ++i) { lo[i] = vtr(vp + i * 1024); hh[i] = vtr(vp + i * 1024 + 512); }
#define ATT_VFR(i) (bf16x8){lo[i][0], lo[i][1], lo[i][2], lo[i][3], hh[i][0], hh[i][1], hh[i][2], hh[i][3]}
        if (act0) {
            o00 = __builtin_amdgcn_mfma_f32_32x32x16_bf16(__builtin_bit_cast(bf16x8, pa0), ATT_VFR(0), o00, 0, 0, 0);
            o00 = __builtin_amdgcn_mfma_f32_32x32x16_bf16(__builtin_bit_cast(bf16x8, pa1), ATT_VFR(1), o00, 0, 0, 0);
            o01 = __builtin_amdgcn_mfma_f32_32x32x16_bf16(__builtin_bit_cast(bf16x8, pa0), ATT_VFR(2), o01, 0, 0, 0);
            o01 = __builtin_amdgcn_mfma_f32_32x32x16_bf16(__builtin_bit_cast(bf16x8, pa1), ATT_VFR(3), o01, 0, 0, 0);
        }
        if (act1) {
            o10 = __builtin_amdgcn_mfma_f32_32x32x16_bf16(__builtin_bit_cast(bf16x8, pb0), ATT_VFR(0), o10, 0, 0, 0);
            o10 = __builtin_amdgcn_mfma_f32_32x32x16_bf16(__builtin_bit_cast(bf16x8, pb1), ATT_VFR(1), o10, 0, 0, 0);
            o11 = __builtin_amdgcn_mfma_f32_32x32x16_bf16(__builtin_bit_cast(bf16x8, pb0), ATT_VFR(2), o11, 0, 0, 0);
            o11 = __builtin_amdgcn_mfma_f32_32x32x16_bf16(__builtin_bit_cast(bf16x8, pb1), ATT_VFR(3), o11, 0, 0, 0);
        }
#undef ATT_VFR
        }
        asm volatile("s_waitcnt lgkmcnt(0)" ::: "memory");
        if (DRY != 2 && e >= 2) { if (j + 2 < nt) ATT_DMA_V(D, L, ktlo, j + 2, j + par); else ATT_DMA_V(N, L, Nktlo, j + 2 - nt, j + par); }
    }
    int lane_s = lane; asm volatile("" : "+v"(lane_s));
    {
    const int lane = lane_s, q = lane & 31, hi = lane >> 5;
    __attribute__((address_space(3))) unsigned short* st = (__attribute__((address_space(3))) unsigned short*)stage;
    u32x4 g0[4], a0[4], b0[4]; float la0[4], lb0[4];
#define ATT_EPI_T(QT, pp) ((size_t)(D.r + D.dil * (32 * (QT) + 16 * ((pp) >> 1) + 8 * ((pp) & 1) + (lane >> 3))))
#define ATT_EPI_LOAD(QT, G, A, B, LA, LB, GATE) do { _Pragma("unroll") for (int pp = 0; pp < 4; ++pp) { const size_t t = ATT_EPI_T(QT, pp); const int ch = lane & 7; \
        G[pp] = *(const u32x4*)((GATE) + t * 512 + ch * 8); \
        if (MODE == 2) { A[pp] = __builtin_nontemporal_load((const u32x4*)(D.po_a + t * 64 + ch * 8)); B[pp] = __builtin_nontemporal_load((const u32x4*)(D.po_b + t * 64 + ch * 8)); \
                         LA[pp] = __builtin_nontemporal_load(D.pl_a + t); LB[pp] = __builtin_nontemporal_load(D.pl_b + t); } } } while (0)
#define ATT_EPI_TOUCH(G, A, B, LA, LB) do { asm volatile("" : "+v"(G[0]), "+v"(G[1]), "+v"(G[2]), "+v"(G[3])); \
        if (MODE == 2) { asm volatile("" : "+v"(A[0]), "+v"(A[1]), "+v"(A[2]), "+v"(A[3]), "+v"(B[0]), "+v"(B[1]), "+v"(B[2]), "+v"(B[3])); \
                         asm volatile("" : "+v"(LA[0]), "+v"(LA[1]), "+v"(LA[2]), "+v"(LA[3]), "+v"(LB[0]), "+v"(LB[1]), "+v"(LB[2]), "+v"(LB[3])); } } while (0)
#define ATT_EPI_PROC(QT, OA, OB, LS, G, A, B, LA, LB, MIX, SINK) do { \
        { auto sw_ = __builtin_amdgcn_permlane32_swap(__float_as_uint(LS), __float_as_uint(LS), false, false); LS = __uint_as_float(sw_[0]) + __uint_as_float(sw_[1]); } \
        _Pragma("unroll") for (int hf = 0; hf < 2; ++hf) { \
            _Pragma("unroll") for (int i8 = 0; i8 < 8; ++i8) { const int rl = crow(i8, hi); \
                st[rl * 64 + q] = (unsigned short)(cvtpk_s(OA[8 * hf + i8], 0.f) & 0xffffu); st[rl * 64 + 32 + q] = (unsigned short)(cvtpk_s(OB[8 * hf + i8], 0.f) & 0xffffu); } \
            _Pragma("unroll") for (int i2 = 0; i2 < 2; ++i2) { \
                const int pp = 2 * hf + i2, rl = 8 * i2 + (lane >> 3), ch = lane & 7, row = 16 * hf + rl; \
                const u32x4 ow = *(const __attribute__((address_space(3))) u32x4*)(st + rl * 64 + ch * 8); \
                float l = __shfl(LS, row); \
                const size_t t = ATT_EPI_T(QT, pp); \
                if (MODE == 1) { *(u32x4*)(D.po + t * 64 + ch * 8) = ow; if (ch == 0) D.pl[t] = l; } \
                else { \
                    float v[8]; \
                    _Pragma("unroll") for (int k = 0; k < 4; ++k) { v[2 * k] = __uint_as_float(ow[k] << 16); v[2 * k + 1] = __uint_as_float(ow[k] & 0xffff0000u); } \
                    if (MODE == 2) { \
                        l += LA[pp] + LB[pp]; \
                        _Pragma("unroll") for (int k = 0; k < 4; ++k) { v[2 * k] += __uint_as_float(A[pp][k] << 16) + __uint_as_float(B[pp][k] << 16); v[2 * k + 1] += __uint_as_float(A[pp][k] & 0xffff0000u) + __uint_as_float(B[pp][k] & 0xffff0000u); } \
                    } else l += (SINK); \
                    const float rl_ = 1.0f / l; \
                    u32x4 w; \
                    _Pragma("unroll") for (int k = 0; k < 4; ++k) w[k] = cvtpk_s(v[2 * k] * rl_ * __uint_as_float(G[pp][k] << 16), v[2 * k + 1] * rl_ * __uint_as_float(G[pp][k] & 0xffff0000u)); \
                    *(u32x4*)((MIX) + t * 1024 + ch * 8) = w; \
                } \
            } \
        } } while (0)
    if (DRY != 0) {
        asm volatile("" :: "v"(o00), "v"(o01), "v"(o10), "v"(o11), "v"(ls0), "v"(ls1));
        if (has_next) prefetch<DRY>(N, ring0, qx, lane, 0);
    } else if (MODE == 1) {
        if (has_next) { if (!ext) prefetch(N, ring0, qx, lane, 0); else { const unsigned short* q0_ = N.Q0 + (size_t)(N.r + N.dil * (32 * N.qt0 + q)) * 64 + hi * 8; const unsigned short* q1_ = N.Q1 + (size_t)(N.r + N.dil * (32 * N.qt1 + q)) * 64 + hi * 8;
            _Pragma("unroll") for (int d0 = 0; d0 < 4; ++d0) { qx[0][d0] = *(const bf16x8*)(q0_ + d0 * 16); qx[1][d0] = *(const bf16x8*)(q1_ + d0 * 16); } } }
        ATT_EPI_PROC(D.qt0, o00, o01, ls0, g0, a0, b0, la0, lb0, D.mix0, D.sink0);
        ATT_EPI_PROC(D.qt1, o10, o11, ls1, g0, a0, b0, la0, lb0, D.mix1, D.sink1);
    } else {
        ATT_EPI_LOAD(D.qt0, g0, a0, b0, la0, lb0, D.gate0);
        __builtin_amdgcn_sched_barrier(0);
        ATT_EPI_TOUCH(g0, a0, b0, la0, lb0);
        __builtin_amdgcn_sched_barrier(0);
        ATT_EPI_PROC(D.qt0, o00, o01, ls0, g0, a0, b0, la0, lb0, D.mix0, D.sink0);
        __builtin_amdgcn_sched_barrier(0);
        ATT_EPI_LOAD(D.qt1, g0, a0, b0, la0, lb0, D.gate1);
        __builtin_amdgcn_sched_barrier(0);
        if (has_next) { if (!ext) prefetch(N, ring0, qx, lane, 0); else { const unsigned short* q0_ = N.Q0 + (size_t)(N.r + N.dil * (32 * N.qt0 + q)) * 64 + hi * 8; const unsigned short* q1_ = N.Q1 + (size_t)(N.r + N.dil * (32 * N.qt1 + q)) * 64 + hi * 8;
            _Pragma("unroll") for (int d0 = 0; d0 < 4; ++d0) { qx[0][d0] = *(const bf16x8*)(q0_ + d0 * 16); qx[1][d0] = *(const bf16x8*)(q1_ + d0 * 16); } } }
        __builtin_amdgcn_sched_barrier(0);
        ATT_EPI_TOUCH(g0, a0, b0, la0, lb0);
        __builtin_amdgcn_sched_barrier(0);
        ATT_EPI_PROC(D.qt1, o10, o11, ls1, g0, a0, b0, la0, lb0, D.mix1, D.sink1);
    }
#undef ATT_EPI_T
#undef ATT_EPI_LOAD
#undef ATT_EPI_TOUCH
#undef ATT_EPI_PROC
    }
    par = ext ? ((par + nt) & 1) : 0;
}
#undef ATT_DMA_K
#undef ATT_DMA_V
#undef ATT_WAITV
#undef ATT_GLDS
}
#ifndef PG8_SP2
#define PG8_SP2 true
#endif
#ifndef PG8_ALIGN
#define PG8_ALIGN true
#endif
constexpr int NWAVES = 8;
constexpr int BATCH = 8, SEQ = 4096, DM = 1024, M = BATCH * SEQ, NIN = 3328, HD = 64;
constexpr float LOG2E = 1.4426950408889634f;
constexpr size_t MiB = 1u << 20;
constexpr size_t WS_CTL = 0, CTL_ZERO_BYTES = 64 * 1024;
constexpr size_t WS_COS = 1 * MiB, WS_SIN = WS_COS + 512 * 1024;
constexpr size_t WS_WIT = 2 * MiB, WS_WOT = 9 * MiB;
constexpr size_t WS_XN = 16 * MiB;
constexpr size_t WS_QA = 80 * MiB, WS_QB = 112 * MiB, WS_KA = 144 * MiB, WS_VA = 152 * MiB, WS_KB = 160 * MiB, WS_VB = 192 * MiB;
constexpr size_t WS_GA = 224 * MiB, WS_GB = 256 * MiB, WS_MIX = 288 * MiB, WS_PO16 = 352 * MiB, WS_PO4 = 384 * MiB, WS_PL16 = 416 * MiB, WS_PL4 = 417 * MiB, WS_END = 418 * MiB;
constexpr int CW_BAR = 1024;
constexpr int RING_OFF = 0, RING_BYTES = 131072;
constexpr int LDSCTL_OFF = RING_BYTES + 16384, MISC_OFF = LDSCTL_OFF + 320;
constexpr int LDS_BYTES = 149504;
static_assert(MISC_OFF + 128 <= LDS_BYTES, "LDS map");
#define GAS __attribute__((address_space(1)))
#define LAS __attribute__((address_space(3)))
typedef unsigned short bf16;
typedef unsigned v4u __attribute__((ext_vector_type(4)));
typedef float f32x4 __attribute__((ext_vector_type(4)));
typedef short bf16x8 __attribute__((ext_vector_type(8)));
typedef GAS unsigned gu32;
typedef GAS unsigned long long gu64;
#define RLX_AGENT __ATOMIC_RELAXED, __HIP_MEMORY_SCOPE_AGENT
#define LDS_WAIT() asm volatile("s_waitcnt lgkmcnt(0)" ::: "memory")
#define VM_WAIT() asm volatile("s_waitcnt vmcnt(0)" ::: "memory")
__device__ __forceinline__ unsigned long long rt() { return __builtin_amdgcn_s_memrealtime(); }
__device__ __forceinline__ unsigned f2bf(float f) { unsigned u = __builtin_bit_cast(unsigned, f); return (u + 0x7fffu + ((u >> 16) & 1u)) >> 16; }
__device__ __forceinline__ unsigned pk2(float lo, float hi) { return f2bf(lo) | (f2bf(hi) << 16); }

#define XB_TMO      128
#define XB_XCNT(j)  (256  + 64 * (j))
#define XB_XSUB(j)  (1280 + 64 * (j))
#define XB_XGEN(j)  (2304 + 64 * (j))
#define XB_TOP      3328
#define XB_TOPGEN   3392
#define XCD_BAR_WORDS 3456
#define XB_SPIN_CAP (1u << 18)

__device__ __forceinline__ unsigned xb_ld(unsigned* p)              { return __hip_atomic_load(p, __ATOMIC_RELAXED, __HIP_MEMORY_SCOPE_AGENT); }
__device__ __forceinline__ unsigned xb_add(unsigned* p, unsigned v) { return __hip_atomic_fetch_add(p, v, __ATOMIC_RELAXED, __HIP_MEMORY_SCOPE_AGENT); }
__device__ __forceinline__ unsigned xb_xcc_id() { return (unsigned)__builtin_amdgcn_s_getreg((3 << 11) | 20) & 0xFu; }
#define XB_SPIN(cond, bar) do { unsigned _sp = 0; while (cond) { __builtin_amdgcn_s_sleep(1); \
    if ((++_sp & 255u) == 0u) { if (xb_ld(&(bar)[XB_TMO])) break; if (_sp > XB_SPIN_CAP) { atomicAdd(&(bar)[XB_TMO], 1u); break; } } } } while (0)

struct XcdBarrier {
    unsigned* bar; unsigned x;
    volatile LAS unsigned* st;
};

__device__ __forceinline__ XcdBarrier xcd_barrier_post(unsigned* bar, volatile LAS unsigned* st) {
    XcdBarrier b; b.bar = bar; b.x = xb_xcc_id(); b.st = st;
    if (threadIdx.x == 0) (void)xb_add(&bar[XB_XCNT(b.x)], 1u);
    return b;
}
__device__ __forceinline__ void xcd_barrier_complete(unsigned* bar, unsigned x, unsigned& nloc, unsigned& nx) {
    const unsigned G = gridDim.x * gridDim.y * gridDim.z;
    unsigned sum, cnt, mine, sp = 0u;
    for (;;) {
        sum = 0u; cnt = 0u; mine = 0u;
#pragma unroll
        for (unsigned j = 0; j < 16; ++j) { const unsigned c = xb_ld(&bar[XB_XCNT(j)]); sum += c; cnt += (c > 0u) ? 1u : 0u; mine = (j == x) ? c : mine; }
        if (sum == G) break;
        __builtin_amdgcn_s_sleep(1);
        if ((++sp & 255u) == 0u) { if (xb_ld(&bar[XB_TMO])) break; if (sp > XB_SPIN_CAP) { atomicAdd(&bar[XB_TMO], 1u); break; } }
    }
    nloc = mine > 0u ? mine : 1u; nx = cnt > 0u ? cnt : 1u;
}

__device__ __forceinline__ void xcd_barrier(const XcdBarrier& b) {
    asm volatile("s_waitcnt vmcnt(0)" ::: "memory");
    __syncthreads();
    if (threadIdx.x == 0) {
        unsigned* bar = b.bar;
        __builtin_amdgcn_s_waitcnt(0);
        unsigned nloc = b.st[0], nx = b.st[1];
        if (nloc == 0u) { xcd_barrier_complete(bar, b.x, nloc, nx); b.st[0] = nloc; b.st[1] = nx; }
        const unsigned old = xb_add(&bar[XB_XSUB(b.x)], 1u);
        const unsigned gen = old / nloc;
        if (old + 1u == (gen + 1u) * nloc) {
            __builtin_amdgcn_fence(__ATOMIC_RELEASE, "agent");
            asm volatile("s_waitcnt vmcnt(0)" ::: "memory");
            const unsigned og = xb_add(&bar[XB_TOP], 1u);
            const unsigned tg = og / nx;
            if (og + 1u == (tg + 1u) * nx) xb_add(&bar[XB_TOPGEN], 1u);
            else XB_SPIN(xb_ld(&bar[XB_TOPGEN]) == tg, bar);
            __builtin_amdgcn_fence(__ATOMIC_ACQUIRE, "agent");
            xb_add(&bar[XB_XGEN(b.x)], 1u);
            asm volatile("s_waitcnt vmcnt(0)" ::: "memory");
        } else {
            XB_SPIN(xb_ld(&bar[XB_XGEN(b.x)]) == gen, bar);
            __builtin_amdgcn_fence(__ATOMIC_ACQUIRE, "agent");
            asm volatile("s_waitcnt vmcnt(0)" ::: "memory");
        }
    }
    __syncthreads();
}
static_assert((CW_BAR + XCD_BAR_WORDS) * 4 <= (int)CTL_ZERO_BYTES, "barrier words inside the memset region");

struct Frame {
    LAS unsigned char* lds;
    volatile LAS unsigned* MISC;
    gu32* ctl;
    int tid, lane, wave;
    int vcu, G;
};
__device__ __forceinline__ float bf2f(bf16 b) { return __uint_as_float(((unsigned)b) << 16); }
__device__ __forceinline__ float wave_sum(float v) {
#pragma unroll
    for (int o = 1; o < 64; o <<= 1) v += __shfl_xor(v, o);
    return v;
}
__device__ __forceinline__ void sincos_d(float ang, float& s, float& c) {
    const double a = (double)ang;
    const double k = rint(a * 0.6366197723675814);
    double y = fma(-k, 1.5707963267948966, a);
    y = fma(-k, 6.123233995736766e-17, y);
    const double y2 = y * y;
    const double sp = y * (1.0 + y2 * (-1.0 / 6 + y2 * (1.0 / 120 + y2 * (-1.0 / 5040 + y2 * (1.0 / 362880 + y2 * (-1.0 / 39916800 + y2 * (1.0 / 6227020800.0)))))));
    const double cp = 1.0 + y2 * (-0.5 + y2 * (1.0 / 24 + y2 * (-1.0 / 720 + y2 * (1.0 / 40320 + y2 * (-1.0 / 3628800 + y2 * (1.0 / 479001600.0 + y2 * (-1.0 / 87178291200.0)))))));
    const int q = ((int)(long long)k) & 3;
    const double ss = (q == 0) ? sp : (q == 1) ? cp : (q == 2) ? -sp : -cp;
    const double cc = (q == 0) ? cp : (q == 1) ? -sp : (q == 2) ? -cp : sp;
    s = (float)ss; c = (float)cc;
}
__device__ __forceinline__ void p0_transpose_item(const float* W, int K, int N, bf16* WT, int k0, int n0, int d0, LAS float* scr, int lane) {
#pragma unroll 8
    for (int i = 0; i < 32; ++i) { const int kk = 2 * i + (lane >> 5); scr[kk * 33 + (lane & 31)] = W[(size_t)(k0 + kk) * N + n0 + (lane & 31)]; }
    LDS_WAIT(); asm volatile("" ::: "memory");
    const int c = lane & 7;
#pragma unroll
    for (int j = 0; j < 4; ++j) { const int n = (lane >> 3) + 8 * j; const LAS float* s = scr + (8 * c) * 33 + n;
        v4u o; o.x = pk2(s[0 * 33], s[1 * 33]); o.y = pk2(s[2 * 33], s[3 * 33]); o.z = pk2(s[4 * 33], s[5 * 33]); o.w = pk2(s[6 * 33], s[7 * 33]);
        *(GAS v4u*)(WT + (size_t)(d0 + n) * K + k0 + 8 * c) = o; }
    LDS_WAIT(); asm volatile("" ::: "memory");
}
struct Ptrs {
    const float *x, *gain, *w_in, *qna, *kna, *sinks, *qnb, *knb, *w_out; float* out;
    bf16 *WIT, *WOT, *XN, *QA, *KA, *VA, *GA, *QB, *KB, *VB, *GB, *MIX, *PO16, *PO4; float *cosT, *sinT, *PL16, *PL4;
};
__device__ __forceinline__ void p0_prologue(Frame& F, const Ptrs& P) {
    LAS float* scr = (LAS float*)(F.lds + RING_OFF + F.wave * 16384);
    const int gw = F.vcu * NWAVES + F.wave, NGW = F.G * NWAVES;
    constexpr int I_IN = (DM / 64) * (NIN / 32), I_OUT = (DM / 64) * (DM / 32);
    for (int it = gw; it < I_IN + I_OUT; it += NGW) {
        if (it < I_IN) { const int nblk = NIN / 32, kb = it / nblk, nb = it % nblk, n0 = 32 * nb;
            const int pn = n0 >> 8, rem = n0 & 255, wc = rem >> 6, bjj = (rem >> 5) & 1;
            p0_transpose_item(P.w_in, DM, NIN, P.WIT, 64 * kb, n0, 256 * pn + 128 * bjj + 32 * wc, scr, F.lane); }
        else { const int r = it - I_IN, nblk = DM / 32, kb = r / nblk, nb = r % nblk; p0_transpose_item(P.w_out, DM, DM, P.WOT, 64 * kb, 32 * nb, 32 * nb, scr, F.lane); }
    }
    for (int e = (F.vcu * NWAVES * 64) + F.tid; e < SEQ * 32; e += F.G * NWAVES * 64) {
        const int t = e >> 5, i = e & 31;
        double r = 1.0; for (int k = 0; k < i; ++k) r *= 0.7498942093324558;
        const float inv = (float)r; const float ang = (float)t * inv;
        float s, c; sincos_d(ang, s, c); P.cosT[e] = c; P.sinT[e] = s;
    }
    for (int m = gw; m < M; m += NGW) {
        const GAS f32x4* xr = (const GAS f32x4*)(P.x + (size_t)m * DM) + F.lane;
        f32x4 v[4]; float ss = 0.f;
#pragma unroll
        for (int j = 0; j < 4; ++j) { v[j] = xr[64 * j]; ss += (v[j].x * v[j].x + v[j].y * v[j].y) + (v[j].z * v[j].z + v[j].w * v[j].w); }
        const float rstd = rsqrtf(wave_sum(ss) * (1.f / DM) + 1e-6f);
        GAS unsigned long long* o8 = (GAS unsigned long long*)(P.XN + (size_t)m * DM) + F.lane;
#pragma unroll
        for (int j = 0; j < 4; ++j) { const f32x4 g = ((const GAS f32x4*)P.gain)[64 * j + F.lane];
            o8[64 * j] = (unsigned long long)pk2(v[j].x * rstd * g.x, v[j].y * rstd * g.y) | ((unsigned long long)pk2(v[j].z * rstd * g.z, v[j].w * rstd * g.w) << 32); }
    }
}
constexpr int STAGE_OFF = RING_BYTES;
__device__ __forceinline__ att::Desc b_desc(const Ptrs& P, int uid, int mode, int wave, int k) {
    const int b = uid >> 5, h = (uid >> 2) & 7, blk = uid & 3; const size_t hb = (size_t)(b * 8 + h) * SEQ;
    att::Desc D{};
    D.Q0 = P.QB + hb * 64; D.Q1 = D.Q0; D.K = P.KB + hb * 64; D.V = P.VB + hb * 64;
    if (mode == 1) {
        if (wave < 4) { D.dil = 16; D.r = 4 * wave + k; D.qt0 = 2 * blk; D.po = P.PO16 + hb * 64; D.pl = P.PL16 + hb; }
        else { D.dil = 4; D.r = wave - 4; D.qt0 = 8 * blk + 2 * k; D.po = P.PO4 + hb * 64; D.pl = P.PL4 + hb; }
    } else {
        D.dil = 1; D.r = 0; D.qt0 = 32 * blk + 2 * (2 * wave + k);
        D.po_a = P.PO16 + hb * 64; D.po_b = P.PO4 + hb * 64; D.pl_a = P.PL16 + hb; D.pl_b = P.PL4 + hb;
        D.gate0 = P.GB + (size_t)b * SEQ * 512 + h * 64; D.gate1 = D.gate0; D.mix0 = P.MIX + (size_t)b * SEQ * DM + 512 + h * 64; D.mix1 = D.mix0;
    }
    D.qt1 = D.qt0 + 1;
    return D;
}
__device__ __forceinline__ att::Desc a_desc(const Ptrs& P, int aid) {
    const int b = aid >> 9, hp = (aid >> 7) & 3, qt = aid & 127, kv = hp >> 1, h0 = 2 * hp;
    att::Desc D{};
    D.Q0 = P.QA + (size_t)(b * 8 + h0) * SEQ * 64; D.Q1 = D.Q0 + (size_t)SEQ * 64;
    D.K = P.KA + (size_t)(b * 2 + kv) * SEQ * 64; D.V = P.VA + (size_t)(b * 2 + kv) * SEQ * 64;
    D.dil = 1; D.r = 0; D.qt0 = qt; D.qt1 = qt;
    D.gate0 = P.GA + (size_t)b * SEQ * 512 + h0 * 64; D.gate1 = D.gate0 + 64; D.mix0 = P.MIX + (size_t)b * SEQ * DM + h0 * 64; D.mix1 = D.mix0 + 64;
    D.sink0 = __builtin_amdgcn_exp2f(P.sinks[h0] * LOG2E); D.sink1 = __builtin_amdgcn_exp2f(P.sinks[h0 + 1] * LOG2E);
    return D;
}
#ifndef REP_2A
#define REP_2A 1
#define REP_2B 1
#define REP_2C 1
#endif
__device__ __forceinline__ void p2_attention(Frame& F, const Ptrs& P, const XcdBarrier& bar) {
    att::lds_ptr ring = (att::lds_ptr)(F.lds + RING_OFF + F.wave * 16384), stage = (att::lds_ptr)(F.lds + STAGE_OFF + F.wave * 2048);
    int lane_ = F.lane; asm volatile("" : "+v"(lane_));
    const int lane = lane_, wave = F.wave, uid = F.vcu;
    const unsigned ring0 = (unsigned)(uintptr_t)ring;
    att::bf16x8 qr[2][4];
    att::Desc D, N; int par = 0;
#ifdef DRY_PASS
    D = b_desc(P, uid, 1, wave, 0);
    att::prefetch<DRY_PASS>(D, ring0, qr, lane);
    for (int k = 0; k < 4; ++k) {
        N = b_desc(P, uid, 1, wave, (k + 1) & 3);
        att::attn_item<1, DRY_PASS>(ring, stage, D, k < 3, N, qr, par, lane); D = N;
    }
    asm volatile("s_waitcnt vmcnt(0) lgkmcnt(0)" ::: "memory");
#endif
#pragma unroll
    for (int rep = 0; rep < REP_2A; ++rep) {
    D = b_desc(P, uid, 1, wave, 0);
    par = 0; att::prefetch(D, ring0, qr, lane, 0);
    for (int k = 0; k < 4; ++k) {
        N = b_desc(P, uid, 1, wave, (k + 1) & 3);
        att::attn_item<1>(ring, stage, D, k < 3, N, qr, par, lane); D = N;
    }
    }
    asm volatile("s_waitcnt vmcnt(0) lgkmcnt(0)\n\ts_barrier" ::: "memory");
#pragma unroll
    for (int rep = 0; rep < REP_2B; ++rep) {
    D = b_desc(P, uid, 2, wave, 0);
    par = 0; att::prefetch(D, ring0, qr, lane, 0);
    for (int k = 0; k < 2; ++k) {
        N = b_desc(P, uid, 2, wave, 1);
        att::attn_item<2>(ring, stage, D, k < 1, N, qr, par, lane); D = N;
    }
    }
#pragma unroll
    for (int rep = 0; rep < REP_2C; ++rep) {
    D = a_desc(P, __builtin_amdgcn_readfirstlane(uid * 16 + wave * 2));
    par = 0; att::prefetch(D, ring0, qr, lane, 0);
    for (int k = 0; k < 2; ++k) {
        N = a_desc(P, __builtin_amdgcn_readfirstlane(uid * 16 + wave * 2 + 1));
        att::attn_item<0>(ring, stage, D, k < 1, N, qr, par, lane); D = N;
    }
    }
}

struct Args { const float* in[9]; float* out; unsigned char* ws; };
__global__ void __launch_bounds__(NWAVES * 64, 2) mega_fwd(Args args) {
    extern __shared__ __attribute__((aligned(16))) unsigned char lds[];
    Frame F;
    F.lds = (LAS unsigned char*)lds;
    F.MISC = (volatile LAS unsigned*)(F.lds + MISC_OFF);
    F.tid = threadIdx.x; F.lane = F.tid & 63; F.wave = __builtin_amdgcn_readfirstlane(F.tid >> 6);
    F.G = gridDim.x; { const int bx = blockIdx.x; F.vcu = (F.G % 8 == 0) ? (bx % 8) * (F.G / 8) + bx / 8 : bx; }
    unsigned char* ws = args.ws;
    F.ctl = (gu32*)(ws + WS_CTL);
    Ptrs P;
    P.x = args.in[0]; P.gain = args.in[1]; P.w_in = args.in[2]; P.qna = args.in[3]; P.kna = args.in[4]; P.sinks = args.in[5]; P.qnb = args.in[6]; P.knb = args.in[7]; P.w_out = args.in[8]; P.out = args.out;
    P.WIT = (bf16*)(ws + WS_WIT); P.WOT = (bf16*)(ws + WS_WOT); P.XN = (bf16*)(ws + WS_XN);
    P.QA = (bf16*)(ws + WS_QA); P.KA = (bf16*)(ws + WS_KA); P.VA = (bf16*)(ws + WS_VA); P.GA = (bf16*)(ws + WS_GA);
    P.QB = (bf16*)(ws + WS_QB); P.KB = (bf16*)(ws + WS_KB); P.VB = (bf16*)(ws + WS_VB); P.GB = (bf16*)(ws + WS_GB); P.MIX = (bf16*)(ws + WS_MIX);
    P.cosT = (float*)(ws + WS_COS); P.sinT = (float*)(ws + WS_SIN);
    P.PO16 = (bf16*)(ws + WS_PO16); P.PO4 = (bf16*)(ws + WS_PO4); P.PL16 = (float*)(ws + WS_PL16); P.PL4 = (float*)(ws + WS_PL4);
    for (int u = F.tid; u < (LDS_BYTES - LDSCTL_OFF) / 4; u += NWAVES * 64) ((LAS unsigned*)(F.lds + LDSCTL_OFF))[u] = 0u;
    __syncthreads();
    XcdBarrier bar = xcd_barrier_post((unsigned*)(F.ctl + CW_BAR), F.MISC + 8);

#ifndef PROBE_TS
#define PROBE_TS 0
#endif
    unsigned long long ts0 = 0, ts1 = 0, ts2 = 0, ts3 = 0, ts4 = 0;
    if (PROBE_TS) ts0 = rt();
#ifndef REP_P0
#define REP_P0 1
#define REP_P1 1
#define REP_P2 1
#define REP_P3 1
#endif
#pragma unroll
    for (int rep = 0; rep < REP_P0; ++rep) {
    p0_prologue(F, P);
    xcd_barrier(bar);
    }
    if (PROBE_TS) ts1 = rt();
#pragma unroll
    for (int rep = 0; rep < REP_P1; ++rep) {
#ifdef STAGGER_US
        if ((int)blockIdx.x >= F.G / 2) { const unsigned long long t0_ = rt(); while (rt() - t0_ < (unsigned long long)(STAGGER_US * 100)) __builtin_amdgcn_s_sleep(8); }
#endif
        pg8::Gemm g{P.XN, P.WIT, M, NIN, DM}; pg8::StaticOrder S; S.init(M, NIN, F.G, (int)blockIdx.x);
        pg8::EpiIn E{P.QA, P.KA, P.VA, P.GA, P.QB, P.KB, P.VB, P.GB, P.qna, P.kna, P.qnb, P.knb, P.cosT, P.sinT};
        pg8::gemm_phase<pg8::EpiIn, pg8::StaticOrder, PG8_ALIGN, PG8_SP2>(F.lds + RING_OFF, g, S, E);
    xcd_barrier(bar);
    }
    if (PROBE_TS) ts2 = rt();
#ifdef DRY_GEMM
    {
        pg8::Gemm g{P.XN, P.WIT, M, NIN, DM};
#if DRY_GEMM == 1
        pg8::StaticOrder S; S.init(M, NIN, F.G, (int)blockIdx.x); pg8::EpiNone E{};
        pg8::gemm_phase<pg8::EpiNone, pg8::StaticOrder, PG8_ALIGN, PG8_SP2>(F.lds + RING_OFF, g, S, E);
#else
        pg8::SameTileOrder S; S.init(M, NIN, F.G, (int)blockIdx.x); pg8::EpiNone E{};
        pg8::gemm_phase<pg8::EpiNone, pg8::SameTileOrder, PG8_ALIGN, PG8_SP2>(F.lds + RING_OFF, g, S, E);
#endif
        xcd_barrier(bar);
    }
#endif
#pragma unroll
    for (int rep = 0; rep < REP_P2; ++rep) {
    p2_attention(F, P, bar);
    xcd_barrier(bar);
    }
    if (PROBE_TS) ts3 = rt();
#pragma unroll
    for (int rep = 0; rep < REP_P3; ++rep) {
        pg8::Gemm g{P.MIX, P.WOT, M, DM, DM}; pg8::StaticOrder S; S.init(M, DM, F.G, (int)blockIdx.x);
        pg8::EpiRes E{P.x, P.out};
        pg8::gemm_phase<pg8::EpiRes, pg8::StaticOrder, PG8_ALIGN, PG8_SP2>(F.lds + RING_OFF, g, S, E);
    }
    if (PROBE_TS) {
        ts4 = rt();
        if (blockIdx.x == 0 && F.tid == 0) {
            const float dA = (PROBE_TS == 1) ? (float)(ts2 - ts1) * 0.01f : (float)(ts1 - ts0) * 0.01f;
            const float dB = (PROBE_TS == 1) ? (float)(ts3 - ts2) * 0.01f : (float)(ts4 - ts3) * 0.01f;
            asm volatile("s_waitcnt vmcnt(0)" ::: "memory");
            P.out[0] += dA; P.out[1] += dB;
        }
    }
}

extern "C" void kernel_launch(void* const* d_in, const int* in_sizes, int n_in, void* d_out, int out_size, void* d_ws, size_t ws_size, hipStream_t stream) {
    static int grid = 0;
    if (grid == 0) {
        if (n_in != 9 || out_size != M * DM || ws_size < WS_END) { fprintf(stderr, "kernel_launch: unexpected shapes (n_in %d, out %d, ws %zu); nothing launched\n", n_in, out_size, ws_size); grid = -1; return; }
        int dev = 0, cus = 0;
        if (hipGetDevice(&dev) != hipSuccess || hipDeviceGetAttribute(&cus, hipDeviceAttributeMultiprocessorCount, dev) != hipSuccess) { grid = -1; return; }
        if (hipFuncSetAttribute((const void*)mega_fwd, hipFuncAttributeMaxDynamicSharedMemorySize, LDS_BYTES) != hipSuccess) { fprintf(stderr, "kernel_launch: hipFuncSetAttribute failed\n"); grid = -1; return; }
        (void)hipGetLastError();
        grid = cus;
    }
    if (grid < 0) return;
#ifdef EXTRA_MEMSET
    (void)hipMemsetAsync((char*)d_ws + WS_CTL + 512 * 1024, 0, CTL_ZERO_BYTES, stream);
#endif
    if (hipMemsetAsync((char*)d_ws + WS_CTL, 0, CTL_ZERO_BYTES, stream) != hipSuccess) { fprintf(stderr, "kernel_launch: hipMemsetAsync failed\n"); return; }
    Args a{};
    for (int i = 0; i < 9; ++i) a.in[i] = (const float*)d_in[i];
    a.out = (float*)d_out; a.ws = (unsigned char*)d_ws;
    hipLaunchKernelGGL(mega_fwd, dim3(grid), dim3(NWAVES * 64), LDS_BYTES, stream, a);
}
```

```cpp
#include <hip/hip_runtime.h>
#include <cstdio>
#include <cstdint>
#include <cmath>
#define KSWZ 1
namespace pg8 {
#define PG8_LAS __attribute__((address_space(3)))
typedef unsigned short bf16_t;
typedef short bf16x8 __attribute__((ext_vector_type(8)));
typedef float f32x4 __attribute__((ext_vector_type(4)));
typedef unsigned u32x4 __attribute__((ext_vector_type(4)));
constexpr int BM = 256, BK = 64, HALF = 128, HTB = HALF * BK * 2  , STAGE_BYTES = 8 * HTB, NXCD = 8, WGM = 8;

__host__ __device__ __forceinline__ int lds_byte(int r, int c) { const int st = (r >> 4) * 2 + (c >> 5), rr = r & 15, cc = c & 31, ob = rr * 64 + cc * 2; return st * 1024 + (ob ^ (((ob >> 9) & 1) << 5)); }
__host__ __device__ __forceinline__ void stage_rc(int b, int& R, int& C) { const int st = b / 1024, sb = b % 1024, swz = sb ^ (((sb >> 9) & 1) << 5); R = (st >> 1) * 16 + swz / 64; C = (st & 1) * 32 + (swz % 64) / 2; }
__host__ __device__ __forceinline__ int perm32(int rho) { const int n = rho >> 4, i = rho & 15; return 8 * (i >> 2) + 4 * n + (i & 3); }

struct Unit { int pm, pn; };
struct Gemm { const bf16_t* A; const bf16_t* Bt; int M, N, K; };

struct StaticOrder {
    int nM, nN, nwg, G, c;
    __host__ __device__ void init(int M, int N, int G_, int c_) { nM = M / BM; nN = N / BM; nwg = nM * nN; G = G_; c = c_; }
    __host__ __device__ bool next(int i, Unit& u) const {
        const long L = (long)i * G + c; if (L >= nwg) return false;
        int wgid = (int)L; { const int q = nwg / NXCD, r = nwg % NXCD, xcd = wgid % NXCD, off = wgid / NXCD; wgid = (xcd < r ? xcd * (q + 1) : r * (q + 1) + (xcd - r) * q) + off; }
        const int nig = WGM * nN, gid = wgid / nig, fm = gid * WGM, gsz = (nM - fm) < WGM ? (nM - fm) : WGM;
        u.pm = fm + ((wgid % nig) % gsz); u.pn = (wgid % nig) / gsz; return true;
    }
    __device__ __forceinline__ void a_ready(const Unit&) const {}
    __device__ __forceinline__ void done(const Unit&) const {}
};
__device__ __forceinline__ unsigned cvt_pk_bf16(float lo, float hi) { unsigned r; asm volatile("v_cvt_pk_bf16_f32 %0, %1, %2" : "=v"(r) : "v"(lo), "v"(hi)); return r; }
typedef float f32x2 __attribute__((ext_vector_type(2)));
typedef float f32x2 __attribute__((ext_vector_type(2)));
constexpr int SEQ_ = 4096;
constexpr float C2_ = 0.18033688011112042f, LOG2E_ = 1.4426950408889634f;
__device__ __forceinline__ u32x4 pack8(const f32x4& a, const f32x4& b) { u32x4 w; w.x = cvt_pk_bf16(a[0], a[1]); w.y = cvt_pk_bf16(a[2], a[3]); w.z = cvt_pk_bf16(b[0], b[1]); w.w = cvt_pk_bf16(b[2], b[3]); return w; }
__device__ __forceinline__ void store_row_pair(bf16_t* rowp, size_t pitch, int fr, u32x4 w0, u32x4 w1) {
    const bool odd = fr & 1;
    const u32x4 snd = odd ? w0 : w1;
    u32x4 rcv;
#pragma unroll
    for (int k = 0; k < 4; ++k) rcv[k] = (unsigned)__shfl_xor((int)snd[k], 1);
    const u32x4 A = odd ? rcv : w0, B = odd ? w1 : rcv;
    bf16_t* pa = odd ? rowp - pitch + 32 : rowp;
    bf16_t* pb = odd ? rowp + 32 : rowp + pitch;
    *(u32x4*)pa = A; *(u32x4*)pb = B;
}
template <bool NOSTORE = false> struct EpiInT {
    static constexpr bool PERM = true, AFTER_DRAIN = false, REPME = true; static constexpr int NSTORE = 16;
    bf16_t *QA, *KA, *VA, *GA, *QB, *KB, *VB, *GB;
    const float *qna, *kna, *qnb, *knb, *cosT, *sinT;
    __device__ __forceinline__ void init(f32x4 (&acc)[2][2][4][2], const Unit&, int, int, int, int) const {
#pragma unroll
        for (int a = 0; a < 2; ++a)
#pragma unroll
            for (int b = 0; b < 2; ++b)
#pragma unroll
                for (int m = 0; m < 4; ++m)
#pragma unroll
                    for (int n = 0; n < 2; ++n) acc[a][b][m][n] = (f32x4){0.f, 0.f, 0.f, 0.f};
    }
    __device__ __forceinline__ void operator()(const f32x4 (&acc)[2][2][4][2], const Unit& u, int wr, int wc, int fr, int fq) const {
        const int g = u.pn * 4 + wc;
        int type, head, H = 8; const float* ng = qna; bf16_t* dst; float scale = 1.f;
        if (g < 8) { type = 0; head = g; ng = qna; dst = QA; scale = C2_; }
        else if (g < 10) { type = 0; head = g - 8; ng = kna; dst = KA; H = 2; }
        else if (g < 12) { type = 1; head = g - 10; dst = VA; H = 2; }
        else if (g < 20) { type = 2; head = g - 12; dst = GA; }
        else if (g < 28) { type = 0; head = g - 20; ng = qnb; dst = QB; scale = C2_; }
        else if (g < 36) { type = 0; head = g - 28; ng = knb; dst = KB; }
        else if (g < 44) { type = 1; head = g - 36; dst = VB; }
        else { type = 2; head = g - 44; dst = GB; }
        const int row0 = u.pm * BM + wr * 64 + fr;
        if (type == 0) {
            f32x4 gv[2][2], c16[2], s16[2], cb[2][2], sb[2][2];
            const int tb = (row0 & (SEQ_ - 1));
#pragma unroll
            for (int n = 0; n < 2; ++n) {
                c16[n] = *(const f32x4*)(cosT + 16 * 32 + 8 * fq + 4 * n); s16[n] = *(const f32x4*)(sinT + 16 * 32 + 8 * fq + 4 * n);
#pragma unroll
                for (int ai = 0; ai < 2; ++ai) { cb[ai][n] = *(const f32x4*)(cosT + (tb + ai * HALF) * 32 + 8 * fq + 4 * n); sb[ai][n] = *(const f32x4*)(sinT + (tb + ai * HALF) * 32 + 8 * fq + 4 * n); }
#pragma unroll
                for (int bj = 0; bj < 2; ++bj) gv[bj][n] = *(const f32x4*)(ng + 32 * bj + 8 * fq + 4 * n);
            }
#pragma unroll
            for (int ai = 0; ai < 2; ++ai) {
                f32x4 cs[2] = {cb[ai][0], cb[ai][1]}, sn[2] = {sb[ai][0], sb[ai][1]};
#pragma unroll
                for (int m = 0; m < 4; ++m) {
                    const int row = row0 + ai * HALF + m * 16, b = row >> 12, t = row & (SEQ_ - 1);
                    float ss = 0.f;
#pragma unroll
                    for (int bj = 0; bj < 2; ++bj)
#pragma unroll
                        for (int n = 0; n < 2; ++n) { const f32x4 x = acc[ai][bj][m][n]; ss += (x[0] * x[0] + x[1] * x[1]) + (x[2] * x[2] + x[3] * x[3]); }
                    ss += __shfl_xor(ss, 16); ss += __shfl_xor(ss, 32);
                    const float rs = rsqrtf(ss * (1.f / 64.f) + 1e-6f) * scale;
                    f32x4 o1[2], o2[2];
#pragma unroll
                    for (int n = 0; n < 2; ++n) {
                        const f32x4 n1 = acc[ai][0][m][n] * rs * gv[0][n], n2 = acc[ai][1][m][n] * rs * gv[1][n];
                        o1[n] = n1 * cs[n] - n2 * sn[n]; o2[n] = n2 * cs[n] + n1 * sn[n];
                        const f32x4 cn = cs[n] * c16[n] - sn[n] * s16[n], sn2 = sn[n] * c16[n] + cs[n] * s16[n];
                        cs[n] = cn; sn[n] = sn2;
                    }
                    bf16_t* p = dst + ((size_t)(b * H + head) * SEQ_ + t) * 64 + 8 * fq;
                    { const u32x4 w0_ = pack8(o1[0], o1[1]), w1_ = pack8(o2[0], o2[1]); if (NOSTORE) { asm volatile("" :: "v"(w0_), "v"(w1_)); } else { *(u32x4*)p = w0_; *(u32x4*)(p + 32) = w1_; } }
                }
            }
        } else if (type == 1) {
#pragma unroll
            for (int ai = 0; ai < 2; ++ai)
#pragma unroll
                for (int m = 0; m < 4; ++m) {
                    const int row = row0 + ai * HALF + m * 16, b = row >> 12, t = row & (SEQ_ - 1);
                    bf16_t* p = dst + ((size_t)(b * H + head) * SEQ_ + t) * 64 + 8 * fq;
                    { const u32x4 w0_ = pack8(acc[ai][0][m][0], acc[ai][0][m][1]), w1_ = pack8(acc[ai][1][m][0], acc[ai][1][m][1]); if (NOSTORE) { asm volatile("" :: "v"(w0_), "v"(w1_)); } else { *(u32x4*)p = w0_; *(u32x4*)(p + 32) = w1_; } }
                }
        } else {
#pragma unroll
            for (int ai = 0; ai < 2; ++ai)
#pragma unroll
                for (int m = 0; m < 4; ++m) {
                    const int row = row0 + ai * HALF + m * 16;
                    bf16_t* p = dst + (size_t)row * 512 + head * 64 + 8 * fq;
                    u32x4 wq[2];
#pragma unroll
                    for (int bj = 0; bj < 2; ++bj) {
                        f32x4 s[2];
#pragma unroll
                        for (int n = 0; n < 2; ++n) { const f32x4 v = acc[ai][bj][m][n];
#pragma unroll
                            for (int e = 0; e < 4; ++e) s[n][e] = v[e]; }
                        wq[bj] = pack8(s[0], s[1]);
                    }
                    { const u32x4 w0_ = wq[0], w1_ = wq[1]; if (NOSTORE) { asm volatile("" :: "v"(w0_), "v"(w1_)); } else { *(u32x4*)p = w0_; *(u32x4*)(p + 32) = w1_; } }
                }
        }
    }
};
typedef EpiInT<false> EpiIn;
struct EpiRes {
    static constexpr bool PERM = true, AFTER_DRAIN = false, REPME = false; static constexpr int NSTORE = 32;
    const float* x; float* out;
    __device__ __forceinline__ void init(f32x4 (&acc)[2][2][4][2], const Unit&, int, int, int, int) const {
#pragma unroll
        for (int a = 0; a < 2; ++a)
#pragma unroll
            for (int b = 0; b < 2; ++b)
#pragma unroll
                for (int m = 0; m < 4; ++m)
#pragma unroll
                    for (int n = 0; n < 2; ++n) acc[a][b][m][n] = (f32x4){0.f, 0.f, 0.f, 0.f};
    }
    __device__ __forceinline__ void operator()(const f32x4 (&acc)[2][2][4][2], const Unit& u, int wr, int wc, int fr, int fq) const {
        const int row0 = u.pm * BM + wr * 64 + fr, col0 = u.pn * BM + wc * 32 + 8 * fq;
#pragma unroll
        for (int ai = 0; ai < 2; ++ai) {
            f32x4 xr[4][2][2];
#pragma unroll
            for (int m = 0; m < 4; ++m) {
                const size_t off = (size_t)(row0 + ai * HALF + m * 16) * 1024 + col0;
#pragma unroll
                for (int bj = 0; bj < 2; ++bj) { xr[m][bj][0] = *(const f32x4*)(x + off + bj * HALF); xr[m][bj][1] = *(const f32x4*)(x + off + bj * HALF + 4); }
            }
            asm volatile("" ::: "memory");
#pragma unroll
            for (int m = 0; m < 4; ++m) {
                const size_t off = (size_t)(row0 + ai * HALF + m * 16) * 1024 + col0;
#pragma unroll
                for (int bj = 0; bj < 2; ++bj) { *(f32x4*)(out + off + bj * HALF) = xr[m][bj][0] + acc[ai][bj][m][0]; *(f32x4*)(out + off + bj * HALF + 4) = xr[m][bj][1] + acc[ai][bj][m][1]; }
            }
            asm volatile("" ::: "memory");
        }
    }
};
struct EpiNone {
    static constexpr bool PERM = true, AFTER_DRAIN = false, REPME = false; static constexpr int NSTORE = 0;
    __device__ __forceinline__ void init(f32x4 (&acc)[2][2][4][2], const Unit&, int, int, int, int) const {
#pragma unroll
        for (int a = 0; a < 2; ++a)
#pragma unroll
            for (int b = 0; b < 2; ++b)
#pragma unroll
                for (int m = 0; m < 4; ++m)
#pragma unroll
                    for (int n = 0; n < 2; ++n) acc[a][b][m][n] = (f32x4){0.f, 0.f, 0.f, 0.f};
    }
    __device__ __forceinline__ void operator()(const f32x4 (&acc)[2][2][4][2], const Unit&, int, int, int, int) const {
#pragma unroll
        for (int a = 0; a < 2; ++a)
#pragma unroll
            for (int b = 0; b < 2; ++b)
#pragma unroll
                for (int m = 0; m < 4; ++m)
#pragma unroll
                    for (int n = 0; n < 2; ++n) asm volatile("" :: "v"(acc[a][b][m][n]));
    }
};
struct SameTileOrder : StaticOrder {
    __host__ __device__ bool next(int i, Unit& u) const { if (!StaticOrder::next(i, u)) return false; u.pm = 0; u.pn = 0; return true; }
};
template <class Epi, class Sched, bool ALIGN_EPI = false, bool SP2 = false>
__device__ __forceinline__ void gemm_phase(PG8_LAS unsigned char* lds, const Gemm g, const Sched& S, const Epi& E) {
    int tid_ = threadIdx.x; asm volatile("" : "+v"(tid_));
    const int tid = tid_, wid = __builtin_amdgcn_readfirstlane(tid >> 6), lane = tid & 63, wr = wid >> 2, wc = wid & 3, fr = lane & 15, fq = lane >> 4;
    const int K = g.K, nt = K / BK;
    unsigned voffA[2], voffB[2];
#pragma unroll
    for (int i = 0; i < 2; ++i) { int R, C; stage_rc(tid * 16 + i * 8192, R, C); const int Rb = Epi::PERM ? ((R & ~31) + perm32(R & 31)) : R;
        voffA[i] = (unsigned)(R * K + C) * 2u; voffB[i] = (unsigned)(Rb * K + C) * 2u; }
    const size_t kstep = (size_t)(BK * 2);
    const size_t hstep = (size_t)HALF * K * 2;
    const size_t tstep = 2 * hstep;
    const unsigned ldsw = (unsigned)wid * 1024u;
    const int aoff = lds_byte(wr * 64 + fr, fq * 8), boff = lds_byte(wc * 32 + fr, fq * 8);
#define PG8_SA(b, h) (((b) * 2 + (h)) * HTB)
#define PG8_SB(b, h) ((4 + (b) * 2 + (h)) * HTB)
#define PG8_STAGE(bufoff, gbase, voff) do { _Pragma("unroll") for (int _i = 0; _i < 2; ++_i) \
        __builtin_amdgcn_global_load_lds((const unsigned*)((const char*)(gbase) + (voff)[_i]), (PG8_LAS unsigned*)(lds + (bufoff) + ldsw + _i * 8192), 16, 0, 0); } while (0)
#define PG8_LDA(dst, b, h) do { _Pragma("unroll") for (int m = 0; m < 4; ++m) _Pragma("unroll") for (int k = 0; k < 2; ++k) dst[m][k] = *(const PG8_LAS bf16x8*)(lds + PG8_SA(b, h) + aoff + m * 2048 + k * 1024); } while (0)
#define PG8_LDB(dst, b, h) do { _Pragma("unroll") for (int n = 0; n < 2; ++n) _Pragma("unroll") for (int k = 0; k < 2; ++k) dst[n][k] = *(const PG8_LAS bf16x8*)(lds + PG8_SB(b, h) + boff + n * 2048 + k * 1024); } while (0)
#define PG8_MMA(ai, bj, At, Bt) do { __builtin_amdgcn_s_setprio(1); _Pragma("unroll") for (int m = 0; m < 4; ++m) _Pragma("unroll") for (int n = 0; n < 2; ++n) _Pragma("unroll") for (int k = 0; k < 2; ++k) \
        acc[ai][bj][m][n] = __builtin_amdgcn_mfma_f32_16x16x32_bf16(Bt[n][k], At[m][k], acc[ai][bj][m][n], 0, 0, 0); __builtin_amdgcn_s_setprio(0); } while (0)
#define PG8_WAIT_V(n) asm volatile("s_waitcnt vmcnt(" #n ")" ::: "memory")
#define PG8_WAIT_V8S() do { if (Epi::NSTORE == 16) PG8_WAIT_V(24); else if (Epi::NSTORE == 32) PG8_WAIT_V(40); else PG8_WAIT_V(8); } while (0)
#define PG8_WAIT_L(n) asm volatile("s_waitcnt lgkmcnt(" #n ")" ::: "memory")
#define PG8_BAR __builtin_amdgcn_s_barrier()
#define PG8_SCHED __builtin_amdgcn_sched_barrier(0)
    Unit cur, nxt; int ui = 0;
    if (!S.next(0, cur)) return;
    f32x4 acc[2][2][4][2];
    E.init(acc, cur, wr, wc, fr, fq);
    bf16x8 At[4][2], B0[2][2], B1[2][2];
    const char* cA = (const char*)g.A + (size_t)cur.pm * tstep; const char* cB = (const char*)g.Bt + (size_t)cur.pn * tstep;
    S.a_ready(cur);
    if constexpr (SP2) {
        PG8_STAGE(PG8_SB(0, 0), cB, voffB); PG8_STAGE(PG8_SB(0, 1), cB + hstep, voffB); PG8_STAGE(PG8_SA(0, 0), cA, voffA); PG8_STAGE(PG8_SA(0, 1), cA + hstep, voffA);
        if (wr == 1) PG8_BAR;
        PG8_WAIT_V(2); PG8_BAR;
        PG8_STAGE(PG8_SB(1, 0), cB + kstep, voffB); PG8_STAGE(PG8_SA(1, 0), cA + kstep, voffA); PG8_STAGE(PG8_SB(1, 1), cB + hstep + kstep, voffB);
        PG8_WAIT_V(6); PG8_BAR;
    } else {
        PG8_STAGE(PG8_SB(0, 0), cB, voffB); PG8_STAGE(PG8_SA(0, 0), cA, voffA); PG8_STAGE(PG8_SB(0, 1), cB + hstep, voffB); PG8_STAGE(PG8_SA(0, 1), cA + hstep, voffA);
        if (wr == 1) PG8_BAR;
        PG8_WAIT_V(4); PG8_BAR;
        PG8_STAGE(PG8_SB(1, 0), cB + kstep, voffB); PG8_STAGE(PG8_SA(1, 0), cA + kstep, voffA); PG8_STAGE(PG8_SB(1, 1), cB + hstep + kstep, voffB);
        PG8_WAIT_V(6); PG8_BAR;
    }
    for (;;) {
        const bool has_next = S.next(ui + 1, nxt);
        const char* nA = has_next ? (const char*)g.A + (size_t)nxt.pm * tstep : cA; const char* nB = has_next ? (const char*)g.Bt + (size_t)nxt.pn * tstep : cB;
        for (int t = 0; t < nt; t += 2) {
            const bool last = (t == nt - 2);
            const char* a1 = cA + (size_t)(t + 1) * kstep;
            const char* a2 = last ? nA : cA + (size_t)(t + 2) * kstep; const char* b2 = last ? nB : cB + (size_t)(t + 2) * kstep;
            const char* a3 = a2 + kstep; const char* b3 = b2 + kstep;
            if (last && has_next) S.a_ready(nxt);
            if constexpr (SP2) {
            PG8_LDB(B0, 0, 0); PG8_LDB(B1, 0, 1); PG8_SCHED; PG8_LDA(At, 0, 0); PG8_STAGE(PG8_SA(1, 1), a1 + hstep, voffA);
            PG8_WAIT_V(8); PG8_WAIT_L(0); PG8_BAR; PG8_MMA(0, 0, At, B0); PG8_MMA(0, 1, At, B1); PG8_BAR; PG8_SCHED;
            PG8_LDA(At, 0, 1); PG8_STAGE(PG8_SB(0, 0), b2, voffB); PG8_STAGE(PG8_SB(0, 1), b2 + hstep, voffB); PG8_STAGE(PG8_SA(0, 0), a2, voffA);
            PG8_WAIT_V(8); PG8_WAIT_L(0); PG8_BAR; PG8_MMA(1, 0, At, B0); PG8_MMA(1, 1, At, B1); PG8_BAR; PG8_SCHED;
            PG8_LDB(B0, 1, 0); PG8_LDB(B1, 1, 1); PG8_SCHED; PG8_LDA(At, 1, 0); PG8_STAGE(PG8_SA(0, 1), a2 + hstep, voffA);
            PG8_WAIT_V(8); PG8_WAIT_L(0); PG8_BAR; PG8_MMA(0, 0, At, B0); PG8_MMA(0, 1, At, B1); PG8_BAR; PG8_SCHED;
            PG8_LDA(At, 1, 1); PG8_STAGE(PG8_SB(1, 0), b3, voffB); PG8_STAGE(PG8_SB(1, 1), b3 + hstep, voffB); PG8_STAGE(PG8_SA(1, 0), a3, voffA);
            PG8_WAIT_V(8); PG8_WAIT_L(0); PG8_BAR; PG8_MMA(1, 0, At, B0); PG8_MMA(1, 1, At, B1); PG8_BAR; PG8_SCHED;
            } else {
            PG8_LDB(B0, 0, 0); PG8_SCHED; PG8_LDA(At, 0, 0); PG8_STAGE(PG8_SA(1, 1), a1 + hstep, voffA);
            PG8_WAIT_L(8); PG8_BAR; PG8_WAIT_L(0); PG8_MMA(0, 0, At, B0); PG8_BAR; PG8_SCHED;
            PG8_LDB(B1, 0, 1); PG8_STAGE(PG8_SB(0, 0), b2, voffB);
            PG8_BAR; PG8_WAIT_L(0); PG8_MMA(0, 1, At, B1); PG8_BAR;
            PG8_LDA(At, 0, 1); PG8_STAGE(PG8_SA(0, 0), a2, voffA);
            PG8_BAR; PG8_WAIT_L(0); PG8_MMA(1, 0, At, B0); PG8_BAR; PG8_SCHED;
            PG8_STAGE(PG8_SB(0, 1), b2 + hstep, voffB);
            PG8_WAIT_V(6); PG8_BAR; PG8_MMA(1, 1, At, B1); PG8_BAR;
            PG8_LDB(B0, 1, 0); PG8_SCHED; PG8_LDA(At, 1, 0); PG8_STAGE(PG8_SA(0, 1), a2 + hstep, voffA);
            PG8_WAIT_L(8); PG8_BAR; PG8_WAIT_L(0); PG8_MMA(0, 0, At, B0); PG8_BAR; PG8_SCHED;
            PG8_LDB(B1, 1, 1); PG8_STAGE(PG8_SB(1, 0), b3, voffB);
            PG8_BAR; PG8_WAIT_L(0); PG8_MMA(0, 1, At, B1); PG8_BAR;
            PG8_LDA(At, 1, 1); PG8_STAGE(PG8_SA(1, 0), a3, voffA);
            PG8_BAR; PG8_WAIT_L(0); PG8_MMA(1, 0, At, B0); PG8_BAR; PG8_SCHED;
            PG8_STAGE(PG8_SB(1, 1), b3 + hstep, voffB);
            PG8_WAIT_V(6); PG8_BAR; PG8_MMA(1, 1, At, B1); PG8_BAR;
            }
        }
        if constexpr (ALIGN_EPI) { if (wr == 0) PG8_BAR; }
        if constexpr (!Epi::AFTER_DRAIN) { E(acc, cur, wr, wc, fr, fq); S.done(cur); }
        if (!has_next) break;
        E.init(acc, nxt, wr, wc, fr, fq);
        cur = nxt; cA = nA; cB = nB; ++ui;
        if constexpr (ALIGN_EPI) { if (wr == 1) PG8_BAR; }
    }
    PG8_WAIT_V(0);
    if constexpr (!ALIGN_EPI) { if (wr == 0) PG8_BAR; }
    PG8_BAR;
    if constexpr (Epi::AFTER_DRAIN) { E.fused(acc, cur, wr, wc, fr, fq, lds, wid, lane); S.done(cur); }
#undef PG8_SA
#undef PG8_SB
#undef PG8_STAGE
#undef PG8_LDA
#undef PG8_LDB
#undef PG8_MMA
#undef PG8_WAIT_V
#undef PG8_WAIT_V8S
#undef PG8_WAIT_L
#undef PG8_BAR
#undef PG8_SCHED
}
}
namespace att {
#ifndef KSWZ
#define KSWZ 0
#endif
typedef short bf16x8 __attribute__((ext_vector_type(8)));
typedef short s16x4 __attribute__((ext_vector_type(4)));
typedef short v4i16_t __attribute__((ext_vector_type(4)));
typedef float f32x16 __attribute__((ext_vector_type(16)));
typedef float f32x4 __attribute__((ext_vector_type(4)));
typedef unsigned u32x4 __attribute__((ext_vector_type(4)));
typedef float f32x2_t __attribute__((ext_vector_type(2))); typedef __bf16 bf16x2_t __attribute__((ext_vector_type(2)));
typedef __attribute__((address_space(3))) unsigned char* lds_ptr;
__device__ __forceinline__ unsigned cvtpk_s(float lo, float hi) { f32x2_t v = {lo, hi}; bf16x2_t b = __builtin_convertvector(v, bf16x2_t); return __builtin_bit_cast(unsigned, b); }
__device__ __forceinline__ int crow(int r, int hi) { return (r & 3) + 8 * (r >> 2) + 4 * hi; }
__device__ __forceinline__ s16x4 vtr(lds_ptr p) { return __builtin_bit_cast(s16x4, __builtin_amdgcn_ds_read_tr16_b64_v4i16((__attribute__((address_space(3))) v4i16_t*)p)); }
#define ATT_WAITV(n) asm volatile("s_waitcnt vmcnt(" #n ")" ::: "memory")
__device__ __forceinline__ void glds16(const void* gsrc, unsigned lds_dst) { unsigned keep;
    asm volatile("s_mov_b32 %0, m0\n\ts_mov_b32 m0, %2\n\ts_nop 0\n\tglobal_load_lds_dwordx4 %1, off\n\ts_mov_b32 m0, %0" : "=&s"(keep) : "v"(gsrc), "s"(lds_dst) : "memory"); }
#define ATT_GLDS(src, dst) glds16((src), (unsigned)__builtin_amdgcn_readfirstlane((int)(dst)))

struct Desc {
    const unsigned short *Q0, *Q1, *K, *V;
    int dil, r, qt0, qt1;
    unsigned short* po; float* pl;
    const unsigned short *po_a, *po_b; const float *pl_a, *pl_b;
    const unsigned short *gate0, *gate1; unsigned short *mix0, *mix1;
    float sink0, sink1;
};
struct LaneK { unsigned koff[4], voff[4]; };
__device__ __forceinline__ LaneK lane_offsets(int dil, int lane) {
    LaneK L;
#pragma unroll
    for (int i = 0; i < 4; ++i) {
        const int row = 8 * i + (lane >> 3), chunk = (lane & 7) ^ (KSWZ ? ((row >> 1) & 7) : 0);
        L.koff[i] = (unsigned)(dil * row) * 128u + (unsigned)chunk * 16u;
        const int vchunk = (lane & 7) ^ (4 * ((row >> 1) & 1));
        L.voff[i] = (unsigned)(dil * row) * 128u + (unsigned)vchunk * 16u;
    }
    return L;
}
#define ATT_DMA_K(D, L, ktlo, j, sl) do { const char* s_ = (const char*)(D).K + (size_t)(D).r * 128 + (size_t)((ktlo) + (j)) * ((size_t)(D).dil * 4096); const unsigned d_ = ring0 + ((sl) & 1) * 8192; \
        ATT_GLDS(s_ + (L).koff[0], d_); ATT_GLDS(s_ + (L).koff[1], d_ + 1024); ATT_GLDS(s_ + (L).koff[2], d_ + 2048); ATT_GLDS(s_ + (L).koff[3], d_ + 3072); } while (0)
#define ATT_DMA_V(D, L, ktlo, j, sl) do { const char* s_ = (const char*)(D).V + (size_t)(D).r * 128 + (size_t)((ktlo) + (j)) * ((size_t)(D).dil * 4096); const unsigned d_ = ring0 + ((sl) & 1) * 8192 + 4096; \
        ATT_GLDS(s_ + (L).voff[0], d_); ATT_GLDS(s_ + (L).voff[1], d_ + 1024); ATT_GLDS(s_ + (L).voff[2], d_ + 2048); ATT_GLDS(s_ + (L).voff[3], d_ + 3072); } while (0)
template <int DRY = 0>
__device__ __forceinline__ void prefetch(const Desc& D, unsigned ring0, bf16x8 (&qr)[2][4], int lane, int par = 0) {
    const int q = lane & 31, hi = lane >> 5;
    const int ktlo = D.qt0 >= 4 ? D.qt0 - 4 : 0, nt = D.qt1 - ktlo + 1;
    const LaneK L = lane_offsets(D.dil, lane);
    { const unsigned short* q0 = D.Q0 + (size_t)(D.r + D.dil * (32 * D.qt0 + q)) * 64 + hi * 8; const unsigned short* q1 = D.Q1 + (size_t)(D.r + D.dil * (32 * D.qt1 + q)) * 64 + hi * 8;
#pragma unroll
      for (int d0 = 0; d0 < 4; ++d0) { qr[0][d0] = *(const bf16x8*)(q0 + d0 * 16); qr[1][d0] = *(const bf16x8*)(q1 + d0 * 16); } }
    asm volatile("s_waitcnt lgkmcnt(0)" ::: "memory");
    if (DRY != 2) { ATT_DMA_K(D, L, ktlo, 0, par); ATT_DMA_V(D, L, ktlo, 0, par);
    if (nt > 1) { ATT_DMA_K(D, L, ktlo, 1, par + 1); ATT_DMA_V(D, L, ktlo, 1, par + 1); }
    if (DRY == 3) { if (nt > 2) { ATT_DMA_K(D, L, ktlo, 2, par); ATT_DMA_V(D, L, ktlo, 2, par); } if (nt > 3) { ATT_DMA_K(D, L, ktlo, 3, par + 1); ATT_DMA_V(D, L, ktlo, 3, par + 1); } } }
}
template <int MODE, int DRY = 0>
__device__ __forceinline__ void attn_item(lds_ptr ring, lds_ptr stage, const Desc& D, bool has_next, const Desc& N, bf16x8 (&qx)[2][4], int& par, int lane) {
    const int q = lane & 31, hi = lane >> 5;
    const int ktlo = D.qt0 >= 4 ? D.qt0 - 4 : 0, nt = D.qt1 - ktlo + 1;
    constexpr int DMIN = (MODE == 0) ? 1 : 0;
    const unsigned ring0 = (unsigned)(uintptr_t)ring;
    const LaneK L = lane_offsets(D.dil, lane);
    const int krow = q * 128, ksw = KSWZ ? ((q >> 1) & 7) : 0;
    const int vsw = ((lane & 15) >> 3) & 1;
    const int vb = ((lane >> 4) & 1) * 32 + (lane & 3) * 8 + (4 * hi + ((lane & 15) >> 2)) * 128;
    f32x16 o00 = {}, o01 = {}, o10 = {}, o11 = {}; float ls0 = 0.f, ls1 = 0.f;
    asm volatile("s_waitcnt vmcnt(0)" ::: "memory");
    bf16x8 qr[2][4];
#pragma unroll
    for (int s_ = 0; s_ < 2; ++s_)
#pragma unroll
        for (int d0 = 0; d0 < 4; ++d0) qr[s_][d0] = qx[s_][d0];
    asm volatile("" : "+v"(qr[0][0]), "+v"(qr[0][1]), "+v"(qr[0][2]), "+v"(qr[0][3]), "+v"(qr[1][0]), "+v"(qr[1][1]), "+v"(qr[1][2]), "+v"(qr[1][3]));
    const int Nktlo = N.qt0 >= 4 ? N.qt0 - 4 : 0, Nnt = N.qt1 - Nktlo + 1;
    const bool ext = (DRY == 0) && has_next && nt >= 2 && N.dil == D.dil;
    const int nx = ext ? (Nnt < 2 ? Nnt : 2) : 0;
    for (int j = 0; j < nt; ++j) {
        const int e = nt - 1 - j + nx, kt = ktlo + j; lds_ptr slot = ring + ((j + par) & 1) * 8192;
        const bool act0 = (kt <= D.qt0), act1 = (kt >= D.qt1 - 4);
        if (DRY == 3) { if (e >= 3) ATT_WAITV(28); else if (e == 2) ATT_WAITV(20); else if (e == 1) ATT_WAITV(12); else ATT_WAITV(4); }
        else if (DRY != 2) { if (e >= 1) ATT_WAITV(12); else ATT_WAITV(4); }
        bf16x8 kf[4];
        if (DRY != 1 && DRY != 3) {
#pragma unroll
        for (int ks = 0; ks < 4; ++ks) kf[ks] = *(const __attribute__((address_space(3))) bf16x8*)(slot + krow + (((2 * ks + hi) ^ ksw) * 16));
        asm volatile("s_waitcnt lgkmcnt(0)" ::: "memory");
        asm volatile("" : "+v"(kf[0]), "+v"(kf[1]), "+v"(kf[2]), "+v"(kf[3]));
        }
        if (DRY == 3) { if (e >= 4) ATT_DMA_K(D, L, ktlo, j + 4, j + par); }
        else if (DRY != 2 && e >= 2) { if (j + 2 < nt) ATT_DMA_K(D, L, ktlo, j + 2, j + par); else ATT_DMA_K(N, L, Nktlo, j + 2 - nt, j + par); }
        u32x4 pa0 = {}, pa1 = {}, pb0 = {}, pb1 = {};
#define ATT_SCORE(S, QT, ACT, LS, PW0, PW1) if (ACT) { f32x16 p = {}; \
            _Pragma("unroll") for (int ks = 0; ks < 4; ++ks) p = __builtin_amdgcn_mfma_f32_32x32x16_bf16(kf[ks], qr[S][ks], p, 0, 0, 0); \
            const bool first = (kt == (QT) - 4), last = (kt == (QT)); \
            if (first || last) { _Pragma("unroll") for (int rr = 0; rr < 16; ++rr) { const int kk = crow(rr, hi); const bool bad = (first && kk < q + DMIN) || (last && kk > q); if (bad) p[rr] = -INFINITY; } } \
            float s_ = 0.f; \
            _Pragma("unroll") for (int rr = 0; rr < 16; ++rr) { p[rr] = __builtin_amdgcn_exp2f(p[rr]); s_ += p[rr]; } \
            LS += s_; \
            PW0[0] = cvtpk_s(p[0], p[1]); PW0[1] = cvtpk_s(p[2], p[3]); PW0[2] = cvtpk_s(p[4], p[5]); PW0[3] = cvtpk_s(p[6], p[7]); \
            PW1[0] = cvtpk_s(p[8], p[9]); PW1[1] = cvtpk_s(p[10], p[11]); PW1[2] = cvtpk_s(p[12], p[13]); PW1[3] = cvtpk_s(p[14], p[15]); }
        if (DRY != 1 && DRY != 3) {
        ATT_SCORE(0, D.qt0, act0, ls0, pa0, pa1)
        ATT_SCORE(1, D.qt1, act1, ls1, pb0, pb1)
        }
#undef ATT_SCORE
        if (DRY == 3) { if (e >= 4) ATT_WAITV(28); else if (e == 3) ATT_WAITV(24); else if (e == 2) ATT_WAITV(16); else if (e == 1) ATT_WAITV(8); else ATT_WAITV(0); }
        else if (DRY != 2) { if (e >= 2) ATT_WAITV(12); else if (e == 1) ATT_WAITV(8); else ATT_WAITV(0); }
        if (DRY != 1 && DRY != 3) {
        lds_ptr vp = slot + 4096 + vb;
        s16x4 lo[4], hh[4];
#pragma unroll
        for (int i = 0; i < 4; ++i) { const int o_ = (i & 1) * 2048 + (((i >> 1) ^ vsw) * 64); lo[i] = vtr(vp + o_); hh[i] = vtr(vp + o_ + 1024); }
#define ATT_VFR(i) (bf16x8){lo[i][0], lo[i][1], lo[i][2], lo[i][3], hh[i][0], hh[i][1], hh[i][2], hh[i][3]}
        if (act0) {
            o00 = __builtin_amdgcn_mfma_f32_32x32x16_bf16(__builtin_bit_cast(bf16x8, pa0), ATT_VFR(0), o00, 0, 0, 0);
            o00 = __builtin_amdgcn_mfma_f32_32x32x16_bf16(__builtin_bit_cast(bf16x8, pa1), ATT_VFR(1), o00, 0, 0, 0);
            o01 = __builtin_amdgcn_mfma_f32_32x32x16_bf16(__builtin_bit_cast(bf16x8, pa0), ATT_VFR(2), o01, 0, 0, 0);
            o01 = __builtin_amdgcn_mfma_f32_32x32x16_bf16(__builtin_bit_cast(bf16x8, pa1), ATT_VFR(3), o01, 0, 0, 0);
        }
        if (act1) {
            o10 = __builtin_amdgcn_mfma_f32_32x32x16_bf16(__builtin_bit_cast(bf16x8, pb0), ATT_VFR(0), o10, 0, 0, 0);
            o10 = __builtin_amdgcn_mfma_f32_32x32x16_bf16(__builtin_bit_cast(bf16x8, pb1), ATT_VFR(1), o10, 0, 0, 0);
            o11 = __builtin_amdgcn_mfma_f32_32x32x16_bf16(__builtin_bit_cast(bf16x8, pb0), ATT_VFR(2), o11, 0, 0, 0);
            o11 = __builtin_amdgcn_mfma_f32_32x32x16_bf16(__builtin_bit_cast(bf16x8, pb1), ATT_VFR(3), o11, 0, 0, 0);
        }
#undef ATT_VFR
        }
        asm volatile("s_waitcnt lgkmcnt(0)" ::: "memory");
        if (DRY == 3) { if (e >= 4) ATT_DMA_V(D, L, ktlo, j + 4, j + par); }
        else if (DRY != 2 && e >= 2) { if (j + 2 < nt) ATT_DMA_V(D, L, ktlo, j + 2, j + par); else ATT_DMA_V(N, L, Nktlo, j + 2 - nt, j + par); }
    }
    int lane_s = lane; asm volatile("" : "+v"(lane_s));
    {
    const int lane = lane_s, q = lane & 31, hi = lane >> 5;
    __attribute__((address_space(3))) unsigned short* st = (__attribute__((address_space(3))) unsigned short*)stage;
    u32x4 g0[4], a0[4], b0[4]; float la0[4], lb0[4];
#define ATT_EPI_T(QT, pp) ((size_t)(D.r + D.dil * (32 * (QT) + 16 * ((pp) >> 1) + 8 * ((pp) & 1) + (lane >> 3))))
#define ATT_EPI_LOAD(QT, G, A, B, LA, LB, GATE) do { _Pragma("unroll") for (int pp = 0; pp < 4; ++pp) { const size_t t = ATT_EPI_T(QT, pp); const int ch = lane & 7; \
        G[pp] = *(const u32x4*)((GATE) + t * 512 + ch * 8); \
        if (MODE == 2) { A[pp] = __builtin_nontemporal_load((const u32x4*)(D.po_a + t * 64 + ch * 8)); B[pp] = __builtin_nontemporal_load((const u32x4*)(D.po_b + t * 64 + ch * 8)); \
                         LA[pp] = __builtin_nontemporal_load(D.pl_a + t); LB[pp] = __builtin_nontemporal_load(D.pl_b + t); } } } while (0)
#define ATT_EPI_TOUCH(G, A, B, LA, LB) do { asm volatile("" : "+v"(G[0]), "+v"(G[1]), "+v"(G[2]), "+v"(G[3])); \
        if (MODE == 2) { asm volatile("" : "+v"(A[0]), "+v"(A[1]), "+v"(A[2]), "+v"(A[3]), "+v"(B[0]), "+v"(B[1]), "+v"(B[2]), "+v"(B[3])); \
                         asm volatile("" : "+v"(LA[0]), "+v"(LA[1]), "+v"(LA[2]), "+v"(LA[3]), "+v"(LB[0]), "+v"(LB[1]), "+v"(LB[2]), "+v"(LB[3])); } } while (0)
#define ATT_EPI_PROC(QT, OA, OB, LS, G, A, B, LA, LB, MIX, SINK) do { \
        { auto sw_ = __builtin_amdgcn_permlane32_swap(__float_as_uint(LS), __float_as_uint(LS), false, false); LS = __uint_as_float(sw_[0]) + __uint_as_float(sw_[1]); } \
        _Pragma("unroll") for (int hf = 0; hf < 2; ++hf) { \
            _Pragma("unroll") for (int i8 = 0; i8 < 8; ++i8) { const int rl = crow(i8, hi); \
                st[rl * 64 + q] = (unsigned short)(cvtpk_s(OA[8 * hf + i8], 0.f) & 0xffffu); st[rl * 64 + 32 + q] = (unsigned short)(cvtpk_s(OB[8 * hf + i8], 0.f) & 0xffffu); } \
            _Pragma("unroll") for (int i2 = 0; i2 < 2; ++i2) { \
                const int pp = 2 * hf + i2, rl = 8 * i2 + (lane >> 3), ch = lane & 7, row = 16 * hf + rl; \
                const u32x4 ow = *(const __attribute__((address_space(3))) u32x4*)(st + rl * 64 + ch * 8); \
                float l = __shfl(LS, row); \
                const size_t t = ATT_EPI_T(QT, pp); \
                if (MODE == 1) { *(u32x4*)(D.po + t * 64 + ch * 8) = ow; if (ch == 0) D.pl[t] = l; } \
                else { \
                    float v[8]; \
                    _Pragma("unroll") for (int k = 0; k < 4; ++k) { v[2 * k] = __uint_as_float(ow[k] << 16); v[2 * k + 1] = __uint_as_float(ow[k] & 0xffff0000u); } \
                    if (MODE == 2) { \
                        l += LA[pp] + LB[pp]; \
                        _Pragma("unroll") for (int k = 0; k < 4; ++k) { v[2 * k] += __uint_as_float(A[pp][k] << 16) + __uint_as_float(B[pp][k] << 16); v[2 * k + 1] += __uint_as_float(A[pp][k] & 0xffff0000u) + __uint_as_float(B[pp][k] & 0xffff0000u); } \
                    } else l += (SINK); \
                    const float rl_ = 1.0f / l; \
                    u32x4 w; \
                    _Pragma("unroll") for (int k = 0; k < 4; ++k) { const float ga_ = __uint_as_float(G[pp][k] << 16), gb_ = __uint_as_float(G[pp][k] & 0xffff0000u); \
                        const float sa_ = ga_ * __builtin_amdgcn_rcpf(1.f + __builtin_amdgcn_exp2f(-1.4426950408889634f * ga_)), sb_ = gb_ * __builtin_amdgcn_rcpf(1.f + __builtin_amdgcn_exp2f(-1.4426950408889634f * gb_)); \
                        w[k] = cvtpk_s(v[2 * k] * rl_ * sa_, v[2 * k + 1] * rl_ * sb_); } \
                    *(u32x4*)((MIX) + t * 1024 + ch * 8) = w; \
                } \
            } \
        } } while (0)
    if (DRY != 0) {
        asm volatile("" :: "v"(o00), "v"(o01), "v"(o10), "v"(o11), "v"(ls0), "v"(ls1));
        if (has_next) prefetch<DRY>(N, ring0, qx, lane, 0);
    } else if (MODE == 1) {
        if (has_next) { if (!ext) prefetch(N, ring0, qx, lane, 0); else { const unsigned short* q0_ = N.Q0 + (size_t)(N.r + N.dil * (32 * N.qt0 + q)) * 64 + hi * 8; const unsigned short* q1_ = N.Q1 + (size_t)(N.r + N.dil * (32 * N.qt1 + q)) * 64 + hi * 8;
            _Pragma("unroll") for (int d0 = 0; d0 < 4; ++d0) { qx[0][d0] = *(const bf16x8*)(q0_ + d0 * 16); qx[1][d0] = *(const bf16x8*)(q1_ + d0 * 16); } } }
        ATT_EPI_PROC(D.qt0, o00, o01, ls0, g0, a0, b0, la0, lb0, D.mix0, D.sink0);
        ATT_EPI_PROC(D.qt1, o10, o11, ls1, g0, a0, b0, la0, lb0, D.mix1, D.sink1);
    } else {
        ATT_EPI_LOAD(D.qt0, g0, a0, b0, la0, lb0, D.gate0);
        __builtin_amdgcn_sched_barrier(0);
        ATT_EPI_TOUCH(g0, a0, b0, la0, lb0);
        __builtin_amdgcn_sched_barrier(0);
        ATT_EPI_PROC(D.qt0, o00, o01, ls0, g0, a0, b0, la0, lb0, D.mix0, D.sink0);
        __builtin_amdgcn_sched_barrier(0);
        ATT_EPI_LOAD(D.qt1, g0, a0, b0, la0, lb0, D.gate1);
        __builtin_amdgcn_sched_barrier(0);
        if (has_next) { if (!ext) prefetch(N, ring0, qx, lane, 0); else { const unsigned short* q0_ = N.Q0 + (size_t)(N.r + N.dil * (32 * N.qt0 + q)) * 64 + hi * 8; const unsigned short* q1_ = N.Q1 + (size_t)(N.r + N.dil * (32 * N.qt1 + q)) * 64 + hi * 8;
            _Pragma("unroll") for (int d0 = 0; d0 < 4; ++d0) { qx[0][d0] = *(const bf16x8*)(q0_ + d0 * 16); qx[1][d0] = *(const bf16x8*)(q1_ + d0 * 16); } } }
        __builtin_amdgcn_sched_barrier(0);
        ATT_EPI_TOUCH(g0, a0, b0, la0, lb0);
        __builtin_amdgcn_sched_barrier(0);
        ATT_EPI_PROC(D.qt1, o10, o11, ls1, g0, a0, b0, la0, lb0, D.mix1, D.sink1);
    }
#undef ATT_EPI_T
#undef ATT_EPI_LOAD
#undef ATT_EPI_TOUCH
#undef ATT_EPI_PROC
    }
    par = ext ? ((par + nt) & 1) : 0;
}
#undef ATT_DMA_K
#undef ATT_DMA_V
#undef ATT_WAITV
#undef ATT_GLDS
}
#ifndef PG8_SP2
#define PG8_SP2 true
#endif
#ifndef PG8_ALIGN
#define PG8_ALIGN true
#endif
constexpr int NWAVES = 8;
constexpr int BATCH = 8, SEQ = 4096, DM = 1024, M = BATCH * SEQ, NIN = 3328, HD = 64;
constexpr float LOG2E = 1.4426950408889634f;
constexpr size_t MiB = 1u << 20;
constexpr size_t WS_CTL = 0, CTL_ZERO_BYTES = 64 * 1024;
constexpr size_t WS_COS = 1 * MiB, WS_SIN = WS_COS + 512 * 1024;
constexpr size_t WS_WIT = 2 * MiB, WS_WOT = 9 * MiB;
constexpr size_t WS_XN = 16 * MiB;
constexpr size_t WS_QA = 80 * MiB, WS_QB = 112 * MiB, WS_KA = 144 * MiB, WS_VA = 152 * MiB, WS_KB = 160 * MiB, WS_VB = 192 * MiB;
constexpr size_t WS_GA = 224 * MiB, WS_GB = 256 * MiB, WS_MIX = 288 * MiB, WS_PO16 = 352 * MiB, WS_PO4 = 384 * MiB, WS_PL16 = 416 * MiB, WS_PL4 = 417 * MiB, WS_END = 418 * MiB;
constexpr int CW_BAR = 1024;
constexpr int RING_OFF = 0, RING_BYTES = 131072;
constexpr int LDSCTL_OFF = RING_BYTES + 16384, MISC_OFF = LDSCTL_OFF + 320;
constexpr int LDS_BYTES = 149504;
static_assert(MISC_OFF + 128 <= LDS_BYTES, "LDS map");
#define GAS __attribute__((address_space(1)))
#define LAS __attribute__((address_space(3)))
typedef unsigned short bf16;
typedef unsigned v4u __attribute__((ext_vector_type(4)));
typedef float f32x4 __attribute__((ext_vector_type(4)));
typedef short bf16x8 __attribute__((ext_vector_type(8)));
typedef GAS unsigned gu32;
typedef GAS unsigned long long gu64;
#define RLX_AGENT __ATOMIC_RELAXED, __HIP_MEMORY_SCOPE_AGENT
#define LDS_WAIT() asm volatile("s_waitcnt lgkmcnt(0)" ::: "memory")
#define VM_WAIT() asm volatile("s_waitcnt vmcnt(0)" ::: "memory")
__device__ __forceinline__ unsigned long long rt() { return __builtin_amdgcn_s_memrealtime(); }
__device__ __forceinline__ unsigned f2bf(float f) { unsigned u = __builtin_bit_cast(unsigned, f); return (u + 0x7fffu + ((u >> 16) & 1u)) >> 16; }
__device__ __forceinline__ unsigned pk2(float lo, float hi) { return f2bf(lo) | (f2bf(hi) << 16); }

#define XB_TMO      128
#define XB_XCNT(j)  (256  + 64 * (j))
#define XB_XSUB(j)  (1280 + 64 * (j))
#define XB_XGEN(j)  (2304 + 64 * (j))
#define XB_TOP      3328
#define XB_TOPGEN   3392
#define XCD_BAR_WORDS 3456
#define XB_SPIN_CAP (1u << 18)

__device__ __forceinline__ unsigned xb_ld(unsigned* p)              { return __hip_atomic_load(p, __ATOMIC_RELAXED, __HIP_MEMORY_SCOPE_AGENT); }
__device__ __forceinline__ unsigned xb_add(unsigned* p, unsigned v) { return __hip_atomic_fetch_add(p, v, __ATOMIC_RELAXED, __HIP_MEMORY_SCOPE_AGENT); }
__device__ __forceinline__ unsigned xb_xcc_id() { return (unsigned)__builtin_amdgcn_s_getreg((3 << 11) | 20) & 0xFu; }
#define XB_SPIN(cond, bar) do { unsigned _sp = 0; while (cond) { __builtin_amdgcn_s_sleep(1); \
    if ((++_sp & 255u) == 0u) { if (xb_ld(&(bar)[XB_TMO])) break; if (_sp > XB_SPIN_CAP) { atomicAdd(&(bar)[XB_TMO], 1u); break; } } } } while (0)

struct XcdBarrier {
    unsigned* bar; unsigned x;
    volatile LAS unsigned* st;
};

__device__ __forceinline__ XcdBarrier xcd_barrier_post(unsigned* bar, volatile LAS unsigned* st) {
    XcdBarrier b; b.bar = bar; b.x = xb_xcc_id(); b.st = st;
    if (threadIdx.x == 0) (void)xb_add(&bar[XB_XCNT(b.x)], 1u);
    return b;
}
__device__ __forceinline__ void xcd_barrier_complete(unsigned* bar, unsigned x, unsigned& nloc, unsigned& nx) {
    const unsigned G = gridDim.x * gridDim.y * gridDim.z;
    unsigned sum, cnt, mine, sp = 0u;
    for (;;) {
        sum = 0u; cnt = 0u; mine = 0u;
#pragma unroll
        for (unsigned j = 0; j < 16; ++j) { const unsigned c = xb_ld(&bar[XB_XCNT(j)]); sum += c; cnt += (c > 0u) ? 1u : 0u; mine = (j == x) ? c : mine; }
        if (sum == G) break;
        __builtin_amdgcn_s_sleep(1);
        if ((++sp & 255u) == 0u) { if (xb_ld(&bar[XB_TMO])) break; if (sp > XB_SPIN_CAP) { atomicAdd(&bar[XB_TMO], 1u); break; } }
    }
    nloc = mine > 0u ? mine : 1u; nx = cnt > 0u ? cnt : 1u;
}

__device__ __forceinline__ void xcd_barrier(const XcdBarrier& b) {
    asm volatile("s_waitcnt vmcnt(0)" ::: "memory");
    __syncthreads();
    if (threadIdx.x == 0) {
        unsigned* bar = b.bar;
        __builtin_amdgcn_s_waitcnt(0);
        unsigned nloc = b.st[0], nx = b.st[1];
        if (nloc == 0u) { xcd_barrier_complete(bar, b.x, nloc, nx); b.st[0] = nloc; b.st[1] = nx; }
        const unsigned old = xb_add(&bar[XB_XSUB(b.x)], 1u);
        const unsigned gen = old / nloc;
        if (old + 1u == (gen + 1u) * nloc) {
            __builtin_amdgcn_fence(__ATOMIC_RELEASE, "agent");
            asm volatile("s_waitcnt vmcnt(0)" ::: "memory");
            const unsigned og = xb_add(&bar[XB_TOP], 1u);
            const unsigned tg = og / nx;
            if (og + 1u == (tg + 1u) * nx) xb_add(&bar[XB_TOPGEN], 1u);
            else XB_SPIN(xb_ld(&bar[XB_TOPGEN]) == tg, bar);
            __builtin_amdgcn_fence(__ATOMIC_ACQUIRE, "agent");
            xb_add(&bar[XB_XGEN(b.x)], 1u);
            asm volatile("s_waitcnt vmcnt(0)" ::: "memory");
        } else {
            XB_SPIN(xb_ld(&bar[XB_XGEN(b.x)]) == gen, bar);
            __builtin_amdgcn_fence(__ATOMIC_ACQUIRE, "agent");
            asm volatile("s_waitcnt vmcnt(0)" ::: "memory");
        }
    }
    __syncthreads();
}
static_assert((CW_BAR + XCD_BAR_WORDS) * 4 <= (int)CTL_ZERO_BYTES, "barrier words inside the memset region");

struct Frame {
    LAS unsigned char* lds;
    volatile LAS unsigned* MISC;
    gu32* ctl;
    int tid, lane, wave;
    int vcu, G;
};
__device__ __forceinline__ float bf2f(bf16 b) { return __uint_as_float(((unsigned)b) << 16); }
__device__ __forceinline__ float wave_sum(float v) {
#pragma unroll
    for (int o = 1; o < 64; o <<= 1) v += __shfl_xor(v, o);
    return v;
}
__device__ __forceinline__ void sincos_d(float ang, float& s, float& c) {
    const double a = (double)ang;
    const double k = rint(a * 0.6366197723675814);
    double y = fma(-k, 1.5707963267948966, a);
    y = fma(-k, 6.123233995736766e-17, y);
    const double y2 = y * y;
    const double sp = y * (1.0 + y2 * (-1.0 / 6 + y2 * (1.0 / 120 + y2 * (-1.0 / 5040 + y2 * (1.0 / 362880 + y2 * (-1.0 / 39916800 + y2 * (1.0 / 6227020800.0)))))));
    const double cp = 1.0 + y2 * (-0.5 + y2 * (1.0 / 24 + y2 * (-1.0 / 720 + y2 * (1.0 / 40320 + y2 * (-1.0 / 3628800 + y2 * (1.0 / 479001600.0 + y2 * (-1.0 / 87178291200.0)))))));
    const int q = ((int)(long long)k) & 3;
    const double ss = (q == 0) ? sp : (q == 1) ? cp : (q == 2) ? -sp : -cp;
    const double cc = (q == 0) ? cp : (q == 1) ? -sp : (q == 2) ? -cp : sp;
    s = (float)ss; c = (float)cc;
}
__device__ __forceinline__ void p0_transpose_item(const float* W, int K, int N, bf16* WT, int k0, int n0, int d0, LAS float* scr, int lane) {
#pragma unroll 8
    for (int i = 0; i < 32; ++i) { const int kk = 2 * i + (lane >> 5); scr[kk * 33 + (lane & 31)] = W[(size_t)(k0 + kk) * N + n0 + (lane & 31)]; }
    LDS_WAIT(); asm volatile("" ::: "memory");
    const int c = lane & 7;
#pragma unroll
    for (int j = 0; j < 4; ++j) { const int n = (lane >> 3) + 8 * j; const LAS float* s = scr + (8 * c) * 33 + n;
        v4u o; o.x = pk2(s[0 * 33], s[1 * 33]); o.y = pk2(s[2 * 33], s[3 * 33]); o.z = pk2(s[4 * 33], s[5 * 33]); o.w = pk2(s[6 * 33], s[7 * 33]);
        *(GAS v4u*)(WT + (size_t)(d0 + n) * K + k0 + 8 * c) = o; }
    LDS_WAIT(); asm volatile("" ::: "memory");
}
struct Ptrs {
    const float *x, *gain, *w_in, *qna, *kna, *sinks, *qnb, *knb, *w_out; float* out;
    bf16 *WIT, *WOT, *XN, *QA, *KA, *VA, *GA, *QB, *KB, *VB, *GB, *MIX, *PO16, *PO4; float *cosT, *sinT, *PL16, *PL4;
};
__device__ __forceinline__ void p0_prologue(Frame& F, const Ptrs& P) {
    LAS float* scr = (LAS float*)(F.lds + RING_OFF + F.wave * 16384);
    const int gw = F.vcu * NWAVES + F.wave, NGW = F.G * NWAVES;
    constexpr int I_IN = (DM / 64) * (NIN / 32), I_OUT = (DM / 64) * (DM / 32);
    for (int it = gw; it < I_IN + I_OUT; it += NGW) {
        if (it < I_IN) { const int nblk = NIN / 32, kb = it / nblk, nb = it % nblk, n0 = 32 * nb;
            const int pn = n0 >> 8, rem = n0 & 255, wc = rem >> 6, bjj = (rem >> 5) & 1;
            p0_transpose_item(P.w_in, DM, NIN, P.WIT, 64 * kb, n0, 256 * pn + 128 * bjj + 32 * wc, scr, F.lane); }
        else { const int r = it - I_IN, nblk = DM / 32, kb = r / nblk, nb = r % nblk; p0_transpose_item(P.w_out, DM, DM, P.WOT, 64 * kb, 32 * nb, 32 * nb, scr, F.lane); }
    }
    for (int e = (F.vcu * NWAVES * 64) + F.tid; e < SEQ * 32; e += F.G * NWAVES * 64) {
        const int t = e >> 5, i = e & 31;
        double r = 1.0; for (int k = 0; k < i; ++k) r *= 0.7498942093324558;
        const float inv = (float)r; const float ang = (float)t * inv;
        float s, c; sincos_d(ang, s, c); P.cosT[e] = c; P.sinT[e] = s;
    }
    for (int m = gw; m < M; m += NGW) {
        const GAS f32x4* xr = (const GAS f32x4*)(P.x + (size_t)m * DM) + F.lane;
        f32x4 v[4]; float ss = 0.f;
#pragma unroll
        for (int j = 0; j < 4; ++j) { v[j] = xr[64 * j]; ss += (v[j].x * v[j].x + v[j].y * v[j].y) + (v[j].z * v[j].z + v[j].w * v[j].w); }
        const float rstd = rsqrtf(wave_sum(ss) * (1.f / DM) + 1e-6f);
        GAS unsigned long long* o8 = (GAS unsigned long long*)(P.XN + (size_t)m * DM) + F.lane;
#pragma unroll
        for (int j = 0; j < 4; ++j) { const f32x4 g = ((const GAS f32x4*)P.gain)[64 * j + F.lane];
            o8[64 * j] = (unsigned long long)pk2(v[j].x * rstd * g.x, v[j].y * rstd * g.y) | ((unsigned long long)pk2(v[j].z * rstd * g.z, v[j].w * rstd * g.w) << 32); }
    }
}
constexpr int STAGE_OFF = RING_BYTES;
__device__ __forceinline__ att::Desc b_desc(const Ptrs& P, int uid, int mode, int wave, int k) {
    const int b = uid >> 5, h = (uid >> 2) & 7, blk = uid & 3; const size_t hb = (size_t)(b * 8 + h) * SEQ;
    att::Desc D{};
    D.Q0 = P.QB + hb * 64; D.Q1 = D.Q0; D.K = P.KB + hb * 64; D.V = P.VB + hb * 64;
    if (mode == 1) {
        if (wave < 4) { D.dil = 16; D.r = 4 * wave + k; D.qt0 = 2 * blk; D.po = P.PO16 + hb * 64; D.pl = P.PL16 + hb; }
        else { D.dil = 4; D.r = wave - 4; D.qt0 = 8 * blk + 2 * k; D.po = P.PO4 + hb * 64; D.pl = P.PL4 + hb; }
    } else {
        D.dil = 1; D.r = 0; D.qt0 = 32 * blk + 2 * (2 * wave + k);
        D.po_a = P.PO16 + hb * 64; D.po_b = P.PO4 + hb * 64; D.pl_a = P.PL16 + hb; D.pl_b = P.PL4 + hb;
        D.gate0 = P.GB + (size_t)b * SEQ * 512 + h * 64; D.gate1 = D.gate0; D.mix0 = P.MIX + (size_t)b * SEQ * DM + 512 + h * 64; D.mix1 = D.mix0;
    }
    D.qt1 = D.qt0 + 1;
    return D;
}
__device__ __forceinline__ att::Desc a_desc(const Ptrs& P, int b, int hp, int qt) {
    const int kv = hp >> 1, h0 = 2 * hp;
    att::Desc D{};
    D.Q0 = P.QA + (size_t)(b * 8 + h0) * SEQ * 64; D.Q1 = D.Q0 + (size_t)SEQ * 64;
    D.K = P.KA + (size_t)(b * 2 + kv) * SEQ * 64; D.V = P.VA + (size_t)(b * 2 + kv) * SEQ * 64;
    D.dil = 1; D.r = 0; D.qt0 = qt; D.qt1 = qt;
    D.gate0 = P.GA + (size_t)b * SEQ * 512 + h0 * 64; D.gate1 = D.gate0 + 64; D.mix0 = P.MIX + (size_t)b * SEQ * DM + h0 * 64; D.mix1 = D.mix0 + 64;
    D.sink0 = __builtin_amdgcn_exp2f(P.sinks[h0] * LOG2E); D.sink1 = __builtin_amdgcn_exp2f(P.sinks[h0 + 1] * LOG2E);
    return D;
}
#ifndef REP_2A
#define REP_2A 1
#define REP_2B 1
#define REP_2C 1
#endif
__device__ __forceinline__ void p2_attention(Frame& F, const Ptrs& P, const XcdBarrier& bar) {
    att::lds_ptr ring = (att::lds_ptr)(F.lds + RING_OFF + F.wave * 16384), stage = (att::lds_ptr)(F.lds + STAGE_OFF + F.wave * 2048);
    int lane_ = F.lane; asm volatile("" : "+v"(lane_));
    const int lane = lane_, wave = F.wave, uid = F.vcu;
    const unsigned ring0 = (unsigned)(uintptr_t)ring;
    att::bf16x8 qr[2][4];
    att::Desc D, N; int par = 0;
#ifdef DRY_PASS
    D = b_desc(P, uid, 1, wave, 0);
    att::prefetch<DRY_PASS>(D, ring0, qr, lane);
    for (int k = 0; k < 4; ++k) {
        N = b_desc(P, uid, 1, wave, (k + 1) & 3);
        att::attn_item<1, DRY_PASS>(ring, stage, D, k < 3, N, qr, par, lane); D = N;
    }
    asm volatile("s_waitcnt vmcnt(0) lgkmcnt(0)" ::: "memory");
#endif
#pragma unroll
    for (int rep = 0; rep < REP_2A; ++rep) {
    D = b_desc(P, uid, 1, wave, 0);
    par = 0; att::prefetch(D, ring0, qr, lane, 0);
    for (int k = 0; k < 4; ++k) {
        N = b_desc(P, uid, 1, wave, (k + 1) & 3);
        att::attn_item<1>(ring, stage, D, k < 3, N, qr, par, lane); D = N;
    }
    }
    asm volatile("s_waitcnt vmcnt(0) lgkmcnt(0)\n\ts_barrier" ::: "memory");
#pragma unroll
    for (int rep = 0; rep < REP_2B; ++rep) {
    D = b_desc(P, uid, 2, wave, 0);
    par = 0; att::prefetch(D, ring0, qr, lane, 0);
    for (int k = 0; k < 2; ++k) {
        N = b_desc(P, uid, 2, wave, 1);
        att::attn_item<2>(ring, stage, D, k < 1, N, qr, par, lane); D = N;
    }
    }
#pragma unroll
    for (int rep = 0; rep < REP_2C; ++rep) {
    {
        const int aid0 = uid * 16 + wave * 2;
        D = a_desc(P, aid0 >> 9, (aid0 >> 7) & 3, aid0 & 127);
        par = 0; att::prefetch(D, ring0, qr, lane, 0);
        for (int k = 0; k < 2; ++k) {
            N = a_desc(P, aid0 >> 9, (aid0 >> 7) & 3, (aid0 & 127) + 1);
            att::attn_item<0>(ring, stage, D, k < 1, N, qr, par, lane); D = N;
        }
    }
    }
}

struct Args { const float* in[9]; float* out; unsigned char* ws; };
__global__ void __launch_bounds__(NWAVES * 64, 2) mega_fwd(Args args) {
    extern __shared__ __attribute__((aligned(16))) unsigned char lds[];
    Frame F;
    F.lds = (LAS unsigned char*)lds;
    F.MISC = (volatile LAS unsigned*)(F.lds + MISC_OFF);
    F.tid = threadIdx.x; F.lane = F.tid & 63; F.wave = __builtin_amdgcn_readfirstlane(F.tid >> 6);
    F.G = gridDim.x; { const int bx = blockIdx.x; F.vcu = (F.G % 8 == 0) ? (bx % 8) * (F.G / 8) + bx / 8 : bx; }
    unsigned char* ws = args.ws;
    F.ctl = (gu32*)(ws + WS_CTL);
    Ptrs P;
    P.x = args.in[0]; P.gain = args.in[1]; P.w_in = args.in[2]; P.qna = args.in[3]; P.kna = args.in[4]; P.sinks = args.in[5]; P.qnb = args.in[6]; P.knb = args.in[7]; P.w_out = args.in[8]; P.out = args.out;
    P.WIT = (bf16*)(ws + WS_WIT); P.WOT = (bf16*)(ws + WS_WOT); P.XN = (bf16*)(ws + WS_XN);
    P.QA = (bf16*)(ws + WS_QA); P.KA = (bf16*)(ws + WS_KA); P.VA = (bf16*)(ws + WS_VA); P.GA = (bf16*)(ws + WS_GA);
    P.QB = (bf16*)(ws + WS_QB); P.KB = (bf16*)(ws + WS_KB); P.VB = (bf16*)(ws + WS_VB); P.GB = (bf16*)(ws + WS_GB); P.MIX = (bf16*)(ws + WS_MIX);
    P.cosT = (float*)(ws + WS_COS); P.sinT = (float*)(ws + WS_SIN);
    P.PO16 = (bf16*)(ws + WS_PO16); P.PO4 = (bf16*)(ws + WS_PO4); P.PL16 = (float*)(ws + WS_PL16); P.PL4 = (float*)(ws + WS_PL4);
    for (int u = F.tid; u < (LDS_BYTES - LDSCTL_OFF) / 4; u += NWAVES * 64) ((LAS unsigned*)(F.lds + LDSCTL_OFF))[u] = 0u;
    __syncthreads();
    XcdBarrier bar = xcd_barrier_post((unsigned*)(F.ctl + CW_BAR), F.MISC + 8);

#ifndef PROBE_TS
#define PROBE_TS 0
#endif
    unsigned long long ts0 = 0, ts1 = 0, ts2 = 0, ts3 = 0, ts4 = 0;
    if (PROBE_TS) ts0 = rt();
#ifndef REP_P0
#define REP_P0 1
#define REP_P1 1
#define REP_P2 1
#define REP_P3 1
#endif
#pragma unroll
    for (int rep = 0; rep < REP_P0; ++rep) {
    p0_prologue(F, P);
    xcd_barrier(bar);
    }
    if (PROBE_TS) ts1 = rt();
#pragma unroll
    for (int rep = 0; rep < REP_P1; ++rep) {
#ifdef STAGGER_US
        if ((int)blockIdx.x >= F.G / 2) { const unsigned long long t0_ = rt(); while (rt() - t0_ < (unsigned long long)(STAGGER_US * 100)) __builtin_amdgcn_s_sleep(8); }
#endif
        pg8::Gemm g{P.XN, P.WIT, M, NIN, DM}; pg8::StaticOrder S; S.init(M, NIN, F.G, (int)blockIdx.x);
        pg8::EpiIn E{P.QA, P.KA, P.VA, P.GA, P.QB, P.KB, P.VB, P.GB, P.qna, P.kna, P.qnb, P.knb, P.cosT, P.sinT};
        pg8::gemm_phase<pg8::EpiIn, pg8::StaticOrder, PG8_ALIGN, PG8_SP2>(F.lds + RING_OFF, g, S, E);
    xcd_barrier(bar);
    }
    if (PROBE_TS) ts2 = rt();
#ifdef DRY_GEMM
    {
        pg8::Gemm g{P.XN, P.WIT, M, NIN, DM};
#if DRY_GEMM == 1
        pg8::StaticOrder S; S.init(M, NIN, F.G, (int)blockIdx.x); pg8::EpiNone E{};
        pg8::gemm_phase<pg8::EpiNone, pg8::StaticOrder, PG8_ALIGN, PG8_SP2>(F.lds + RING_OFF, g, S, E);
#elif DRY_GEMM == 3
        pg8::StaticOrder S; S.init(M, NIN, F.G, (int)blockIdx.x);
        pg8::EpiInT<true> E{P.QA, P.KA, P.VA, P.GA, P.QB, P.KB, P.VB, P.GB, P.qna, P.kna, P.qnb, P.knb, P.cosT, P.sinT};
        pg8::gemm_phase<pg8::EpiInT<true>, pg8::StaticOrder, PG8_ALIGN, PG8_SP2>(F.lds + RING_OFF, g, S, E);
#else
        pg8::SameTileOrder S; S.init(M, NIN, F.G, (int)blockIdx.x); pg8::EpiNone E{};
        pg8::gemm_phase<pg8::EpiNone, pg8::SameTileOrder, PG8_ALIGN, PG8_SP2>(F.lds + RING_OFF, g, S, E);
#endif
        xcd_barrier(bar);
    }
#endif
#pragma unroll
    for (int rep = 0; rep < REP_P2; ++rep) {
    p2_attention(F, P, bar);
    xcd_barrier(bar);
    }
    if (PROBE_TS) ts3 = rt();
#pragma unroll
    for (int rep = 0; rep < REP_P3; ++rep) {
        pg8::Gemm g{P.MIX, P.WOT, M, DM, DM}; pg8::StaticOrder S; S.init(M, DM, F.G, (int)blockIdx.x);
        pg8::EpiRes E{P.x, P.out};
        pg8::gemm_phase<pg8::EpiRes, pg8::StaticOrder, PG8_ALIGN, PG8_SP2>(F.lds + RING_OFF, g, S, E);
    }
    if (PROBE_TS) {
        ts4 = rt();
        if (blockIdx.x == 0 && F.tid == 0) {
            const float dA = (PROBE_TS == 1) ? (float)(ts2 - ts1) * 0.01f : (float)(ts1 - ts0) * 0.01f;
            const float dB = (PROBE_TS == 1) ? (float)(ts3 - ts2) * 0.01f : (float)(ts4 - ts3) * 0.01f;
            asm volatile("s_waitcnt vmcnt(0)" ::: "memory");
            P.out[0] += dA; P.out[1] += dB;
        }
    }
}

extern "C" void kernel_launch(void* const* d_in, const int* in_sizes, int n_in, void* d_out, int out_size, void* d_ws, size_t ws_size, hipStream_t stream) {
    static int grid = 0;
    if (grid == 0) {
        if (n_in != 9 || out_size != M * DM || ws_size < WS_END) { fprintf(stderr, "kernel_launch: unexpected shapes (n_in %d, out %d, ws %zu); nothing launched\n", n_in, out_size, ws_size); grid = -1; return; }
        int dev = 0, cus = 0;
        if (hipGetDevice(&dev) != hipSuccess || hipDeviceGetAttribute(&cus, hipDeviceAttributeMultiprocessorCount, dev) != hipSuccess) { grid = -1; return; }
        if (hipFuncSetAttribute((const void*)mega_fwd, hipFuncAttributeMaxDynamicSharedMemorySize, LDS_BYTES) != hipSuccess) { fprintf(stderr, "kernel_launch: hipFuncSetAttribute failed\n"); grid = -1; return; }
        (void)hipGetLastError();
        grid = cus;
    }
    if (grid < 0) return;
#ifdef EXTRA_MEMSET
    (void)hipMemsetAsync((char*)d_ws + WS_CTL + 512 * 1024, 0, CTL_ZERO_BYTES, stream);
#endif
    if (hipMemsetAsync((char*)d_ws + WS_CTL, 0, CTL_ZERO_BYTES, stream) != hipSuccess) { fprintf(stderr, "kernel_launch: hipMemsetAsync failed\n"); return; }
    Args a{};
    for (int i = 0; i < 9; ++i) a.in[i] = (const float*)d_in[i];
    a.out = (float*)d_out; a.ws = (unsigned char*)d_ws;
    hipLaunchKernelGGL(mega_fwd, dim3(grid), dim3(NWAVES * 64), LDS_BYTES, stream, a);
}
```

```cpp
#include <hip/hip_runtime.h>
#include <cstdio>
#include <cstdint>
#include <cmath>
#define KSWZ 1
namespace pg8 {
#define PG8_LAS __attribute__((address_space(3)))
typedef unsigned short bf16_t;
typedef short bf16x8 __attribute__((ext_vector_type(8)));
typedef float f32x4 __attribute__((ext_vector_type(4)));
typedef unsigned u32x4 __attribute__((ext_vector_type(4)));
constexpr int BM = 256, BK = 64, HALF = 128, HTB = HALF * BK * 2  , STAGE_BYTES = 8 * HTB, NXCD = 8, WGM = 8;

__host__ __device__ __forceinline__ int lds_byte(int r, int c) { const int st = (r >> 4) * 2 + (c >> 5), rr = r & 15, cc = c & 31, ob = rr * 64 + cc * 2; return st * 1024 + (ob ^ (((ob >> 9) & 1) << 5)); }
__host__ __device__ __forceinline__ void stage_rc(int b, int& R, int& C) { const int st = b / 1024, sb = b % 1024, swz = sb ^ (((sb >> 9) & 1) << 5); R = (st >> 1) * 16 + swz / 64; C = (st & 1) * 32 + (swz % 64) / 2; }
__host__ __device__ __forceinline__ int perm32(int rho) { const int n = rho >> 4, i = rho & 15; return 8 * (i >> 2) + 4 * n + (i & 3); }

struct Unit { int pm, pn; };
struct Gemm { const bf16_t* A; const bf16_t* Bt; int M, N, K; };

struct StaticOrder {
    int nM, nN, nwg, G, c;
    __host__ __device__ void init(int M, int N, int G_, int c_) { nM = M / BM; nN = N / BM; nwg = nM * nN; G = G_; c = c_; }
    __host__ __device__ bool next(int i, Unit& u) const {
        const long L = (long)i * G + c; if (L >= nwg) return false;
        int wgid = (int)L; { const int q = nwg / NXCD, r = nwg % NXCD, xcd = wgid % NXCD, off = wgid / NXCD; wgid = (xcd < r ? xcd * (q + 1) : r * (q + 1) + (xcd - r) * q) + off; }
        const int nig = WGM * nN, gid = wgid / nig, fm = gid * WGM, gsz = (nM - fm) < WGM ? (nM - fm) : WGM;
        u.pm = fm + ((wgid % nig) % gsz); u.pn = (wgid % nig) / gsz; return true;
    }
    __device__ __forceinline__ void a_ready(const Unit&) const {}
    __device__ __forceinline__ void done(const Unit&) const {}
};
__device__ __forceinline__ unsigned cvt_pk_bf16(float lo, float hi) { unsigned r; asm volatile("v_cvt_pk_bf16_f32 %0, %1, %2" : "=v"(r) : "v"(lo), "v"(hi)); return r; }
typedef float f32x2 __attribute__((ext_vector_type(2)));
typedef float f32x2 __attribute__((ext_vector_type(2)));
constexpr int SEQ_ = 4096;
constexpr float C2_ = 0.18033688011112042f, LOG2E_ = 1.4426950408889634f;
__device__ __forceinline__ u32x4 pack8(const f32x4& a, const f32x4& b) { u32x4 w; w.x = cvt_pk_bf16(a[0], a[1]); w.y = cvt_pk_bf16(a[2], a[3]); w.z = cvt_pk_bf16(b[0], b[1]); w.w = cvt_pk_bf16(b[2], b[3]); return w; }
__device__ __forceinline__ void store_row_pair(bf16_t* rowp, size_t pitch, int fr, u32x4 w0, u32x4 w1) {
    const bool odd = fr & 1;
    const u32x4 snd = odd ? w0 : w1;
    u32x4 rcv;
#pragma unroll
    for (int k = 0; k < 4; ++k) rcv[k] = (unsigned)__shfl_xor((int)snd[k], 1);
    const u32x4 A = odd ? rcv : w0, B = odd ? w1 : rcv;
    bf16_t* pa = odd ? rowp - pitch + 32 : rowp;
    bf16_t* pb = odd ? rowp + 32 : rowp + pitch;
    *(u32x4*)pa = A; *(u32x4*)pb = B;
}
template <bool NOSTORE = false> struct EpiInT {
    static constexpr bool PERM = true, AFTER_DRAIN = false, REPME = true; static constexpr int NSTORE = 16;
    bf16_t *QA, *KA, *VA, *GA, *QB, *KB, *VB, *GB;
    const float *qna, *kna, *qnb, *knb, *cosT, *sinT;
    __device__ __forceinline__ void init(f32x4 (&acc)[2][2][4][2], const Unit&, int, int, int, int) const {
#pragma unroll
        for (int a = 0; a < 2; ++a)
#pragma unroll
            for (int b = 0; b < 2; ++b)
#pragma unroll
                for (int m = 0; m < 4; ++m)
#pragma unroll
                    for (int n = 0; n < 2; ++n) acc[a][b][m][n] = (f32x4){0.f, 0.f, 0.f, 0.f};
    }
    __device__ __forceinline__ void operator()(const f32x4 (&acc)[2][2][4][2], const Unit& u, int wr, int wc, int fr, int fq) const {
        const int g = u.pn * 4 + wc;
        int type, head, H = 8; const float* ng = qna; bf16_t* dst; float scale = 1.f;
        if (g < 8) { type = 0; head = g; ng = qna; dst = QA; scale = C2_; }
        else if (g < 10) { type = 0; head = g - 8; ng = kna; dst = KA; H = 2; }
        else if (g < 12) { type = 1; head = g - 10; dst = VA; H = 2; }
        else if (g < 20) { type = 2; head = g - 12; dst = GA; }
        else if (g < 28) { type = 0; head = g - 20; ng = qnb; dst = QB; scale = C2_; }
        else if (g < 36) { type = 0; head = g - 28; ng = knb; dst = KB; }
        else if (g < 44) { type = 1; head = g - 36; dst = VB; }
        else { type = 2; head = g - 44; dst = GB; }
        const int row0 = u.pm * BM + wr * 64 + fr;
        if (type == 0) {
            f32x4 gv[2][2], c16[2], s16[2], cb[2][2], sb[2][2];
            const int tb = (row0 & (SEQ_ - 1));
#pragma unroll
            for (int n = 0; n < 2; ++n) {
                c16[n] = *(const f32x4*)(cosT + 16 * 32 + 8 * fq + 4 * n); s16[n] = *(const f32x4*)(sinT + 16 * 32 + 8 * fq + 4 * n);
#pragma unroll
                for (int ai = 0; ai < 2; ++ai) { cb[ai][n] = *(const f32x4*)(cosT + (tb + ai * HALF) * 32 + 8 * fq + 4 * n); sb[ai][n] = *(const f32x4*)(sinT + (tb + ai * HALF) * 32 + 8 * fq + 4 * n); }
#pragma unroll
                for (int bj = 0; bj < 2; ++bj) gv[bj][n] = *(const f32x4*)(ng + 32 * bj + 8 * fq + 4 * n);
            }
#pragma unroll
            for (int ai = 0; ai < 2; ++ai) {
                f32x4 cs[2] = {cb[ai][0], cb[ai][1]}, sn[2] = {sb[ai][0], sb[ai][1]};
#pragma unroll
                for (int m = 0; m < 4; ++m) {
                    const int row = row0 + ai * HALF + m * 16, b = row >> 12, t = row & (SEQ_ - 1);
                    float ss = 0.f;
#pragma unroll
                    for (int bj = 0; bj < 2; ++bj)
#pragma unroll
                        for (int n = 0; n < 2; ++n) { const f32x4 x = acc[ai][bj][m][n]; ss += (x[0] * x[0] + x[1] * x[1]) + (x[2] * x[2] + x[3] * x[3]); }
                    ss += __shfl_xor(ss, 16); ss += __shfl_xor(ss, 32);
                    const float rs = rsqrtf(ss * (1.f / 64.f) + 1e-6f) * scale;
                    f32x4 o1[2], o2[2];
#pragma unroll
                    for (int n = 0; n < 2; ++n) {
                        const f32x4 n1 = acc[ai][0][m][n] * rs * gv[0][n], n2 = acc[ai][1][m][n] * rs * gv[1][n];
                        o1[n] = n1 * cs[n] - n2 * sn[n]; o2[n] = n2 * cs[n] + n1 * sn[n];
                        const f32x4 cn = cs[n] * c16[n] - sn[n] * s16[n], sn2 = sn[n] * c16[n] + cs[n] * s16[n];
                        cs[n] = cn; sn[n] = sn2;
                    }
                    bf16_t* p = dst + ((size_t)(b * H + head) * SEQ_ + t) * 64 + 8 * fq;
                    { const u32x4 w0_ = pack8(o1[0], o1[1]), w1_ = pack8(o2[0], o2[1]); if (NOSTORE) { asm volatile("" :: "v"(w0_), "v"(w1_)); } else { *(u32x4*)p = w0_; *(u32x4*)(p + 32) = w1_; } }
                }
            }
        } else if (type == 1) {
#pragma unroll
            for (int ai = 0; ai < 2; ++ai)
#pragma unroll
                for (int m = 0; m < 4; ++m) {
                    const int row = row0 + ai * HALF + m * 16, b = row >> 12, t = row & (SEQ_ - 1);
                    bf16_t* p = dst + ((size_t)(b * H + head) * SEQ_ + t) * 64 + 8 * fq;
                    { const u32x4 w0_ = pack8(acc[ai][0][m][0], acc[ai][0][m][1]), w1_ = pack8(acc[ai][1][m][0], acc[ai][1][m][1]); if (NOSTORE) { asm volatile("" :: "v"(w0_), "v"(w1_)); } else { *(u32x4*)p = w0_; *(u32x4*)(p + 32) = w1_; } }
                }
        } else {
#pragma unroll
            for (int ai = 0; ai < 2; ++ai)
#pragma unroll
                for (int m = 0; m < 4; ++m) {
                    const int row = row0 + ai * HALF + m * 16;
                    bf16_t* p = dst + (size_t)row * 512 + head * 64 + 8 * fq;
                    u32x4 wq[2];
#pragma unroll
                    for (int bj = 0; bj < 2; ++bj) {
                        f32x4 s[2];
#pragma unroll
                        for (int n = 0; n < 2; ++n) { const f32x4 v = acc[ai][bj][m][n];
#pragma unroll
                            for (int e = 0; e < 4; ++e) s[n][e] = v[e]; }
                        wq[bj] = pack8(s[0], s[1]);
                    }
                    { const u32x4 w0_ = wq[0], w1_ = wq[1]; if (NOSTORE) { asm volatile("" :: "v"(w0_), "v"(w1_)); } else { *(u32x4*)p = w0_; *(u32x4*)(p + 32) = w1_; } }
                }
        }
    }
};
typedef EpiInT<false> EpiIn;
struct EpiRes {
    static constexpr bool PERM = true, AFTER_DRAIN = false, REPME = false; static constexpr int NSTORE = 32;
    const float* x; float* out;
    __device__ __forceinline__ void init(f32x4 (&acc)[2][2][4][2], const Unit&, int, int, int, int) const {
#pragma unroll
        for (int a = 0; a < 2; ++a)
#pragma unroll
            for (int b = 0; b < 2; ++b)
#pragma unroll
                for (int m = 0; m < 4; ++m)
#pragma unroll
                    for (int n = 0; n < 2; ++n) acc[a][b][m][n] = (f32x4){0.f, 0.f, 0.f, 0.f};
    }
    __device__ __forceinline__ void operator()(const f32x4 (&acc)[2][2][4][2], const Unit& u, int wr, int wc, int fr, int fq) const {
        const int row0 = u.pm * BM + wr * 64 + fr, col0 = u.pn * BM + wc * 32 + 8 * fq;
#pragma unroll
        for (int ai = 0; ai < 2; ++ai) {
            f32x4 xr[4][2][2];
#pragma unroll
            for (int m = 0; m < 4; ++m) {
                const size_t off = (size_t)(row0 + ai * HALF + m * 16) * 1024 + col0;
#pragma unroll
                for (int bj = 0; bj < 2; ++bj) { xr[m][bj][0] = *(const f32x4*)(x + off + bj * HALF); xr[m][bj][1] = *(const f32x4*)(x + off + bj * HALF + 4); }
            }
            asm volatile("" ::: "memory");
#pragma unroll
            for (int m = 0; m < 4; ++m) {
                const size_t off = (size_t)(row0 + ai * HALF + m * 16) * 1024 + col0;
#pragma unroll
                for (int bj = 0; bj < 2; ++bj) { *(f32x4*)(out + off + bj * HALF) = xr[m][bj][0] + acc[ai][bj][m][0]; *(f32x4*)(out + off + bj * HALF + 4) = xr[m][bj][1] + acc[ai][bj][m][1]; }
            }
            asm volatile("" ::: "memory");
        }
    }
};
struct EpiNone {
    static constexpr bool PERM = true, AFTER_DRAIN = false, REPME = false; static constexpr int NSTORE = 0;
    __device__ __forceinline__ void init(f32x4 (&acc)[2][2][4][2], const Unit&, int, int, int, int) const {
#pragma unroll
        for (int a = 0; a < 2; ++a)
#pragma unroll
            for (int b = 0; b < 2; ++b)
#pragma unroll
                for (int m = 0; m < 4; ++m)
#pragma unroll
                    for (int n = 0; n < 2; ++n) acc[a][b][m][n] = (f32x4){0.f, 0.f, 0.f, 0.f};
    }
    __device__ __forceinline__ void operator()(const f32x4 (&acc)[2][2][4][2], const Unit&, int, int, int, int) const {
#pragma unroll
        for (int a = 0; a < 2; ++a)
#pragma unroll
            for (int b = 0; b < 2; ++b)
#pragma unroll
                for (int m = 0; m < 4; ++m)
#pragma unroll
                    for (int n = 0; n < 2; ++n) asm volatile("" :: "v"(acc[a][b][m][n]));
    }
};
struct SameTileOrder : StaticOrder {
    __host__ __device__ bool next(int i, Unit& u) const { if (!StaticOrder::next(i, u)) return false; u.pm = 0; u.pn = 0; return true; }
};
template <class Epi, class Sched, bool ALIGN_EPI = false, bool SP2 = false>
__device__ __forceinline__ void gemm_phase(PG8_LAS unsigned char* lds, const Gemm g, const Sched& S, const Epi& E) {
    int tid_ = threadIdx.x; asm volatile("" : "+v"(tid_));
    const int tid = tid_, wid = __builtin_amdgcn_readfirstlane(tid >> 6), lane = tid & 63, wr = wid >> 2, wc = wid & 3, fr = lane & 15, fq = lane >> 4;
    const int K = g.K, nt = K / BK;
    unsigned voffA[2], voffB[2];
#pragma unroll
    for (int i = 0; i < 2; ++i) { int R, C; stage_rc(tid * 16 + i * 8192, R, C); const int Rb = Epi::PERM ? ((R & ~31) + perm32(R & 31)) : R;
        voffA[i] = (unsigned)(R * K + C) * 2u; voffB[i] = (unsigned)(Rb * K + C) * 2u; }
    const size_t kstep = (size_t)(BK * 2);
    const size_t hstep = (size_t)HALF * K * 2;
    const size_t tstep = 2 * hstep;
    const unsigned ldsw = (unsigned)wid * 1024u;
    const int aoff = lds_byte(wr * 64 + fr, fq * 8), boff = lds_byte(wc * 32 + fr, fq * 8);
#define PG8_SA(b, h) (((b) * 2 + (h)) * HTB)
#define PG8_SB(b, h) ((4 + (b) * 2 + (h)) * HTB)
#define PG8_STAGE(bufoff, gbase, voff) do { _Pragma("unroll") for (int _i = 0; _i < 2; ++_i) \
        __builtin_amdgcn_global_load_lds((const unsigned*)((const char*)(gbase) + (voff)[_i]), (PG8_LAS unsigned*)(lds + (bufoff) + ldsw + _i * 8192), 16, 0, 0); } while (0)
#define PG8_LDA(dst, b, h) do { _Pragma("unroll") for (int m = 0; m < 4; ++m) _Pragma("unroll") for (int k = 0; k < 2; ++k) dst[m][k] = *(const PG8_LAS bf16x8*)(lds + PG8_SA(b, h) + aoff + m * 2048 + k * 1024); } while (0)
#define PG8_LDB(dst, b, h) do { _Pragma("unroll") for (int n = 0; n < 2; ++n) _Pragma("unroll") for (int k = 0; k < 2; ++k) dst[n][k] = *(const PG8_LAS bf16x8*)(lds + PG8_SB(b, h) + boff + n * 2048 + k * 1024); } while (0)
#define PG8_MMA(ai, bj, At, Bt) do { __builtin_amdgcn_s_setprio(1); _Pragma("unroll") for (int m = 0; m < 4; ++m) _Pragma("unroll") for (int n = 0; n < 2; ++n) _Pragma("unroll") for (int k = 0; k < 2; ++k) \
        acc[ai][bj][m][n] = __builtin_amdgcn_mfma_f32_16x16x32_bf16(Bt[n][k], At[m][k], acc[ai][bj][m][n], 0, 0, 0); __builtin_amdgcn_s_setprio(0); } while (0)
#define PG8_WAIT_V(n) asm volatile("s_waitcnt vmcnt(" #n ")" ::: "memory")
#define PG8_WAIT_V8S() do { if (Epi::NSTORE == 16) PG8_WAIT_V(24); else if (Epi::NSTORE == 32) PG8_WAIT_V(40); else PG8_WAIT_V(8); } while (0)
#define PG8_WAIT_L(n) asm volatile("s_waitcnt lgkmcnt(" #n ")" ::: "memory")
#define PG8_BAR __builtin_amdgcn_s_barrier()
#define PG8_SCHED __builtin_amdgcn_sched_barrier(0)
    Unit cur, nxt; int ui = 0;
    if (!S.next(0, cur)) return;
    f32x4 acc[2][2][4][2];
    E.init(acc, cur, wr, wc, fr, fq);
    bf16x8 At[4][2], B0[2][2], B1[2][2];
    const char* cA = (const char*)g.A + (size_t)cur.pm * tstep; const char* cB = (const char*)g.Bt + (size_t)cur.pn * tstep;
    S.a_ready(cur);
    if constexpr (SP2) {
        PG8_STAGE(PG8_SB(0, 0), cB, voffB); PG8_STAGE(PG8_SB(0, 1), cB + hstep, voffB); PG8_STAGE(PG8_SA(0, 0), cA, voffA); PG8_STAGE(PG8_SA(0, 1), cA + hstep, voffA);
        if (wr == 1) PG8_BAR;
        PG8_WAIT_V(2); PG8_BAR;
        PG8_STAGE(PG8_SB(1, 0), cB + kstep, voffB); PG8_STAGE(PG8_SA(1, 0), cA + kstep, voffA); PG8_STAGE(PG8_SB(1, 1), cB + hstep + kstep, voffB);
        PG8_WAIT_V(6); PG8_BAR;
    } else {
        PG8_STAGE(PG8_SB(0, 0), cB, voffB); PG8_STAGE(PG8_SA(0, 0), cA, voffA); PG8_STAGE(PG8_SB(0, 1), cB + hstep, voffB); PG8_STAGE(PG8_SA(0, 1), cA + hstep, voffA);
        if (wr == 1) PG8_BAR;
        PG8_WAIT_V(4); PG8_BAR;
        PG8_STAGE(PG8_SB(1, 0), cB + kstep, voffB); PG8_STAGE(PG8_SA(1, 0), cA + kstep, voffA); PG8_STAGE(PG8_SB(1, 1), cB + hstep + kstep, voffB);
        PG8_WAIT_V(6); PG8_BAR;
    }
    for (;;) {
        const bool has_next = S.next(ui + 1, nxt);
        const char* nA = has_next ? (const char*)g.A + (size_t)nxt.pm * tstep : cA; const char* nB = has_next ? (const char*)g.Bt + (size_t)nxt.pn * tstep : cB;
        for (int t = 0; t < nt; t += 2) {
            const bool last = (t == nt - 2);
            const char* a1 = cA + (size_t)(t + 1) * kstep;
            const char* a2 = last ? nA : cA + (size_t)(t + 2) * kstep; const char* b2 = last ? nB : cB + (size_t)(t + 2) * kstep;
            const char* a3 = a2 + kstep; const char* b3 = b2 + kstep;
            if (last && has_next) S.a_ready(nxt);
            if constexpr (SP2) {
            PG8_LDB(B0, 0, 0); PG8_LDB(B1, 0, 1); PG8_SCHED; PG8_LDA(At, 0, 0); PG8_STAGE(PG8_SA(1, 1), a1 + hstep, voffA);
            PG8_WAIT_V(8); PG8_WAIT_L(0); PG8_BAR; PG8_MMA(0, 0, At, B0); PG8_MMA(0, 1, At, B1); PG8_BAR; PG8_SCHED;
            PG8_LDA(At, 0, 1); PG8_STAGE(PG8_SB(0, 0), b2, voffB); PG8_STAGE(PG8_SB(0, 1), b2 + hstep, voffB); PG8_STAGE(PG8_SA(0, 0), a2, voffA);
            PG8_WAIT_V(8); PG8_WAIT_L(0); PG8_BAR; PG8_MMA(1, 0, At, B0); PG8_MMA(1, 1, At, B1); PG8_BAR; PG8_SCHED;
            PG8_LDB(B0, 1, 0); PG8_LDB(B1, 1, 1); PG8_SCHED; PG8_LDA(At, 1, 0); PG8_STAGE(PG8_SA(0, 1), a2 + hstep, voffA);
            PG8_WAIT_V(8); PG8_WAIT_L(0); PG8_BAR; PG8_MMA(0, 0, At, B0); PG8_MMA(0, 1, At, B1); PG8_BAR; PG8_SCHED;
            PG8_LDA(At, 1, 1); PG8_STAGE(PG8_SB(1, 0), b3, voffB); PG8_STAGE(PG8_SB(1, 1), b3 + hstep, voffB); PG8_STAGE(PG8_SA(1, 0), a3, voffA);
            PG8_WAIT_V(8); PG8_WAIT_L(0); PG8_BAR; PG8_MMA(1, 0, At, B0); PG8_MMA(1, 1, At, B1); PG8_BAR; PG8_SCHED;
            } else {
            PG8_LDB(B0, 0, 0); PG8_SCHED; PG8_LDA(At, 0, 0); PG8_STAGE(PG8_SA(1, 1), a1 + hstep, voffA);
            PG8_WAIT_L(8); PG8_BAR; PG8_WAIT_L(0); PG8_MMA(0, 0, At, B0); PG8_BAR; PG8_SCHED;
            PG8_LDB(B1, 0, 1); PG8_STAGE(PG8_SB(0, 0), b2, voffB);
            PG8_BAR; PG8_WAIT_L(0); PG8_MMA(0, 1, At, B1); PG8_BAR;
            PG8_LDA(At, 0, 1); PG8_STAGE(PG8_SA(0, 0), a2, voffA);
            PG8_BAR; PG8_WAIT_L(0); PG8_MMA(1, 0, At, B0); PG8_BAR; PG8_SCHED;
            PG8_STAGE(PG8_SB(0, 1), b2 + hstep, voffB);
            PG8_WAIT_V(6); PG8_BAR; PG8_MMA(1, 1, At, B1); PG8_BAR;
            PG8_LDB(B0, 1, 0); PG8_SCHED; PG8_LDA(At, 1, 0); PG8_STAGE(PG8_SA(0, 1), a2 + hstep, voffA);
            PG8_WAIT_L(8); PG8_BAR; PG8_WAIT_L(0); PG8_MMA(0, 0, At, B0); PG8_BAR; PG8_SCHED;
            PG8_LDB(B1, 1, 1); PG8_STAGE(PG8_SB(1, 0), b3, voffB);
            PG8_BAR; PG8_WAIT_L(0); PG8_MMA(0, 1, At, B1); PG8_BAR;
            PG8_LDA(At, 1, 1); PG8_STAGE(PG8_SA(1, 0), a3, voffA);
            PG8_BAR; PG8_WAIT_L(0); PG8_MMA(1, 0, At, B0); PG8_BAR; PG8_SCHED;
            PG8_STAGE(PG8_SB(1, 1), b3 + hstep, voffB);
            PG8_WAIT_V(6); PG8_BAR; PG8_MMA(1, 1, At, B1); PG8_BAR;
            }
        }
        if constexpr (ALIGN_EPI) { if (wr == 0) PG8_BAR; }
        if constexpr (!Epi::AFTER_DRAIN) { E(acc, cur, wr, wc, fr, fq); S.done(cur); }
        if (!has_next) break;
        E.init(acc, nxt, wr, wc, fr, fq);
        cur = nxt; cA = nA; cB = nB; ++ui;
        if constexpr (ALIGN_EPI) { if (wr == 1) PG8_BAR; }
    }
    PG8_WAIT_V(0);
    if constexpr (!ALIGN_EPI) { if (wr == 0) PG8_BAR; }
    PG8_BAR;
    if constexpr (Epi::AFTER_DRAIN) { E.fused(acc, cur, wr, wc, fr, fq, lds, wid, lane); S.done(cur); }
#undef PG8_SA
#undef PG8_SB
#undef PG8_STAGE
#undef PG8_LDA
#undef PG8_LDB
#undef PG8_MMA
#undef PG8_WAIT_V
#undef PG8_WAIT_V8S
#undef PG8_WAIT_L
#undef PG8_BAR
#undef PG8_SCHED
}
}
namespace att {
#ifndef KSWZ
#define KSWZ 0
#endif
typedef short bf16x8 __attribute__((ext_vector_type(8)));
typedef short s16x4 __attribute__((ext_vector_type(4)));
typedef short v4i16_t __attribute__((ext_vector_type(4)));
typedef float f32x16 __attribute__((ext_vector_type(16)));
typedef float f32x4 __attribute__((ext_vector_type(4)));
typedef unsigned u32x4 __attribute__((ext_vector_type(4)));
typedef float f32x2_t __attribute__((ext_vector_type(2))); typedef __bf16 bf16x2_t __attribute__((ext_vector_type(2)));
typedef __attribute__((address_space(3))) unsigned char* lds_ptr;
__device__ __forceinline__ unsigned cvtpk_s(float lo, float hi) { f32x2_t v = {lo, hi}; bf16x2_t b = __builtin_convertvector(v, bf16x2_t); return __builtin_bit_cast(unsigned, b); }
__device__ __forceinline__ int crow(int r, int hi) { return (r & 3) + 8 * (r >> 2) + 4 * hi; }
__device__ __forceinline__ s16x4 vtr(lds_ptr p) { return __builtin_bit_cast(s16x4, __builtin_amdgcn_ds_read_tr16_b64_v4i16((__attribute__((address_space(3))) v4i16_t*)p)); }
#define ATT_WAITV(n) asm volatile("s_waitcnt vmcnt(" #n ")" ::: "memory")
__device__ __forceinline__ void glds16(const void* gsrc, unsigned lds_dst) { unsigned keep;
    asm volatile("s_mov_b32 %0, m0\n\ts_mov_b32 m0, %2\n\ts_nop 0\n\tglobal_load_lds_dwordx4 %1, off\n\ts_mov_b32 m0, %0" : "=&s"(keep) : "v"(gsrc), "s"(lds_dst) : "memory"); }
#define ATT_GLDS(src, dst) glds16((src), (unsigned)__builtin_amdgcn_readfirstlane((int)(dst)))

struct Desc {
    const unsigned short *Q0, *Q1, *K, *V;
    int dil, r, qt0, qt1;
    unsigned short* po; float* pl;
    const unsigned short *po_a, *po_b; const float *pl_a, *pl_b;
    const unsigned short *gate0, *gate1; unsigned short *mix0, *mix1;
    float sink0, sink1;
};
struct LaneK { unsigned koff[4], voff[4]; };
__device__ __forceinline__ LaneK lane_offsets(int dil, int lane) {
    LaneK L;
#pragma unroll
    for (int i = 0; i < 4; ++i) {
        const int row = 8 * i + (lane >> 3), chunk = (lane & 7) ^ (KSWZ ? ((row >> 1) & 7) : 0);
        L.koff[i] = (unsigned)(dil * row) * 128u + (unsigned)chunk * 16u;
        const int vchunk = (lane & 7) ^ (4 * ((row >> 1) & 1));
        L.voff[i] = (unsigned)(dil * row) * 128u + (unsigned)vchunk * 16u;
    }
    return L;
}
#define ATT_DMA_K(D, L, ktlo, j, sl) do { const char* s_ = (const char*)(D).K + (size_t)(D).r * 128 + (size_t)((ktlo) + (j)) * ((size_t)(D).dil * 4096); const unsigned d_ = ring0 + ((sl) & 1) * 8192; \
        ATT_GLDS(s_ + (L).koff[0], d_); ATT_GLDS(s_ + (L).koff[1], d_ + 1024); ATT_GLDS(s_ + (L).koff[2], d_ + 2048); ATT_GLDS(s_ + (L).koff[3], d_ + 3072); } while (0)
#define ATT_DMA_V(D, L, ktlo, j, sl) do { const char* s_ = (const char*)(D).V + (size_t)(D).r * 128 + (size_t)((ktlo) + (j)) * ((size_t)(D).dil * 4096); const unsigned d_ = ring0 + ((sl) & 1) * 8192 + 4096; \
        ATT_GLDS(s_ + (L).voff[0], d_); ATT_GLDS(s_ + (L).voff[1], d_ + 1024); ATT_GLDS(s_ + (L).voff[2], d_ + 2048); ATT_GLDS(s_ + (L).voff[3], d_ + 3072); } while (0)
template <int DRY = 0>
__device__ __forceinline__ void prefetch(const Desc& D, unsigned ring0, bf16x8 (&qr)[2][4], int lane, int par = 0) {
    const int q = lane & 31, hi = lane >> 5;
    const int ktlo = D.qt0 >= 4 ? D.qt0 - 4 : 0, nt = D.qt1 - ktlo + 1;
    const LaneK L = lane_offsets(D.dil, lane);
    { const unsigned short* q0 = D.Q0 + (size_t)(D.r + D.dil * (32 * D.qt0 + q)) * 64 + hi * 8; const unsigned short* q1 = D.Q1 + (size_t)(D.r + D.dil * (32 * D.qt1 + q)) * 64 + hi * 8;
#pragma unroll
      for (int d0 = 0; d0 < 4; ++d0) { qr[0][d0] = *(const bf16x8*)(q0 + d0 * 16); qr[1][d0] = *(const bf16x8*)(q1 + d0 * 16); } }
    asm volatile("s_waitcnt lgkmcnt(0)" ::: "memory");
    if (DRY != 2) { ATT_DMA_K(D, L, ktlo, 0, par); ATT_DMA_V(D, L, ktlo, 0, par);
    if (nt > 1) { ATT_DMA_K(D, L, ktlo, 1, par + 1); ATT_DMA_V(D, L, ktlo, 1, par + 1); }
    if (DRY == 3) { if (nt > 2) { ATT_DMA_K(D, L, ktlo, 2, par); ATT_DMA_V(D, L, ktlo, 2, par); } if (nt > 3) { ATT_DMA_K(D, L, ktlo, 3, par + 1); ATT_DMA_V(D, L, ktlo, 3, par + 1); } } }
}
template <int MODE, int DRY = 0>
__device__ __forceinline__ void attn_item(lds_ptr ring, lds_ptr stage, const Desc& D, bool has_next, const Desc& N, bf16x8 (&qx)[2][4], int& par, int lane) {
    const int q = lane & 31, hi = lane >> 5;
    const int ktlo = D.qt0 >= 4 ? D.qt0 - 4 : 0, nt = D.qt1 - ktlo + 1;
    constexpr int DMIN = (MODE == 0) ? 1 : 0;
    const unsigned ring0 = (unsigned)(uintptr_t)ring;
    const LaneK L = lane_offsets(D.dil, lane);
    const int krow = q * 128, ksw = KSWZ ? ((q >> 1) & 7) : 0;
    const int vsw = ((lane & 15) >> 3) & 1;
    const int vb = ((lane >> 4) & 1) * 32 + (lane & 3) * 8 + (4 * hi + ((lane & 15) >> 2)) * 128;
    f32x16 o00 = {}, o01 = {}, o10 = {}, o11 = {}; float ls0 = 0.f, ls1 = 0.f;
    asm volatile("s_waitcnt vmcnt(0)" ::: "memory");
    bf16x8 qr[2][4];
#pragma unroll
    for (int s_ = 0; s_ < 2; ++s_)
#pragma unroll
        for (int d0 = 0; d0 < 4; ++d0) qr[s_][d0] = qx[s_][d0];
    asm volatile("" : "+v"(qr[0][0]), "+v"(qr[0][1]), "+v"(qr[0][2]), "+v"(qr[0][3]), "+v"(qr[1][0]), "+v"(qr[1][1]), "+v"(qr[1][2]), "+v"(qr[1][3]));
    const int Nktlo = N.qt0 >= 4 ? N.qt0 - 4 : 0, Nnt = N.qt1 - Nktlo + 1;
    const bool ext = (DRY == 0) && has_next && nt >= 2 && N.dil == D.dil;
    const int nx = ext ? (Nnt < 2 ? Nnt : 2) : 0;
    for (int j = 0; j < nt; ++j) {
        const int e = nt - 1 - j + nx, kt = ktlo + j; lds_ptr slot = ring + ((j + par) & 1) * 8192;
        const bool act0 = (kt <= D.qt0), act1 = (kt >= D.qt1 - 4);
        if (DRY == 3) { if (e >= 3) ATT_WAITV(28); else if (e == 2) ATT_WAITV(20); else if (e == 1) ATT_WAITV(12); else ATT_WAITV(4); }
        else if (DRY != 2) { if (e >= 1) ATT_WAITV(12); else ATT_WAITV(4); }
        bf16x8 kf[4];
        if (DRY != 1 && DRY != 3) {
#pragma unroll
        for (int ks = 0; ks < 4; ++ks) kf[ks] = *(const __attribute__((address_space(3))) bf16x8*)(slot + krow + (((2 * ks + hi) ^ ksw) * 16));
        asm volatile("s_waitcnt lgkmcnt(0)" ::: "memory");
        asm volatile("" : "+v"(kf[0]), "+v"(kf[1]), "+v"(kf[2]), "+v"(kf[3]));
        }
        if (DRY == 3) { if (e >= 4) ATT_DMA_K(D, L, ktlo, j + 4, j + par); }
        else if (DRY != 2 && e >= 2) { if (j + 2 < nt) ATT_DMA_K(D, L, ktlo, j + 2, j + par); else ATT_DMA_K(N, L, Nktlo, j + 2 - nt, j + par); }
        u32x4 pa0 = {}, pa1 = {}, pb0 = {}, pb1 = {};
#define ATT_SCORE(S, QT, ACT, LS, PW0, PW1) if (ACT) { f32x16 p = {}; \
            _Pragma("unroll") for (int ks = 0; ks < 4; ++ks) p = __builtin_amdgcn_mfma_f32_32x32x16_bf16(kf[ks], qr[S][ks], p, 0, 0, 0); \
            const bool first = (kt == (QT) - 4), last = (kt == (QT)); \
            if (first || last) { _Pragma("unroll") for (int rr = 0; rr < 16; ++rr) { const int kk = crow(rr, hi); const bool bad = (first && kk < q + DMIN) || (last && kk > q); if (bad) p[rr] = -INFINITY; } } \
            float s_ = 0.f; \
            _Pragma("unroll") for (int rr = 0; rr < 16; ++rr) { p[rr] = __builtin_amdgcn_exp2f(p[rr]); s_ += p[rr]; } \
            LS += s_; \
            PW0[0] = cvtpk_s(p[0], p[1]); PW0[1] = cvtpk_s(p[2], p[3]); PW0[2] = cvtpk_s(p[4], p[5]); PW0[3] = cvtpk_s(p[6], p[7]); \
            PW1[0] = cvtpk_s(p[8], p[9]); PW1[1] = cvtpk_s(p[10], p[11]); PW1[2] = cvtpk_s(p[12], p[13]); PW1[3] = cvtpk_s(p[14], p[15]); }
        if (DRY != 1 && DRY != 3) {
        ATT_SCORE(0, D.qt0, act0, ls0, pa0, pa1)
        ATT_SCORE(1, D.qt1, act1, ls1, pb0, pb1)
        }
#undef ATT_SCORE
        if (DRY == 3) { if (e >= 4) ATT_WAITV(28); else if (e == 3) ATT_WAITV(24); else if (e == 2) ATT_WAITV(16); else if (e == 1) ATT_WAITV(8); else ATT_WAITV(0); }
        else if (DRY != 2) { if (e >= 2) ATT_WAITV(12); else if (e == 1) ATT_WAITV(8); else ATT_WAITV(0); }
        if (DRY != 1 && DRY != 3) {
        lds_ptr vp = slot + 4096 + vb;
        s16x4 lo[4], hh[4];
#pragma unroll
        for (int i = 0; i < 4; ++i) { const int o_ = (i & 1) * 2048 + (((i >> 1) ^ vsw) * 64); lo[i] = vtr(vp + o_); hh[i] = vtr(vp + o_ + 1024); }
#define ATT_VFR(i) (bf16x8){lo[i][0], lo[i][1], lo[i][2], lo[i][3], hh[i][0], hh[i][1], hh[i][2], hh[i][3]}
        if (act0) {
            o00 = __builtin_amdgcn_mfma_f32_32x32x16_bf16(__builtin_bit_cast(bf16x8, pa0), ATT_VFR(0), o00, 0, 0, 0);
            o00 = __builtin_amdgcn_mfma_f32_32x32x16_bf16(__builtin_bit_cast(bf16x8, pa1), ATT_VFR(1), o00, 0, 0, 0);
            o01 = __builtin_amdgcn_mfma_f32_32x32x16_bf16(__builtin_bit_cast(bf16x8, pa0), ATT_VFR(2), o01, 0, 0, 0);
            o01 = __builtin_amdgcn_mfma_f32_32x32x16_bf16(__builtin_bit_cast(bf16x8, pa1), ATT_VFR(3), o01, 0, 0, 0);
        }
        if (act1) {
            o10 = __builtin_amdgcn_mfma_f32_32x32x16_bf16(__builtin_bit_cast(bf16x8, pb0), ATT_VFR(0), o10, 0, 0, 0);
            o10 = __builtin_amdgcn_mfma_f32_32x32x16_bf16(__builtin_bit_cast(bf16x8, pb1), ATT_VFR(1), o10, 0, 0, 0);
            o11 = __builtin_amdgcn_mfma_f32_32x32x16_bf16(__builtin_bit_cast(bf16x8, pb0), ATT_VFR(2), o11, 0, 0, 0);
            o11 = __builtin_amdgcn_mfma_f32_32x32x16_bf16(__builtin_bit_cast(bf16x8, pb1), ATT_VFR(3), o11, 0, 0, 0);
        }
#undef ATT_VFR
        }
        asm volatile("s_waitcnt lgkmcnt(0)" ::: "memory");
        if (DRY == 3) { if (e >= 4) ATT_DMA_V(D, L, ktlo, j + 4, j + par); }
        else if (DRY != 2 && e >= 2) { if (j + 2 < nt) ATT_DMA_V(D, L, ktlo, j + 2, j + par); else ATT_DMA_V(N, L, Nktlo, j + 2 - nt, j + par); }
    }
    int lane_s = lane; asm volatile("" : "+v"(lane_s));
    {
    const int lane = lane_s, q = lane & 31, hi = lane >> 5;
    __attribute__((address_space(3))) unsigned short* st = (__attribute__((address_space(3))) unsigned short*)stage;
    u32x4 g0[4], a0[4], b0[4]; float la0[4], lb0[4];
#define ATT_EPI_T(QT, pp) ((size_t)(D.r + D.dil * (32 * (QT) + 16 * ((pp) >> 1) + 8 * ((pp) & 1) + (lane >> 3))))
#define ATT_EPI_LOAD(QT, G, A, B, LA, LB, GATE) do { _Pragma("unroll") for (int pp = 0; pp < 4; ++pp) { const size_t t = ATT_EPI_T(QT, pp); const int ch = lane & 7; \
        G[pp] = *(const u32x4*)((GATE) + t * 512 + ch * 8); \
        if (MODE == 2) { A[pp] = __builtin_nontemporal_load((const u32x4*)(D.po_a + t * 64 + ch * 8)); B[pp] = __builtin_nontemporal_load((const u32x4*)(D.po_b + t * 64 + ch * 8)); \
                         LA[pp] = __builtin_nontemporal_load(D.pl_a + t); LB[pp] = __builtin_nontemporal_load(D.pl_b + t); } } } while (0)
#define ATT_EPI_TOUCH(G, A, B, LA, LB) do { asm volatile("" : "+v"(G[0]), "+v"(G[1]), "+v"(G[2]), "+v"(G[3])); \
        if (MODE == 2) { asm volatile("" : "+v"(A[0]), "+v"(A[1]), "+v"(A[2]), "+v"(A[3]), "+v"(B[0]), "+v"(B[1]), "+v"(B[2]), "+v"(B[3])); \
                         asm volatile("" : "+v"(LA[0]), "+v"(LA[1]), "+v"(LA[2]), "+v"(LA[3]), "+v"(LB[0]), "+v"(LB[1]), "+v"(LB[2]), "+v"(LB[3])); } } while (0)
#define ATT_EPI_PROC(QT, OA, OB, LS, G, A, B, LA, LB, MIX, SINK) do { \
        { auto sw_ = __builtin_amdgcn_permlane32_swap(__float_as_uint(LS), __float_as_uint(LS), false, false); LS = __uint_as_float(sw_[0]) + __uint_as_float(sw_[1]); } \
        _Pragma("unroll") for (int hf = 0; hf < 2; ++hf) { \
            _Pragma("unroll") for (int i8 = 0; i8 < 8; ++i8) { const int rl = crow(i8, hi); \
                st[rl * 64 + q] = (unsigned short)(cvtpk_s(OA[8 * hf + i8], 0.f) & 0xffffu); st[rl * 64 + 32 + q] = (unsigned short)(cvtpk_s(OB[8 * hf + i8], 0.f) & 0xffffu); } \
            _Pragma("unroll") for (int i2 = 0; i2 < 2; ++i2) { \
                const int pp = 2 * hf + i2, rl = 8 * i2 + (lane >> 3), ch = lane & 7, row = 16 * hf + rl; \
                const u32x4 ow = *(const __attribute__((address_space(3))) u32x4*)(st + rl * 64 + ch * 8); \
                float l = __shfl(LS, row); \
                const size_t t = ATT_EPI_T(QT, pp); \
                if (MODE == 1) { *(u32x4*)(D.po + t * 64 + ch * 8) = ow; if (ch == 0) D.pl[t] = l; } \
                else { \
                    float v[8]; \
                    _Pragma("unroll") for (int k = 0; k < 4; ++k) { v[2 * k] = __uint_as_float(ow[k] << 16); v[2 * k + 1] = __uint_as_float(ow[k] & 0xffff0000u); } \
                    if (MODE == 2) { \
                        l += LA[pp] + LB[pp]; \
                        _Pragma("unroll") for (int k = 0; k < 4; ++k) { v[2 * k] += __uint_as_float(A[pp][k] << 16) + __uint_as_float(B[pp][k] << 16); v[2 * k + 1] += __uint_as_float(A[pp][k] & 0xffff0000u) + __uint_as_float(B[pp][k] & 0xffff0000u); } \
                    } else l += (SINK); \
                    const float rl_ = 1.0f / l; \
                    u32x4 w; \
                    _Pragma("unroll") for (int k = 0; k < 4; ++k) { const float ga_ = __uint_as_float(G[pp][k] << 16), gb_ = __uint_as_float(G[pp][k] & 0xffff0000u); \
                        const float sa_ = ga_ * __builtin_amdgcn_rcpf(1.f + __builtin_amdgcn_exp2f(-1.4426950408889634f * ga_)), sb_ = gb_ * __builtin_amdgcn_rcpf(1.f + __builtin_amdgcn_exp2f(-1.4426950408889634f * gb_)); \
                        w[k] = cvtpk_s(v[2 * k] * rl_ * sa_, v[2 * k + 1] * rl_ * sb_); } \
                    *(u32x4*)((MIX) + t * 1024 + ch * 8) = w; \
                } \
            } \
        } } while (0)
    if (DRY != 0) {
        asm volatile("" :: "v"(o00), "v"(o01), "v"(o10), "v"(o11), "v"(ls0), "v"(ls1));
        if (has_next) prefetch<DRY>(N, ring0, qx, lane, 0);
    } else if (MODE == 1) {
        if (has_next) { if (!ext) prefetch(N, ring0, qx, lane, 0); else { const unsigned short* q0_ = N.Q0 + (size_t)(N.r + N.dil * (32 * N.qt0 + q)) * 64 + hi * 8; const unsigned short* q1_ = N.Q1 + (size_t)(N.r + N.dil * (32 * N.qt1 + q)) * 64 + hi * 8;
            _Pragma("unroll") for (int d0 = 0; d0 < 4; ++d0) { qx[0][d0] = *(const bf16x8*)(q0_ + d0 * 16); qx[1][d0] = *(const bf16x8*)(q1_ + d0 * 16); } } }
        ATT_EPI_PROC(D.qt0, o00, o01, ls0, g0, a0, b0, la0, lb0, D.mix0, D.sink0);
        ATT_EPI_PROC(D.qt1, o10, o11, ls1, g0, a0, b0, la0, lb0, D.mix1, D.sink1);
    } else {
        ATT_EPI_LOAD(D.qt0, g0, a0, b0, la0, lb0, D.gate0);
        __builtin_amdgcn_sched_barrier(0);
        ATT_EPI_TOUCH(g0, a0, b0, la0, lb0);
        __builtin_amdgcn_sched_barrier(0);
        ATT_EPI_PROC(D.qt0, o00, o01, ls0, g0, a0, b0, la0, lb0, D.mix0, D.sink0);
        __builtin_amdgcn_sched_barrier(0);
        ATT_EPI_LOAD(D.qt1, g0, a0, b0, la0, lb0, D.gate1);
        __builtin_amdgcn_sched_barrier(0);
        if (has_next) { if (!ext) prefetch(N, ring0, qx, lane, 0); else { const unsigned short* q0_ = N.Q0 + (size_t)(N.r + N.dil * (32 * N.qt0 + q)) * 64 + hi * 8; const unsigned short* q1_ = N.Q1 + (size_t)(N.r + N.dil * (32 * N.qt1 + q)) * 64 + hi * 8;
            _Pragma("unroll") for (int d0 = 0; d0 < 4; ++d0) { qx[0][d0] = *(const bf16x8*)(q0_ + d0 * 16); qx[1][d0] = *(const bf16x8*)(q1_ + d0 * 16); } } }
        __builtin_amdgcn_sched_barrier(0);
        ATT_EPI_TOUCH(g0, a0, b0, la0, lb0);
        __builtin_amdgcn_sched_barrier(0);
        ATT_EPI_PROC(D.qt1, o10, o11, ls1, g0, a0, b0, la0, lb0, D.mix1, D.sink1);
    }
#undef ATT_EPI_T
#undef ATT_EPI_LOAD
#undef ATT_EPI_TOUCH
#undef ATT_EPI_PROC
    }
    par = ext ? ((par + nt) & 1) : 0;
}
#undef ATT_DMA_K
#undef ATT_DMA_V
#undef ATT_WAITV
#undef ATT_GLDS
}
#ifndef PG8_SP2
#define PG8_SP2 true
#endif
#ifndef PG8_ALIGN
#define PG8_ALIGN true
#endif
constexpr int NWAVES = 8;
constexpr int BATCH = 8, SEQ = 4096, DM = 1024, M = BATCH * SEQ, NIN = 3328, HD = 64;
constexpr float LOG2E = 1.4426950408889634f;
constexpr size_t MiB = 1u << 20;
constexpr size_t WS_CTL = 0, CTL_ZERO_BYTES = 64 * 1024;
constexpr size_t WS_COS = 1 * MiB, WS_SIN = WS_COS + 512 * 1024;
constexpr size_t WS_WIT = 2 * MiB, WS_WOT = 9 * MiB;
constexpr size_t WS_XN = 16 * MiB;
constexpr size_t WS_QA = 80 * MiB, WS_QB = 112 * MiB, WS_KA = 144 * MiB, WS_VA = 152 * MiB, WS_KB = 160 * MiB, WS_VB = 192 * MiB;
constexpr size_t WS_GA = 224 * MiB, WS_GB = 256 * MiB, WS_MIX = 288 * MiB, WS_PO16 = 352 * MiB, WS_PO4 = 384 * MiB, WS_PL16 = 416 * MiB, WS_PL4 = 417 * MiB, WS_END = 418 * MiB;
constexpr int CW_BAR = 1024;
constexpr int RING_OFF = 0, RING_BYTES = 131072;
constexpr int LDSCTL_OFF = RING_BYTES + 16384, MISC_OFF = LDSCTL_OFF + 320;
constexpr int LDS_BYTES = 149504;
static_assert(MISC_OFF + 128 <= LDS_BYTES, "LDS map");
#define GAS __attribute__((address_space(1)))
#define LAS __attribute__((address_space(3)))
typedef unsigned short bf16;
typedef unsigned v4u __attribute__((ext_vector_type(4)));
typedef float f32x4 __attribute__((ext_vector_type(4)));
typedef short bf16x8 __attribute__((ext_vector_type(8)));
typedef GAS unsigned gu32;
typedef GAS unsigned long long gu64;
#define RLX_AGENT __ATOMIC_RELAXED, __HIP_MEMORY_SCOPE_AGENT
#define LDS_WAIT() asm volatile("s_waitcnt lgkmcnt(0)" ::: "memory")
#define VM_WAIT() asm volatile("s_waitcnt vmcnt(0)" ::: "memory")
__device__ __forceinline__ unsigned long long rt() { return __builtin_amdgcn_s_memrealtime(); }
__device__ __forceinline__ unsigned f2bf(float f) { unsigned u = __builtin_bit_cast(unsigned, f); return (u + 0x7fffu + ((u >> 16) & 1u)) >> 16; }
__device__ __forceinline__ unsigned pk2(float lo, float hi) { return f2bf(lo) | (f2bf(hi) << 16); }

#define XB_TMO      128
#define XB_XCNT(j)  (256  + 64 * (j))
#define XB_XSUB(j)  (1280 + 64 * (j))
#define XB_XGEN(j)  (2304 + 64 * (j))
#define XB_TOP      3328
#define XB_TOPGEN   3392
#define XCD_BAR_WORDS 3456
#define XB_SPIN_CAP (1u << 18)

__device__ __forceinline__ unsigned xb_ld(unsigned* p)              { return __hip_atomic_load(p, __ATOMIC_RELAXED, __HIP_MEMORY_SCOPE_AGENT); }
__device__ __forceinline__ unsigned xb_add(unsigned* p, unsigned v) { return __hip_atomic_fetch_add(p, v, __ATOMIC_RELAXED, __HIP_MEMORY_SCOPE_AGENT); }
__device__ __forceinline__ unsigned xb_xcc_id() { return (unsigned)__builtin_amdgcn_s_getreg((3 << 11) | 20) & 0xFu; }
#define XB_SPIN(cond, bar) do { unsigned _sp = 0; while (cond) { __builtin_amdgcn_s_sleep(1); \
    if ((++_sp & 255u) == 0u) { if (xb_ld(&(bar)[XB_TMO])) break; if (_sp > XB_SPIN_CAP) { atomicAdd(&(bar)[XB_TMO], 1u); break; } } } } while (0)

struct XcdBarrier {
    unsigned* bar; unsigned x;
    volatile LAS unsigned* st;
};

__device__ __forceinline__ XcdBarrier xcd_barrier_post(unsigned* bar, volatile LAS unsigned* st) {
    XcdBarrier b; b.bar = bar; b.x = xb_xcc_id(); b.st = st;
    if (threadIdx.x == 0) (void)xb_add(&bar[XB_XCNT(b.x)], 1u);
    return b;
}
__device__ __forceinline__ void xcd_barrier_complete(unsigned* bar, unsigned x, unsigned& nloc, unsigned& nx) {
    const unsigned G = gridDim.x * gridDim.y * gridDim.z;
    unsigned sum, cnt, mine, sp = 0u;
    for (;;) {
        sum = 0u; cnt = 0u; mine = 0u;
#pragma unroll
        for (unsigned j = 0; j < 16; ++j) { const unsigned c = xb_ld(&bar[XB_XCNT(j)]); sum += c; cnt += (c > 0u) ? 1u : 0u; mine = (j == x) ? c : mine; }
        if (sum == G) break;
        __builtin_amdgcn_s_sleep(1);
        if ((++sp & 255u) == 0u) { if (xb_ld(&bar[XB_TMO])) break; if (sp > XB_SPIN_CAP) { atomicAdd(&bar[XB_TMO], 1u); break; } }
    }
    nloc = mine > 0u ? mine : 1u; nx = cnt > 0u ? cnt : 1u;
}

__device__ __forceinline__ void xcd_barrier(const XcdBarrier& b) {
    asm volatile("s_waitcnt vmcnt(0)" ::: "memory");
    __syncthreads();
    if (threadIdx.x == 0) {
        unsigned* bar = b.bar;
        __builtin_amdgcn_s_waitcnt(0);
        unsigned nloc = b.st[0], nx = b.st[1];
        if (nloc == 0u) { xcd_barrier_complete(bar, b.x, nloc, nx); b.st[0] = nloc; b.st[1] = nx; }
        const unsigned old = xb_add(&bar[XB_XSUB(b.x)], 1u);
        const unsigned gen = old / nloc;
        if (old + 1u == (gen + 1u) * nloc) {
            __builtin_amdgcn_fence(__ATOMIC_RELEASE, "agent");
            asm volatile("s_waitcnt vmcnt(0)" ::: "memory");
            const unsigned og = xb_add(&bar[XB_TOP], 1u);
            const unsigned tg = og / nx;
            if (og + 1u == (tg + 1u) * nx) xb_add(&bar[XB_TOPGEN], 1u);
            else XB_SPIN(xb_ld(&bar[XB_TOPGEN]) == tg, bar);
            __builtin_amdgcn_fence(__ATOMIC_ACQUIRE, "agent");
            xb_add(&bar[XB_XGEN(b.x)], 1u);
            asm volatile("s_waitcnt vmcnt(0)" ::: "memory");
        } else {
            XB_SPIN(xb_ld(&bar[XB_XGEN(b.x)]) == gen, bar);
            __builtin_amdgcn_fence(__ATOMIC_ACQUIRE, "agent");
            asm volatile("s_waitcnt vmcnt(0)" ::: "memory");
        }
    }
    __syncthreads();
}
static_assert((CW_BAR + XCD_BAR_WORDS) * 4 <= (int)CTL_ZERO_BYTES, "barrier words inside the memset region");

struct Frame {
    LAS unsigned char* lds;
    volatile LAS unsigned* MISC;
    gu32* ctl;
    int tid, lane, wave;
    int vcu, G;
};
__device__ __forceinline__ float bf2f(bf16 b) { return __uint_as_float(((unsigned)b) << 16); }
__device__ __forceinline__ float wave_sum(float v) {
#pragma unroll
    for (int o = 1; o < 64; o <<= 1) v += __shfl_xor(v, o);
    return v;
}
__device__ __forceinline__ void sincos_d(float ang, float& s, float& c) {
    const double a = (double)ang;
    const double k = rint(a * 0.6366197723675814);
    double y = fma(-k, 1.5707963267948966, a);
    y = fma(-k, 6.123233995736766e-17, y);
    const double y2 = y * y;
    const double sp = y * (1.0 + y2 * (-1.0 / 6 + y2 * (1.0 / 120 + y2 * (-1.0 / 5040 + y2 * (1.0 / 362880 + y2 * (-1.0 / 39916800 + y2 * (1.0 / 6227020800.0)))))));
    const double cp = 1.0 + y2 * (-0.5 + y2 * (1.0 / 24 + y2 * (-1.0 / 720 + y2 * (1.0 / 40320 + y2 * (-1.0 / 3628800 + y2 * (1.0 / 479001600.0 + y2 * (-1.0 / 87178291200.0)))))));
    const int q = ((int)(long long)k) & 3;
    const double ss = (q == 0) ? sp : (q == 1) ? cp : (q == 2) ? -sp : -cp;
    const double cc = (q == 0) ? cp : (q == 1) ? -sp : (q == 2) ? -cp : sp;
    s = (float)ss; c = (float)cc;
}
__device__ __forceinline__ void p0_transpose_item(const float* W, int K, int N, bf16* WT, int k0, int n0, int d0, LAS float* scr, int lane) {
#pragma unroll 8
    for (int i = 0; i < 32; ++i) { const int kk = 2 * i + (lane >> 5); scr[kk * 33 + (lane & 31)] = W[(size_t)(k0 + kk) * N + n0 + (lane & 31)]; }
    LDS_WAIT(); asm volatile("" ::: "memory");
    const int c = lane & 7;
#pragma unroll
    for (int j = 0; j < 4; ++j) { const int n = (lane >> 3) + 8 * j; const LAS float* s = scr + (8 * c) * 33 + n;
        v4u o; o.x = pk2(s[0 * 33], s[1 * 33]); o.y = pk2(s[2 * 33], s[3 * 33]); o.z = pk2(s[4 * 33], s[5 * 33]); o.w = pk2(s[6 * 33], s[7 * 33]);
        *(GAS v4u*)(WT + (size_t)(d0 + n) * K + k0 + 8 * c) = o; }
    LDS_WAIT(); asm volatile("" ::: "memory");
}
struct Ptrs {
    const float *x, *gain, *w_in, *qna, *kna, *sinks, *qnb, *knb, *w_out; float* out;
    bf16 *WIT, *WOT, *XN, *QA, *KA, *VA, *GA, *QB, *KB, *VB, *GB, *MIX, *PO16, *PO4; float *cosT, *sinT, *PL16, *PL4;
};
__device__ __forceinline__ void p0_prologue(Frame& F, const Ptrs& P) {
    LAS float* scr = (LAS float*)(F.lds + RING_OFF + F.wave * 16384);
    const int gw = F.vcu * NWAVES + F.wave, NGW = F.G * NWAVES;
    constexpr int I_IN = (DM / 64) * (NIN / 32), I_OUT = (DM / 64) * (DM / 32);
    for (int it = gw; it < I_IN + I_OUT; it += NGW) {
        if (it < I_IN) { const int nblk = NIN / 32, kb = it / nblk, nb = it % nblk, n0 = 32 * nb;
            const int pn = n0 >> 8, rem = n0 & 255, wc = rem >> 6, bjj = (rem >> 5) & 1;
            p0_transpose_item(P.w_in, DM, NIN, P.WIT, 64 * kb, n0, 256 * pn + 128 * bjj + 32 * wc, scr, F.lane); }
        else { const int r = it - I_IN, nblk = DM / 32, kb = r / nblk, nb = r % nblk; p0_transpose_item(P.w_out, DM, DM, P.WOT, 64 * kb, 32 * nb, 32 * nb, scr, F.lane); }
    }
    for (int e = (F.vcu * NWAVES * 64) + F.tid; e < SEQ * 32; e += F.G * NWAVES * 64) {
        const int t = e >> 5, i = e & 31;
        double r = 1.0; for (int k = 0; k < i; ++k) r *= 0.7498942093324558;
        const float inv = (float)r; const float ang = (float)t * inv;
        float s, c; sincos_d(ang, s, c); P.cosT[e] = c; P.sinT[e] = s;
    }
    for (int m = gw; m < M; m += NGW) {
        const GAS f32x4* xr = (const GAS f32x4*)(P.x + (size_t)m * DM) + F.lane;
        f32x4 v[4]; float ss = 0.f;
#pragma unroll
        for (int j = 0; j < 4; ++j) { v[j] = __builtin_nontemporal_load(xr + 64 * j); ss += (v[j].x * v[j].x + v[j].y * v[j].y) + (v[j].z * v[j].z + v[j].w * v[j].w); }
        const float rstd = rsqrtf(wave_sum(ss) * (1.f / DM) + 1e-6f);
        GAS unsigned long long* o8 = (GAS unsigned long long*)(P.XN + (size_t)m * DM) + F.lane;
#pragma unroll
        for (int j = 0; j < 4; ++j) { const f32x4 g = ((const GAS f32x4*)P.gain)[64 * j + F.lane];
            o8[64 * j] = (unsigned long long)pk2(v[j].x * rstd * g.x, v[j].y * rstd * g.y) | ((unsigned long long)pk2(v[j].z * rstd * g.z, v[j].w * rstd * g.w) << 32); }
    }
}
constexpr int STAGE_OFF = RING_BYTES;
__device__ __forceinline__ att::Desc b_desc(const Ptrs& P, int uid, int mode, int wave, int k) {
    const int b = uid >> 5, h = (uid >> 2) & 7, blk = uid & 3; const size_t hb = (size_t)(b * 8 + h) * SEQ;
    att::Desc D{};
    D.Q0 = P.QB + hb * 64; D.Q1 = D.Q0; D.K = P.KB + hb * 64; D.V = P.VB + hb * 64;
    if (mode == 1) {
        if (wave < 4) { D.dil = 16; D.r = 4 * wave + k; D.qt0 = 2 * blk; D.po = P.PO16 + hb * 64; D.pl = P.PL16 + hb; }
        else { D.dil = 4; D.r = wave - 4; D.qt0 = 8 * blk + 2 * k; D.po = P.PO4 + hb * 64; D.pl = P.PL4 + hb; }
    } else {
        D.dil = 1; D.r = 0; D.qt0 = 32 * blk + 2 * (2 * wave + k);
        D.po_a = P.PO16 + hb * 64; D.po_b = P.PO4 + hb * 64; D.pl_a = P.PL16 + hb; D.pl_b = P.PL4 + hb;
        D.gate0 = P.GB + (size_t)b * SEQ * 512 + h * 64; D.gate1 = D.gate0; D.mix0 = P.MIX + (size_t)b * SEQ * DM + 512 + h * 64; D.mix1 = D.mix0;
    }
    D.qt1 = D.qt0 + 1;
    return D;
}
__device__ __forceinline__ att::Desc a_desc(const Ptrs& P, int b, int hp, int qt) {
    const int kv = hp >> 1, h0 = 2 * hp;
    att::Desc D{};
    D.Q0 = P.QA + (size_t)(b * 8 + h0) * SEQ * 64; D.Q1 = D.Q0 + (size_t)SEQ * 64;
    D.K = P.KA + (size_t)(b * 2 + kv) * SEQ * 64; D.V = P.VA + (size_t)(b * 2 + kv) * SEQ * 64;
    D.dil = 1; D.r = 0; D.qt0 = qt; D.qt1 = qt;
    D.gate0 = P.GA + (size_t)b * SEQ * 512 + h0 * 64; D.gate1 = D.gate0 + 64; D.mix0 = P.MIX + (size_t)b * SEQ * DM + h0 * 64; D.mix1 = D.mix0 + 64;
    D.sink0 = __builtin_amdgcn_exp2f(P.sinks[h0] * LOG2E); D.sink1 = __builtin_amdgcn_exp2f(P.sinks[h0 + 1] * LOG2E);
    return D;
}
#ifndef REP_2A
#define REP_2A 1
#define REP_2B 1
#define REP_2C 1
#endif
__device__ __forceinline__ void p2_attention(Frame& F, const Ptrs& P, const XcdBarrier& bar) {
    att::lds_ptr ring = (att::lds_ptr)(F.lds + RING_OFF + F.wave * 16384), stage = (att::lds_ptr)(F.lds + STAGE_OFF + F.wave * 2048);
    int lane_ = F.lane; asm volatile("" : "+v"(lane_));
    const int lane = lane_, wave = F.wave, uid = F.vcu;
    const unsigned ring0 = (unsigned)(uintptr_t)ring;
    att::bf16x8 qr[2][4];
    att::Desc D, N; int par = 0;
#ifdef DRY_PASS
    D = b_desc(P, uid, 1, wave, 0);
    att::prefetch<DRY_PASS>(D, ring0, qr, lane);
    for (int k = 0; k < 4; ++k) {
        N = b_desc(P, uid, 1, wave, (k + 1) & 3);
        att::attn_item<1, DRY_PASS>(ring, stage, D, k < 3, N, qr, par, lane); D = N;
    }
    asm volatile("s_waitcnt vmcnt(0) lgkmcnt(0)" ::: "memory");
#endif
#pragma unroll
    for (int rep = 0; rep < REP_2A; ++rep) {
    D = b_desc(P, uid, 1, wave, 0);
    par = 0; att::prefetch(D, ring0, qr, lane, 0);
    for (int k = 0; k < 4; ++k) {
        N = b_desc(P, uid, 1, wave, (k + 1) & 3);
        att::attn_item<1>(ring, stage, D, k < 3, N, qr, par, lane); D = N;
    }
    }
    asm volatile("s_waitcnt vmcnt(0) lgkmcnt(0)\n\ts_barrier" ::: "memory");
#pragma unroll
    for (int rep = 0; rep < REP_2B; ++rep) {
    D = b_desc(P, uid, 2, wave, 0);
    par = 0; att::prefetch(D, ring0, qr, lane, 0);
    for (int k = 0; k < 2; ++k) {
        N = b_desc(P, uid, 2, wave, 1);
        att::attn_item<2>(ring, stage, D, k < 1, N, qr, par, lane); D = N;
    }
    }
#pragma unroll
    for (int rep = 0; rep < REP_2C; ++rep) {
    {
        const int aid0 = uid * 16 + wave * 2;
        D = a_desc(P, aid0 >> 9, (aid0 >> 7) & 3, aid0 & 127);
        par = 0; att::prefetch(D, ring0, qr, lane, 0);
        for (int k = 0; k < 2; ++k) {
            N = a_desc(P, aid0 >> 9, (aid0 >> 7) & 3, (aid0 & 127) + 1);
            att::attn_item<0>(ring, stage, D, k < 1, N, qr, par, lane); D = N;
        }
    }
    }
}

struct Args { const float* in[9]; float* out; unsigned char* ws; };
__global__ void __launch_bounds__(NWAVES * 64, 2) mega_fwd(Args args) {
    extern __shared__ __attribute__((aligned(16))) unsigned char lds[];
    Frame F;
    F.lds = (LAS unsigned char*)lds;
    F.MISC = (volatile LAS unsigned*)(F.lds + MISC_OFF);
    F.tid = threadIdx.x; F.lane = F.tid & 63; F.wave = __builtin_amdgcn_readfirstlane(F.tid >> 6);
    F.G = gridDim.x; { const int bx = blockIdx.x; F.vcu = (F.G % 8 == 0) ? (bx % 8) * (F.G / 8) + bx / 8 : bx; }
    unsigned char* ws = args.ws;
    F.ctl = (gu32*)(ws + WS_CTL);
    Ptrs P;
    P.x = args.in[0]; P.gain = args.in[1]; P.w_in = args.in[2]; P.qna = args.in[3]; P.kna = args.in[4]; P.sinks = args.in[5]; P.qnb = args.in[6]; P.knb = args.in[7]; P.w_out = args.in[8]; P.out = args.out;
    P.WIT = (bf16*)(ws + WS_WIT); P.WOT = (bf16*)(ws + WS_WOT); P.XN = (bf16*)(ws + WS_XN);
    P.QA = (bf16*)(ws + WS_QA); P.KA = (bf16*)(ws + WS_KA); P.VA = (bf16*)(ws + WS_VA); P.GA = (bf16*)(ws + WS_GA);
    P.QB = (bf16*)(ws + WS_QB); P.KB = (bf16*)(ws + WS_KB); P.VB = (bf16*)(ws + WS_VB); P.GB = (bf16*)(ws + WS_GB); P.MIX = (bf16*)(ws + WS_MIX);
    P.cosT = (float*)(ws + WS_COS); P.sinT = (float*)(ws + WS_SIN);
    P.PO16 = (bf16*)(ws + WS_PO16); P.PO4 = (bf16*)(ws + WS_PO4); P.PL16 = (float*)(ws + WS_PL16); P.PL4 = (float*)(ws + WS_PL4);
    for (int u = F.tid; u < (LDS_BYTES - LDSCTL_OFF) / 4; u += NWAVES * 64) ((LAS unsigned*)(F.lds + LDSCTL_OFF))[u] = 0u;
    __syncthreads();
    XcdBarrier bar = xcd_barrier_post((unsigned*)(F.ctl + CW_BAR), F.MISC + 8);

#ifndef PROBE_TS
#define PROBE_TS 0
#endif
    unsigned long long ts0 = 0, ts1 = 0, ts2 = 0, ts3 = 0, ts4 = 0;
    if (PROBE_TS) ts0 = rt();
#ifndef REP_P0
#define REP_P0 1
#define REP_P1 1
#define REP_P2 1
#define REP_P3 1
#endif
#pragma unroll
    for (int rep = 0; rep < REP_P0; ++rep) {
    p0_prologue(F, P);
    xcd_barrier(bar);
    }
    if (PROBE_TS) ts1 = rt();
#pragma unroll
    for (int rep = 0; rep < REP_P1; ++rep) {
#ifdef STAGGER_US
        if ((int)blockIdx.x >= F.G / 2) { const unsigned long long t0_ = rt(); while (rt() - t0_ < (unsigned long long)(STAGGER_US * 100)) __builtin_amdgcn_s_sleep(8); }
#endif
        pg8::Gemm g{P.XN, P.WIT, M, NIN, DM}; pg8::StaticOrder S; S.init(M, NIN, F.G, (int)blockIdx.x);
        pg8::EpiIn E{P.QA, P.KA, P.VA, P.GA, P.QB, P.KB, P.VB, P.GB, P.qna, P.kna, P.qnb, P.knb, P.cosT, P.sinT};
        pg8::gemm_phase<pg8::EpiIn, pg8::StaticOrder, PG8_ALIGN, PG8_SP2>(F.lds + RING_OFF, g, S, E);
    xcd_barrier(bar);
    }
    if (PROBE_TS) ts2 = rt();
#ifdef DRY_GEMM
    {
        pg8::Gemm g{P.XN, P.WIT, M, NIN, DM};
#if DRY_GEMM == 1
        pg8::StaticOrder S; S.init(M, NIN, F.G, (int)blockIdx.x); pg8::EpiNone E{};
        pg8::gemm_phase<pg8::EpiNone, pg8::StaticOrder, PG8_ALIGN, PG8_SP2>(F.lds + RING_OFF, g, S, E);
#elif DRY_GEMM == 3
        pg8::StaticOrder S; S.init(M, NIN, F.G, (int)blockIdx.x);
        pg8::EpiInT<true> E{P.QA, P.KA, P.VA, P.GA, P.QB, P.KB, P.VB, P.GB, P.qna, P.kna, P.qnb, P.knb, P.cosT, P.sinT};
        pg8::gemm_phase<pg8::EpiInT<true>, pg8::StaticOrder, PG8_ALIGN, PG8_SP2>(F.lds + RING_OFF, g, S, E);
#else
        pg8::SameTileOrder S; S.init(M, NIN, F.G, (int)blockIdx.x); pg8::EpiNone E{};
        pg8::gemm_phase<pg8::EpiNone, pg8::SameTileOrder, PG8_ALIGN, PG8_SP2>(F.lds + RING_OFF, g, S, E);
#endif
        xcd_barrier(bar);
    }
#endif
#pragma unroll
    for (int rep = 0; rep < REP_P2; ++rep) {
    p2_attention(F, P, bar);
    xcd_barrier(bar);
    }
    if (PROBE_TS) ts3 = rt();
#pragma unroll
    for (int rep = 0; rep < REP_P3; ++rep) {
        pg8::Gemm g{P.MIX, P.WOT, M, DM, DM}; pg8::StaticOrder S; S.init(M, DM, F.G, (int)blockIdx.x);
        pg8::EpiRes E{P.x, P.out};
        pg8::gemm_phase<pg8::EpiRes, pg8::StaticOrder, PG8_ALIGN, PG8_SP2>(F.lds + RING_OFF, g, S, E);
    }
    if (PROBE_TS) {
        ts4 = rt();
        if (blockIdx.x == 0 && F.tid == 0) {
            const float dA = (PROBE_TS == 1) ? (float)(ts2 - ts1) * 0.01f : (float)(ts1 - ts0) * 0.01f;
            const float dB = (PROBE_TS == 1) ? (float)(ts3 - ts2) * 0.01f : (float)(ts4 - ts3) * 0.01f;
            asm volatile("s_waitcnt vmcnt(0)" ::: "memory");
            P.out[0] += dA; P.out[1] += dB;
        }
    }
}

extern "C" void kernel_launch(void* const* d_in, const int* in_sizes, int n_in, void* d_out, int out_size, void* d_ws, size_t ws_size, hipStream_t stream) {
    static int grid = 0;
    if (grid == 0) {
        if (n_in != 9 || out_size != M * DM || ws_size < WS_END) { fprintf(stderr, "kernel_launch: unexpected shapes (n_in %d, out %d, ws %zu); nothing launched\n", n_in, out_size, ws_size); grid = -1; return; }
        int dev = 0, cus = 0;
        if (hipGetDevice(&dev) != hipSuccess || hipDeviceGetAttribute(&cus, hipDeviceAttributeMultiprocessorCount, dev) != hipSuccess) { grid = -1; return; }
        if (hipFuncSetAttribute((const void*)mega_fwd, hipFuncAttributeMaxDynamicSharedMemorySize, LDS_BYTES) != hipSuccess) { fprintf(stderr, "kernel_launch: hipFuncSetAttribute failed\n"); grid = -1; return; }
        (void)hipGetLastError();
        grid = cus;
    }
    if (grid < 0) return;
#ifdef EXTRA_MEMSET
    (void)hipMemsetAsync((char*)d_ws + WS_CTL + 512 * 1024, 0, CTL_ZERO_BYTES, stream);
#endif
    if (hipMemsetAsync((char*)d_ws + WS_CTL, 0, CTL_ZERO_BYTES, stream) != hipSuccess) { fprintf(stderr, "kernel_launch: hipMemsetAsync failed\n"); return; }
    Args a{};
    for (int i = 0; i < 9; ++i) a.in[i] = (const float*)d_in[i];
    a.out = (float*)d_out; a.ws = (unsigned char*)d_ws;
    hipLaunchKernelGGL(mega_fwd, dim3(grid), dim3(NWAVES * 64), LDS_BYTES, stream, a);
}
```

```cpp
#include <hip/hip_runtime.h>
#include <cstdio>
#include <cstdint>
#include <cmath>
#define KSWZ 1
namespace pg8 {
#define PG8_LAS __attribute__((address_space(3)))
typedef unsigned short bf16_t;
typedef short bf16x8 __attribute__((ext_vector_type(8)));
typedef float f32x4 __attribute__((ext_vector_type(4)));
typedef unsigned u32x4 __attribute__((ext_vector_type(4)));
constexpr int BM = 256, BK = 64, HALF = 128, HTB = HALF * BK * 2  , STAGE_BYTES = 8 * HTB, NXCD = 8, WGM = 8;

__host__ __device__ __forceinline__ int lds_byte(int r, int c) { const int st = (r >> 4) * 2 + (c >> 5), rr = r & 15, cc = c & 31, ob = rr * 64 + cc * 2; return st * 1024 + (ob ^ (((ob >> 9) & 1) << 5)); }
__host__ __device__ __forceinline__ void stage_rc(int b, int& R, int& C) { const int st = b / 1024, sb = b % 1024, swz = sb ^ (((sb >> 9) & 1) << 5); R = (st >> 1) * 16 + swz / 64; C = (st & 1) * 32 + (swz % 64) / 2; }
__host__ __device__ __forceinline__ int perm32(int rho) { const int n = rho >> 4, i = rho & 15; return 8 * (i >> 2) + 4 * n + (i & 3); }

struct Unit { int pm, pn; };
struct Gemm { const bf16_t* A; const bf16_t* Bt; int M, N, K; };

struct StaticOrder {
    int nM, nN, nwg, G, c;
    __host__ __device__ void init(int M, int N, int G_, int c_) { nM = M / BM; nN = N / BM; nwg = nM * nN; G = G_; c = c_; }
    __host__ __device__ bool next(int i, Unit& u) const {
        const long L = (long)i * G + c; if (L >= nwg) return false;
        int wgid = (int)L; { const int q = nwg / NXCD, r = nwg % NXCD, xcd = wgid % NXCD, off = wgid / NXCD; wgid = (xcd < r ? xcd * (q + 1) : r * (q + 1) + (xcd - r) * q) + off; }
        const int nig = WGM * nN, gid = wgid / nig, fm = gid * WGM, gsz = (nM - fm) < WGM ? (nM - fm) : WGM;
        u.pm = fm + ((wgid % nig) % gsz); u.pn = (wgid % nig) / gsz; return true;
    }
    __device__ __forceinline__ void a_ready(const Unit&) const {}
    __device__ __forceinline__ void done(const Unit&) const {}
};
__device__ __forceinline__ unsigned cvt_pk_bf16(float lo, float hi) { unsigned r; asm volatile("v_cvt_pk_bf16_f32 %0, %1, %2" : "=v"(r) : "v"(lo), "v"(hi)); return r; }
typedef float f32x2 __attribute__((ext_vector_type(2)));
typedef float f32x2 __attribute__((ext_vector_type(2)));
constexpr int SEQ_ = 4096;
constexpr float C2_ = 0.18033688011112042f, LOG2E_ = 1.4426950408889634f;
__device__ __forceinline__ u32x4 pack8(const f32x4& a, const f32x4& b) { u32x4 w; w.x = cvt_pk_bf16(a[0], a[1]); w.y = cvt_pk_bf16(a[2], a[3]); w.z = cvt_pk_bf16(b[0], b[1]); w.w = cvt_pk_bf16(b[2], b[3]); return w; }
__device__ __forceinline__ void store_row_pair(bf16_t* rowp, size_t pitch, int fr, u32x4 w0, u32x4 w1) {
    const bool odd = fr & 1;
    const u32x4 snd = odd ? w0 : w1;
    u32x4 rcv;
#pragma unroll
    for (int k = 0; k < 4; ++k) rcv[k] = (unsigned)__shfl_xor((int)snd[k], 1);
    const u32x4 A = odd ? rcv : w0, B = odd ? w1 : rcv;
    bf16_t* pa = odd ? rowp - pitch + 32 : rowp;
    bf16_t* pb = odd ? rowp + 32 : rowp + pitch;
    *(u32x4*)pa = A; *(u32x4*)pb = B;
}
template <bool NOSTORE = false> struct EpiInT {
    static constexpr bool PERM = true, AFTER_DRAIN = false, REPME = true; static constexpr int NSTORE = 16;
    bf16_t *QA, *KA, *VA, *GA, *QB, *KB, *VB, *GB;
    const float *qna, *kna, *qnb, *knb, *cosT, *sinT;
    __device__ __forceinline__ void init(f32x4 (&acc)[2][2][4][2], const Unit&, int, int, int, int) const {
#pragma unroll
        for (int a = 0; a < 2; ++a)
#pragma unroll
            for (int b = 0; b < 2; ++b)
#pragma unroll
                for (int m = 0; m < 4; ++m)
#pragma unroll
                    for (int n = 0; n < 2; ++n) acc[a][b][m][n] = (f32x4){0.f, 0.f, 0.f, 0.f};
    }
    __device__ __forceinline__ void operator()(const f32x4 (&acc)[2][2][4][2], const Unit& u, int wr, int wc, int fr, int fq) const {
        const int g = u.pn * 4 + wc;
        int type, head, H = 8; const float* ng = qna; bf16_t* dst; float scale = 1.f;
        if (g < 8) { type = 0; head = g; ng = qna; dst = QA; scale = C2_; }
        else if (g < 10) { type = 0; head = g - 8; ng = kna; dst = KA; H = 2; }
        else if (g < 12) { type = 1; head = g - 10; dst = VA; H = 2; }
        else if (g < 20) { type = 2; head = g - 12; dst = GA; }
        else if (g < 28) { type = 0; head = g - 20; ng = qnb; dst = QB; scale = C2_; }
        else if (g < 36) { type = 0; head = g - 28; ng = knb; dst = KB; }
        else if (g < 44) { type = 1; head = g - 36; dst = VB; }
        else { type = 2; head = g - 44; dst = GB; }
        const int row0 = u.pm * BM + wr * 64 + fr;
        if (type == 0) {
            f32x4 gv[2][2], c16[2], s16[2], cb[2][2], sb[2][2];
            const int tb = (row0 & (SEQ_ - 1));
#pragma unroll
            for (int n = 0; n < 2; ++n) {
                c16[n] = *(const f32x4*)(cosT + 16 * 32 + 8 * fq + 4 * n); s16[n] = *(const f32x4*)(sinT + 16 * 32 + 8 * fq + 4 * n);
#pragma unroll
                for (int ai = 0; ai < 2; ++ai) { cb[ai][n] = *(const f32x4*)(cosT + (tb + ai * HALF) * 32 + 8 * fq + 4 * n); sb[ai][n] = *(const f32x4*)(sinT + (tb + ai * HALF) * 32 + 8 * fq + 4 * n); }
#pragma unroll
                for (int bj = 0; bj < 2; ++bj) gv[bj][n] = *(const f32x4*)(ng + 32 * bj + 8 * fq + 4 * n);
            }
#pragma unroll
            for (int ai = 0; ai < 2; ++ai) {
                f32x4 cs[2] = {cb[ai][0], cb[ai][1]}, sn[2] = {sb[ai][0], sb[ai][1]};
#pragma unroll
                for (int m = 0; m < 4; ++m) {
                    const int row = row0 + ai * HALF + m * 16, b = row >> 12, t = row & (SEQ_ - 1);
                    float ss = 0.f;
#pragma unroll
                    for (int bj = 0; bj < 2; ++bj)
#pragma unroll
                        for (int n = 0; n < 2; ++n) { const f32x4 x = acc[ai][bj][m][n]; ss += (x[0] * x[0] + x[1] * x[1]) + (x[2] * x[2] + x[3] * x[3]); }
                    ss += __shfl_xor(ss, 16); ss += __shfl_xor(ss, 32);
                    const float rs = rsqrtf(ss * (1.f / 64.f) + 1e-6f) * scale;
                    f32x4 o1[2], o2[2];
#pragma unroll
                    for (int n = 0; n < 2; ++n) {
                        const f32x4 n1 = acc[ai][0][m][n] * rs * gv[0][n], n2 = acc[ai][1][m][n] * rs * gv[1][n];
                        o1[n] = n1 * cs[n] - n2 * sn[n]; o2[n] = n2 * cs[n] + n1 * sn[n];
                        const f32x4 cn = cs[n] * c16[n] - sn[n] * s16[n], sn2 = sn[n] * c16[n] + cs[n] * s16[n];
                        cs[n] = cn; sn[n] = sn2;
                    }
                    bf16_t* p = dst + ((size_t)(b * H + head) * SEQ_ + t) * 64 + 8 * fq;
                    { const u32x4 w0_ = pack8(o1[0], o1[1]), w1_ = pack8(o2[0], o2[1]); if (NOSTORE) { asm volatile("" :: "v"(w0_), "v"(w1_)); } else { *(u32x4*)p = w0_; *(u32x4*)(p + 32) = w1_; } }
                }
            }
        } else if (type == 1) {
#pragma unroll
            for (int ai = 0; ai < 2; ++ai)
#pragma unroll
                for (int m = 0; m < 4; ++m) {
                    const int row = row0 + ai * HALF + m * 16, b = row >> 12, t = row & (SEQ_ - 1);
                    bf16_t* p = dst + ((size_t)(b * H + head) * SEQ_ + t) * 64 + 8 * fq;
                    { const u32x4 w0_ = pack8(acc[ai][0][m][0], acc[ai][0][m][1]), w1_ = pack8(acc[ai][1][m][0], acc[ai][1][m][1]); if (NOSTORE) { asm volatile("" :: "v"(w0_), "v"(w1_)); } else { *(u32x4*)p = w0_; *(u32x4*)(p + 32) = w1_; } }
                }
        } else {
#pragma unroll
            for (int ai = 0; ai < 2; ++ai)
#pragma unroll
                for (int m = 0; m < 4; ++m) {
                    const int row = row0 + ai * HALF + m * 16;
                    bf16_t* p = dst + (size_t)row * 512 + head * 64 + 8 * fq;
                    u32x4 wq[2];
#pragma unroll
                    for (int bj = 0; bj < 2; ++bj) {
                        f32x4 s[2];
#pragma unroll
                        for (int n = 0; n < 2; ++n) { const f32x4 v = acc[ai][bj][m][n];
#pragma unroll
                            for (int e = 0; e < 4; ++e) s[n][e] = v[e]; }
                        wq[bj] = pack8(s[0], s[1]);
                    }
                    { const u32x4 w0_ = wq[0], w1_ = wq[1]; if (NOSTORE) { asm volatile("" :: "v"(w0_), "v"(w1_)); } else { *(u32x4*)p = w0_; *(u32x4*)(p + 32) = w1_; } }
                }
        }
    }
};
typedef EpiInT<false> EpiIn;
struct EpiRes {
    static constexpr bool PERM = true, AFTER_DRAIN = false, REPME = false; static constexpr int NSTORE = 32;
    const float* x; float* out;
    __device__ __forceinline__ void init(f32x4 (&acc)[2][2][4][2], const Unit&, int, int, int, int) const {
#pragma unroll
        for (int a = 0; a < 2; ++a)
#pragma unroll
            for (int b = 0; b < 2; ++b)
#pragma unroll
                for (int m = 0; m < 4; ++m)
#pragma unroll
                    for (int n = 0; n < 2; ++n) acc[a][b][m][n] = (f32x4){0.f, 0.f, 0.f, 0.f};
    }
    __device__ __forceinline__ void operator()(const f32x4 (&acc)[2][2][4][2], const Unit& u, int wr, int wc, int fr, int fq) const {
        const int row0 = u.pm * BM + wr * 64 + fr, col0 = u.pn * BM + wc * 32 + 8 * fq;
#pragma unroll
        for (int ai = 0; ai < 2; ++ai) {
            f32x4 xr[4][2][2];
#pragma unroll
            for (int m = 0; m < 4; ++m) {
                const size_t off = (size_t)(row0 + ai * HALF + m * 16) * 1024 + col0;
#pragma unroll
                for (int bj = 0; bj < 2; ++bj) { xr[m][bj][0] = *(const f32x4*)(x + off + bj * HALF); xr[m][bj][1] = *(const f32x4*)(x + off + bj * HALF + 4); }
            }
            asm volatile("" ::: "memory");
#pragma unroll
            for (int m = 0; m < 4; ++m) {
                const size_t off = (size_t)(row0 + ai * HALF + m * 16) * 1024 + col0;
#pragma unroll
                for (int bj = 0; bj < 2; ++bj) { *(f32x4*)(out + off + bj * HALF) = xr[m][bj][0] + acc[ai][bj][m][0]; *(f32x4*)(out + off + bj * HALF + 4) = xr[m][bj][1] + acc[ai][bj][m][1]; }
            }
            asm volatile("" ::: "memory");
        }
    }
};
struct EpiNone {
    static constexpr bool PERM = true, AFTER_DRAIN = false, REPME = false; static constexpr int NSTORE = 0;
    __device__ __forceinline__ void init(f32x4 (&acc)[2][2][4][2], const Unit&, int, int, int, int) const {
#pragma unroll
        for (int a = 0; a < 2; ++a)
#pragma unroll
            for (int b = 0; b < 2; ++b)
#pragma unroll
                for (int m = 0; m < 4; ++m)
#pragma unroll
                    for (int n = 0; n < 2; ++n) acc[a][b][m][n] = (f32x4){0.f, 0.f, 0.f, 0.f};
    }
    __device__ __forceinline__ void operator()(const f32x4 (&acc)[2][2][4][2], const Unit&, int, int, int, int) const {
#pragma unroll
        for (int a = 0; a < 2; ++a)
#pragma unroll
            for (int b = 0; b < 2; ++b)
#pragma unroll
                for (int m = 0; m < 4; ++m)
#pragma unroll
                    for (int n = 0; n < 2; ++n) asm volatile("" :: "v"(acc[a][b][m][n]));
    }
};
struct SameTileOrder : StaticOrder {
    __host__ __device__ bool next(int i, Unit& u) const { if (!StaticOrder::next(i, u)) return false; u.pm = 0; u.pn = 0; return true; }
};
template <class Epi, class Sched, bool ALIGN_EPI = false, bool SP2 = false>
__device__ __forceinline__ void gemm_phase(PG8_LAS unsigned char* lds, const Gemm g, const Sched& S, const Epi& E) {
    int tid_ = threadIdx.x; asm volatile("" : "+v"(tid_));
    const int tid = tid_, wid = __builtin_amdgcn_readfirstlane(tid >> 6), lane = tid & 63, wr = wid >> 2, wc = wid & 3, fr = lane & 15, fq = lane >> 4;
    const int K = g.K, nt = K / BK;
    unsigned voffA[2], voffB[2];
#pragma unroll
    for (int i = 0; i < 2; ++i) { int R, C; stage_rc(tid * 16 + i * 8192, R, C); const int Rb = Epi::PERM ? ((R & ~31) + perm32(R & 31)) : R;
        voffA[i] = (unsigned)(R * K + C) * 2u; voffB[i] = (unsigned)(Rb * K + C) * 2u; }
    const size_t kstep = (size_t)(BK * 2);
    const size_t hstep = (size_t)HALF * K * 2;
    const size_t tstep = 2 * hstep;
    const unsigned ldsw = (unsigned)wid * 1024u;
    const int aoff = lds_byte(wr * 64 + fr, fq * 8), boff = lds_byte(wc * 32 + fr, fq * 8);
#define PG8_SA(b, h) (((b) * 2 + (h)) * HTB)
#define PG8_SB(b, h) ((4 + (b) * 2 + (h)) * HTB)
#define PG8_STAGE(bufoff, gbase, voff) do { _Pragma("unroll") for (int _i = 0; _i < 2; ++_i) \
        __builtin_amdgcn_global_load_lds((const unsigned*)((const char*)(gbase) + (voff)[_i]), (PG8_LAS unsigned*)(lds + (bufoff) + ldsw + _i * 8192), 16, 0, 0); } while (0)
#define PG8_LDA(dst, b, h) do { _Pragma("unroll") for (int m = 0; m < 4; ++m) _Pragma("unroll") for (int k = 0; k < 2; ++k) dst[m][k] = *(const PG8_LAS bf16x8*)(lds + PG8_SA(b, h) + aoff + m * 2048 + k * 1024); } while (0)
#define PG8_LDB(dst, b, h) do { _Pragma("unroll") for (int n = 0; n < 2; ++n) _Pragma("unroll") for (int k = 0; k < 2; ++k) dst[n][k] = *(const PG8_LAS bf16x8*)(lds + PG8_SB(b, h) + boff + n * 2048 + k * 1024); } while (0)
#define PG8_MMA(ai, bj, At, Bt) do { __builtin_amdgcn_s_setprio(1); _Pragma("unroll") for (int m = 0; m < 4; ++m) _Pragma("unroll") for (int n = 0; n < 2; ++n) _Pragma("unroll") for (int k = 0; k < 2; ++k) \
        acc[ai][bj][m][n] = __builtin_amdgcn_mfma_f32_16x16x32_bf16(Bt[n][k], At[m][k], acc[ai][bj][m][n], 0, 0, 0); __builtin_amdgcn_s_setprio(0); } while (0)
#define PG8_WAIT_V(n) asm volatile("s_waitcnt vmcnt(" #n ")" ::: "memory")
#define PG8_WAIT_V8S() do { if (Epi::NSTORE == 16) PG8_WAIT_V(24); else if (Epi::NSTORE == 32) PG8_WAIT_V(40); else PG8_WAIT_V(8); } while (0)
#define PG8_WAIT_L(n) asm volatile("s_waitcnt lgkmcnt(" #n ")" ::: "memory")
#define PG8_BAR __builtin_amdgcn_s_barrier()
#define PG8_SCHED __builtin_amdgcn_sched_barrier(0)
    Unit cur, nxt; int ui = 0;
    if (!S.next(0, cur)) return;
    f32x4 acc[2][2][4][2];
    E.init(acc, cur, wr, wc, fr, fq);
    bf16x8 At[4][2], B0[2][2], B1[2][2];
    const char* cA = (const char*)g.A + (size_t)cur.pm * tstep; const char* cB = (const char*)g.Bt + (size_t)cur.pn * tstep;
    S.a_ready(cur);
    if constexpr (SP2) {
        PG8_STAGE(PG8_SB(0, 0), cB, voffB); PG8_STAGE(PG8_SB(0, 1), cB + hstep, voffB); PG8_STAGE(PG8_SA(0, 0), cA, voffA); PG8_STAGE(PG8_SA(0, 1), cA + hstep, voffA);
        if (wr == 1) PG8_BAR;
        PG8_WAIT_V(2); PG8_BAR;
        PG8_STAGE(PG8_SB(1, 0), cB + kstep, voffB); PG8_STAGE(PG8_SA(1, 0), cA + kstep, voffA); PG8_STAGE(PG8_SB(1, 1), cB + hstep + kstep, voffB);
        PG8_WAIT_V(6); PG8_BAR;
    } else {
        PG8_STAGE(PG8_SB(0, 0), cB, voffB); PG8_STAGE(PG8_SA(0, 0), cA, voffA); PG8_STAGE(PG8_SB(0, 1), cB + hstep, voffB); PG8_STAGE(PG8_SA(0, 1), cA + hstep, voffA);
        if (wr == 1) PG8_BAR;
        PG8_WAIT_V(4); PG8_BAR;
        PG8_STAGE(PG8_SB(1, 0), cB + kstep, voffB); PG8_STAGE(PG8_SA(1, 0), cA + kstep, voffA); PG8_STAGE(PG8_SB(1, 1), cB + hstep + kstep, voffB);
        PG8_WAIT_V(6); PG8_BAR;
    }
    for (;;) {
        const bool has_next = S.next(ui + 1, nxt);
        const char* nA = has_next ? (const char*)g.A + (size_t)nxt.pm * tstep : cA; const char* nB = has_next ? (const char*)g.Bt + (size_t)nxt.pn * tstep : cB;
        for (int t = 0; t < nt; t += 2) {
            const bool last = (t == nt - 2);
            const char* a1 = cA + (size_t)(t + 1) * kstep;
            const char* a2 = last ? nA : cA + (size_t)(t + 2) * kstep; const char* b2 = last ? nB : cB + (size_t)(t + 2) * kstep;
            const char* a3 = a2 + kstep; const char* b3 = b2 + kstep;
            if (last && has_next) S.a_ready(nxt);
            if constexpr (SP2) {
            PG8_LDB(B0, 0, 0); PG8_LDB(B1, 0, 1); PG8_SCHED; PG8_LDA(At, 0, 0); PG8_STAGE(PG8_SA(1, 1), a1 + hstep, voffA);
            PG8_WAIT_V(8); PG8_WAIT_L(0); PG8_BAR; PG8_MMA(0, 0, At, B0); PG8_MMA(0, 1, At, B1); PG8_BAR; PG8_SCHED;
            PG8_LDA(At, 0, 1); PG8_STAGE(PG8_SB(0, 0), b2, voffB); PG8_STAGE(PG8_SB(0, 1), b2 + hstep, voffB); PG8_STAGE(PG8_SA(0, 0), a2, voffA);
            PG8_WAIT_V(8); PG8_WAIT_L(0); PG8_BAR; PG8_MMA(1, 0, At, B0); PG8_MMA(1, 1, At, B1); PG8_BAR; PG8_SCHED;
            PG8_LDB(B0, 1, 0); PG8_LDB(B1, 1, 1); PG8_SCHED; PG8_LDA(At, 1, 0); PG8_STAGE(PG8_SA(0, 1), a2 + hstep, voffA);
            PG8_WAIT_V(8); PG8_WAIT_L(0); PG8_BAR; PG8_MMA(0, 0, At, B0); PG8_MMA(0, 1, At, B1); PG8_BAR; PG8_SCHED;
            PG8_LDA(At, 1, 1); PG8_STAGE(PG8_SB(1, 0), b3, voffB); PG8_STAGE(PG8_SB(1, 1), b3 + hstep, voffB); PG8_STAGE(PG8_SA(1, 0), a3, voffA);
            PG8_WAIT_V(8); PG8_WAIT_L(0); PG8_BAR; PG8_MMA(1, 0, At, B0); PG8_MMA(1, 1, At, B1); PG8_BAR; PG8_SCHED;
            } else {
            PG8_LDB(B0, 0, 0); PG8_SCHED; PG8_LDA(At, 0, 0); PG8_STAGE(PG8_SA(1, 1), a1 + hstep, voffA);
            PG8_WAIT_L(8); PG8_BAR; PG8_WAIT_L(0); PG8_MMA(0, 0, At, B0); PG8_BAR; PG8_SCHED;
            PG8_LDB(B1, 0, 1); PG8_STAGE(PG8_SB(0, 0), b2, voffB);
            PG8_BAR; PG8_WAIT_L(0); PG8_MMA(0, 1, At, B1); PG8_BAR;
            PG8_LDA(At, 0, 1); PG8_STAGE(PG8_SA(0, 0), a2, voffA);
            PG8_BAR; PG8_WAIT_L(0); PG8_MMA(1, 0, At, B0); PG8_BAR; PG8_SCHED;
            PG8_STAGE(PG8_SB(0, 1), b2 + hstep, voffB);
            PG8_WAIT_V(6); PG8_BAR; PG8_MMA(1, 1, At, B1); PG8_BAR;
            PG8_LDB(B0, 1, 0); PG8_SCHED; PG8_LDA(At, 1, 0); PG8_STAGE(PG8_SA(0, 1), a2 + hstep, voffA);
            PG8_WAIT_L(8); PG8_BAR; PG8_WAIT_L(0); PG8_MMA(0, 0, At, B0); PG8_BAR; PG8_SCHED;
            PG8_LDB(B1, 1, 1); PG8_STAGE(PG8_SB(1, 0), b3, voffB);
            PG8_BAR; PG8_WAIT_L(0); PG8_MMA(0, 1, At, B1); PG8_BAR;
            PG8_LDA(At, 1, 1); PG8_STAGE(PG8_SA(1, 0), a3, voffA);
            PG8_BAR; PG8_WAIT_L(0); PG8_MMA(1, 0, At, B0); PG8_BAR; PG8_SCHED;
            PG8_STAGE(PG8_SB(1, 1), b3 + hstep, voffB);
            PG8_WAIT_V(6); PG8_BAR; PG8_MMA(1, 1, At, B1); PG8_BAR;
            }
        }
        if constexpr (ALIGN_EPI) { if (wr == 0) PG8_BAR; }
        if constexpr (!Epi::AFTER_DRAIN) { E(acc, cur, wr, wc, fr, fq); S.done(cur); }
        if (!has_next) break;
        E.init(acc, nxt, wr, wc, fr, fq);
        cur = nxt; cA = nA; cB = nB; ++ui;
        if constexpr (ALIGN_EPI) { if (wr == 1) PG8_BAR; }
    }
    PG8_WAIT_V(0);
    if constexpr (!ALIGN_EPI) { if (wr == 0) PG8_BAR; }
    PG8_BAR;
    if constexpr (Epi::AFTER_DRAIN) { E.fused(acc, cur, wr, wc, fr, fq, lds, wid, lane); S.done(cur); }
#undef PG8_SA
#undef PG8_SB
#undef PG8_STAGE
#undef PG8_LDA
#undef PG8_LDB
#undef PG8_MMA
#undef PG8_WAIT_V
#undef PG8_WAIT_V8S
#undef PG8_WAIT_L
#undef PG8_BAR
#undef PG8_SCHED
}
}
namespace att {
#ifndef KSWZ
#define KSWZ 0
#endif
typedef short bf16x8 __attribute__((ext_vector_type(8)));
typedef short s16x4 __attribute__((ext_vector_type(4)));
typedef short v4i16_t __attribute__((ext_vector_type(4)));
typedef float f32x16 __attribute__((ext_vector_type(16)));
typedef float f32x4 __attribute__((ext_vector_type(4)));
typedef unsigned u32x4 __attribute__((ext_vector_type(4)));
typedef float f32x2_t __attribute__((ext_vector_type(2))); typedef __bf16 bf16x2_t __attribute__((ext_vector_type(2)));
typedef __attribute__((address_space(3))) unsigned char* lds_ptr;
__device__ __forceinline__ unsigned cvtpk_s(float lo, float hi) { f32x2_t v = {lo, hi}; bf16x2_t b = __builtin_convertvector(v, bf16x2_t); return __builtin_bit_cast(unsigned, b); }
__device__ __forceinline__ int crow(int r, int hi) { return (r & 3) + 8 * (r >> 2) + 4 * hi; }
__device__ __forceinline__ s16x4 vtr(lds_ptr p) { return __builtin_bit_cast(s16x4, __builtin_amdgcn_ds_read_tr16_b64_v4i16((__attribute__((address_space(3))) v4i16_t*)p)); }
#define ATT_WAITV(n) asm volatile("s_waitcnt vmcnt(" #n ")" ::: "memory")
__device__ __forceinline__ void glds16(const void* gsrc, unsigned lds_dst) { unsigned keep;
    asm volatile("s_mov_b32 %0, m0\n\ts_mov_b32 m0, %2\n\ts_nop 0\n\tglobal_load_lds_dwordx4 %1, off\n\ts_mov_b32 m0, %0" : "=&s"(keep) : "v"(gsrc), "s"(lds_dst) : "memory"); }
#define ATT_GLDS(src, dst) glds16((src), (unsigned)__builtin_amdgcn_readfirstlane((int)(dst)))

struct Desc {
    const unsigned short *Q0, *Q1, *K, *V;
    int dil, r, qt0, qt1;
    unsigned short* po; float* pl;
    const unsigned short *po_a, *po_b; const float *pl_a, *pl_b;
    const unsigned short *gate0, *gate1; unsigned short *mix0, *mix1;
    float sink0, sink1;
};
struct LaneK { unsigned koff[4], voff[4]; };
__device__ __forceinline__ LaneK lane_offsets(int dil, int lane) {
    LaneK L;
#pragma unroll
    for (int i = 0; i < 4; ++i) {
        const int row = 8 * i + (lane >> 3), chunk = (lane & 7) ^ (KSWZ ? ((row >> 1) & 7) : 0);
        L.koff[i] = (unsigned)(dil * row) * 128u + (unsigned)chunk * 16u;
        const int vchunk = (lane & 7) ^ (4 * ((row >> 1) & 1));
        L.voff[i] = (unsigned)(dil * row) * 128u + (unsigned)vchunk * 16u;
    }
    return L;
}
#define ATT_DMA_K(D, L, ktlo, j, sl) do { const char* s_ = (const char*)(D).K + (size_t)(D).r * 128 + (size_t)((ktlo) + (j)) * ((size_t)(D).dil * 4096); const unsigned d_ = ring0 + ((sl) & 1) * 8192; \
        ATT_GLDS(s_ + (L).koff[0], d_); ATT_GLDS(s_ + (L).koff[1], d_ + 1024); ATT_GLDS(s_ + (L).koff[2], d_ + 2048); ATT_GLDS(s_ + (L).koff[3], d_ + 3072); } while (0)
#define ATT_DMA_V(D, L, ktlo, j, sl) do { const char* s_ = (const char*)(D).V + (size_t)(D).r * 128 + (size_t)((ktlo) + (j)) * ((size_t)(D).dil * 4096); const unsigned d_ = ring0 + ((sl) & 1) * 8192 + 4096; \
        ATT_GLDS(s_ + (L).voff[0], d_); ATT_GLDS(s_ + (L).voff[1], d_ + 1024); ATT_GLDS(s_ + (L).voff[2], d_ + 2048); ATT_GLDS(s_ + (L).voff[3], d_ + 3072); } while (0)
template <int DRY = 0>
__device__ __forceinline__ void prefetch(const Desc& D, unsigned ring0, bf16x8 (&qr)[2][4], int lane, int par = 0) {
    const int q = lane & 31, hi = lane >> 5;
    const int ktlo = D.qt0 >= 4 ? D.qt0 - 4 : 0, nt = D.qt1 - ktlo + 1;
    const LaneK L = lane_offsets(D.dil, lane);
    { const unsigned short* q0 = D.Q0 + (size_t)(D.r + D.dil * (32 * D.qt0 + q)) * 64 + hi * 8; const unsigned short* q1 = D.Q1 + (size_t)(D.r + D.dil * (32 * D.qt1 + q)) * 64 + hi * 8;
#pragma unroll
      for (int d0 = 0; d0 < 4; ++d0) { qr[0][d0] = *(const bf16x8*)(q0 + d0 * 16); qr[1][d0] = *(const bf16x8*)(q1 + d0 * 16); } }
    asm volatile("s_waitcnt lgkmcnt(0)" ::: "memory");
    if (DRY != 2) { ATT_DMA_K(D, L, ktlo, 0, par); ATT_DMA_V(D, L, ktlo, 0, par);
    if (nt > 1) { ATT_DMA_K(D, L, ktlo, 1, par + 1); ATT_DMA_V(D, L, ktlo, 1, par + 1); }
    if (DRY == 3) { if (nt > 2) { ATT_DMA_K(D, L, ktlo, 2, par); ATT_DMA_V(D, L, ktlo, 2, par); } if (nt > 3) { ATT_DMA_K(D, L, ktlo, 3, par + 1); ATT_DMA_V(D, L, ktlo, 3, par + 1); } } }
}
template <int MODE, int DRY = 0>
__device__ __forceinline__ void attn_item(lds_ptr ring, lds_ptr stage, const Desc& D, bool has_next, const Desc& N, bf16x8 (&qx)[2][4], int& par, int lane) {
    const int q = lane & 31, hi = lane >> 5;
    const int ktlo = D.qt0 >= 4 ? D.qt0 - 4 : 0, nt = D.qt1 - ktlo + 1;
    constexpr int DMIN = (MODE == 0) ? 1 : 0;
    const unsigned ring0 = (unsigned)(uintptr_t)ring;
    const LaneK L = lane_offsets(D.dil, lane);
    const int krow = q * 128, ksw = KSWZ ? ((q >> 1) & 7) : 0;
    const int vsw = ((lane & 15) >> 3) & 1;
    const int vb = ((lane >> 4) & 1) * 32 + (lane & 3) * 8 + (4 * hi + ((lane & 15) >> 2)) * 128;
    f32x16 o00 = {}, o01 = {}, o10 = {}, o11 = {}; float ls0 = 0.f, ls1 = 0.f;
    asm volatile("s_waitcnt vmcnt(0)" ::: "memory");
    bf16x8 qr[2][4];
#pragma unroll
    for (int s_ = 0; s_ < 2; ++s_)
#pragma unroll
        for (int d0 = 0; d0 < 4; ++d0) qr[s_][d0] = qx[s_][d0];
    asm volatile("" : "+v"(qr[0][0]), "+v"(qr[0][1]), "+v"(qr[0][2]), "+v"(qr[0][3]), "+v"(qr[1][0]), "+v"(qr[1][1]), "+v"(qr[1][2]), "+v"(qr[1][3]));
    const int Nktlo = N.qt0 >= 4 ? N.qt0 - 4 : 0, Nnt = N.qt1 - Nktlo + 1;
    const bool ext = (DRY == 0) && has_next && nt >= 2 && N.dil == D.dil;
    const int nx = ext ? (Nnt < 2 ? Nnt : 2) : 0;
    for (int j = 0; j < nt; ++j) {
        const int e = nt - 1 - j + nx, kt = ktlo + j; lds_ptr slot = ring + ((j + par) & 1) * 8192;
        const bool act0 = (kt <= D.qt0), act1 = (kt >= D.qt1 - 4);
        if (DRY == 3) { if (e >= 3) ATT_WAITV(28); else if (e == 2) ATT_WAITV(20); else if (e == 1) ATT_WAITV(12); else ATT_WAITV(4); }
        else if (DRY != 2) { if (e >= 1) ATT_WAITV(12); else ATT_WAITV(4); }
        bf16x8 kf[4];
        if (DRY != 1 && DRY != 3) {
#pragma unroll
        for (int ks = 0; ks < 4; ++ks) kf[ks] = *(const __attribute__((address_space(3))) bf16x8*)(slot + krow + (((2 * ks + hi) ^ ksw) * 16));
        asm volatile("s_waitcnt lgkmcnt(0)" ::: "memory");
        asm volatile("" : "+v"(kf[0]), "+v"(kf[1]), "+v"(kf[2]), "+v"(kf[3]));
        }
        if (DRY == 3) { if (e >= 4) ATT_DMA_K(D, L, ktlo, j + 4, j + par); }
        else if (DRY != 2 && e >= 2) { if (j + 2 < nt) ATT_DMA_K(D, L, ktlo, j + 2, j + par); else ATT_DMA_K(N, L, Nktlo, j + 2 - nt, j + par); }
        u32x4 pa0 = {}, pa1 = {}, pb0 = {}, pb1 = {};
#define ATT_SCORE(S, QT, ACT, LS, PW0, PW1) if (ACT) { f32x16 p = {}; \
            _Pragma("unroll") for (int ks = 0; ks < 4; ++ks) p = __builtin_amdgcn_mfma_f32_32x32x16_bf16(kf[ks], qr[S][ks], p, 0, 0, 0); \
            const bool first = (kt == (QT) - 4), last = (kt == (QT)); \
            if (first || last) { _Pragma("unroll") for (int rr = 0; rr < 16; ++rr) { const int kk = crow(rr, hi); const bool bad = (first && kk < q + DMIN) || (last && kk > q); if (bad) p[rr] = -INFINITY; } } \
            float s_ = 0.f; \
            _Pragma("unroll") for (int rr = 0; rr < 16; ++rr) { p[rr] = __builtin_amdgcn_exp2f(p[rr]); s_ += p[rr]; } \
            LS += s_; \
            PW0[0] = cvtpk_s(p[0], p[1]); PW0[1] = cvtpk_s(p[2], p[3]); PW0[2] = cvtpk_s(p[4], p[5]); PW0[3] = cvtpk_s(p[6], p[7]); \
            PW1[0] = cvtpk_s(p[8], p[9]); PW1[1] = cvtpk_s(p[10], p[11]); PW1[2] = cvtpk_s(p[12], p[13]); PW1[3] = cvtpk_s(p[14], p[15]); }
        if (DRY != 1 && DRY != 3) {
        ATT_SCORE(0, D.qt0, act0, ls0, pa0, pa1)
        ATT_SCORE(1, D.qt1, act1, ls1, pb0, pb1)
        }
#undef ATT_SCORE
        if (DRY == 3) { if (e >= 4) ATT_WAITV(28); else if (e == 3) ATT_WAITV(24); else if (e == 2) ATT_WAITV(16); else if (e == 1) ATT_WAITV(8); else ATT_WAITV(0); }
        else if (DRY != 2) { if (e >= 2) ATT_WAITV(12); else if (e == 1) ATT_WAITV(8); else ATT_WAITV(0); }
        if (DRY != 1 && DRY != 3) {
        lds_ptr vp = slot + 4096 + vb;
        s16x4 lo[4], hh[4];
#pragma unroll
        for (int i = 0; i < 4; ++i) { const int o_ = (i & 1) * 2048 + (((i >> 1) ^ vsw) * 64); lo[i] = vtr(vp + o_); hh[i] = vtr(vp + o_ + 1024); }
#define ATT_VFR(i) (bf16x8){lo[i][0], lo[i][1], lo[i][2], lo[i][3], hh[i][0], hh[i][1], hh[i][2], hh[i][3]}
        if (act0) {
            o00 = __builtin_amdgcn_mfma_f32_32x32x16_bf16(__builtin_bit_cast(bf16x8, pa0), ATT_VFR(0), o00, 0, 0, 0);
            o00 = __builtin_amdgcn_mfma_f32_32x32x16_bf16(__builtin_bit_cast(bf16x8, pa1), ATT_VFR(1), o00, 0, 0, 0);
            o01 = __builtin_amdgcn_mfma_f32_32x32x16_bf16(__builtin_bit_cast(bf16x8, pa0), ATT_VFR(2), o01, 0, 0, 0);
            o01 = __builtin_amdgcn_mfma_f32_32x32x16_bf16(__builtin_bit_cast(bf16x8, pa1), ATT_VFR(3), o01, 0, 0, 0);
        }
        if (act1) {
            o10 = __builtin_amdgcn_mfma_f32_32x32x16_bf16(__builtin_bit_cast(bf16x8, pb0), ATT_VFR(0), o10, 0, 0, 0);
            o10 = __builtin_amdgcn_mfma_f32_32x32x16_bf16(__builtin_bit_cast(bf16x8, pb1), ATT_VFR(1), o10, 0, 0, 0);
            o11 = __builtin_amdgcn_mfma_f32_32x32x16_bf16(__builtin_bit_cast(bf16x8, pb0), ATT_VFR(2), o11, 0, 0, 0);
            o11 = __builtin_amdgcn_mfma_f32_32x32x16_bf16(__builtin_bit_cast(bf16x8, pb1), ATT_VFR(3), o11, 0, 0, 0);
        }
#undef ATT_VFR
        }
        asm volatile("s_waitcnt lgkmcnt(0)" ::: "memory");
        if (DRY == 3) { if (e >= 4) ATT_DMA_V(D, L, ktlo, j + 4, j + par); }
        else if (DRY != 2 && e >= 2) { if (j + 2 < nt) ATT_DMA_V(D, L, ktlo, j + 2, j + par); else ATT_DMA_V(N, L, Nktlo, j + 2 - nt, j + par); }
    }
    int lane_s = lane; asm volatile("" : "+v"(lane_s));
    {
    const int lane = lane_s, q = lane & 31, hi = lane >> 5;
    __attribute__((address_space(3))) unsigned short* st = (__attribute__((address_space(3))) unsigned short*)stage;
    u32x4 g0[4], a0[4], b0[4]; float la0[4], lb0[4];
#define ATT_EPI_T(QT, pp) ((size_t)(D.r + D.dil * (32 * (QT) + 16 * ((pp) >> 1) + 8 * ((pp) & 1) + (lane >> 3))))
#define ATT_EPI_LOAD(QT, G, A, B, LA, LB, GATE) do { _Pragma("unroll") for (int pp = 0; pp < 4; ++pp) { const size_t t = ATT_EPI_T(QT, pp); const int ch = lane & 7; \
        G[pp] = *(const u32x4*)((GATE) + t * 512 + ch * 8); \
        if (MODE == 2) { A[pp] = __builtin_nontemporal_load((const u32x4*)(D.po_a + t * 64 + ch * 8)); B[pp] = __builtin_nontemporal_load((const u32x4*)(D.po_b + t * 64 + ch * 8)); \
                         LA[pp] = __builtin_nontemporal_load(D.pl_a + t); LB[pp] = __builtin_nontemporal_load(D.pl_b + t); } } } while (0)
#define ATT_EPI_TOUCH(G, A, B, LA, LB) do { asm volatile("" : "+v"(G[0]), "+v"(G[1]), "+v"(G[2]), "+v"(G[3])); \
        if (MODE == 2) { asm volatile("" : "+v"(A[0]), "+v"(A[1]), "+v"(A[2]), "+v"(A[3]), "+v"(B[0]), "+v"(B[1]), "+v"(B[2]), "+v"(B[3])); \
                         asm volatile("" : "+v"(LA[0]), "+v"(LA[1]), "+v"(LA[2]), "+v"(LA[3]), "+v"(LB[0]), "+v"(LB[1]), "+v"(LB[2]), "+v"(LB[3])); } } while (0)
#define ATT_EPI_PROC(QT, OA, OB, LS, G, A, B, LA, LB, MIX, SINK) do { \
        { auto sw_ = __builtin_amdgcn_permlane32_swap(__float_as_uint(LS), __float_as_uint(LS), false, false); LS = __uint_as_float(sw_[0]) + __uint_as_float(sw_[1]); } \
        _Pragma("unroll") for (int hf = 0; hf < 2; ++hf) { \
            _Pragma("unroll") for (int i8 = 0; i8 < 8; ++i8) { const int rl = crow(i8, hi); \
                st[rl * 64 + q] = (unsigned short)(cvtpk_s(OA[8 * hf + i8], 0.f) & 0xffffu); st[rl * 64 + 32 + q] = (unsigned short)(cvtpk_s(OB[8 * hf + i8], 0.f) & 0xffffu); } \
            _Pragma("unroll") for (int i2 = 0; i2 < 2; ++i2) { \
                const int pp = 2 * hf + i2, rl = 8 * i2 + (lane >> 3), ch = lane & 7, row = 16 * hf + rl; \
                const u32x4 ow = *(const __attribute__((address_space(3))) u32x4*)(st + rl * 64 + ch * 8); \
                float l = __shfl(LS, row); \
                const size_t t = ATT_EPI_T(QT, pp); \
                if (MODE == 1) { *(u32x4*)(D.po + t * 64 + ch * 8) = ow; if (ch == 0) D.pl[t] = l; } \
                else { \
                    float v[8]; \
                    _Pragma("unroll") for (int k = 0; k < 4; ++k) { v[2 * k] = __uint_as_float(ow[k] << 16); v[2 * k + 1] = __uint_as_float(ow[k] & 0xffff0000u); } \
                    if (MODE == 2) { \
                        l += LA[pp] + LB[pp]; \
                        _Pragma("unroll") for (int k = 0; k < 4; ++k) { v[2 * k] += __uint_as_float(A[pp][k] << 16) + __uint_as_float(B[pp][k] << 16); v[2 * k + 1] += __uint_as_float(A[pp][k] & 0xffff0000u) + __uint_as_float(B[pp][k] & 0xffff0000u); } \
                    } else l += (SINK); \
                    const float rl_ = 1.0f / l; \
                    u32x4 w; \
                    _Pragma("unroll") for (int k = 0; k < 4; ++k) { const float ga_ = __uint_as_float(G[pp][k] << 16), gb_ = __uint_as_float(G[pp][k] & 0xffff0000u); \
                        const float sa_ = ga_ * __builtin_amdgcn_rcpf(1.f + __builtin_amdgcn_exp2f(-1.4426950408889634f * ga_)), sb_ = gb_ * __builtin_amdgcn_rcpf(1.f + __builtin_amdgcn_exp2f(-1.4426950408889634f * gb_)); \
                        w[k] = cvtpk_s(v[2 * k] * rl_ * sa_, v[2 * k + 1] * rl_ * sb_); } \
                    *(u32x4*)((MIX) + t * 1024 + ch * 8) = w; \
                } \
            } \
        } } while (0)
    if (DRY != 0) {
        asm volatile("" :: "v"(o00), "v"(o01), "v"(o10), "v"(o11), "v"(ls0), "v"(ls1));
        if (has_next) prefetch<DRY>(N, ring0, qx, lane, 0);
    } else if (MODE == 1) {
        if (has_next) { if (!ext) prefetch(N, ring0, qx, lane, 0); else { const unsigned short* q0_ = N.Q0 + (size_t)(N.r + N.dil * (32 * N.qt0 + q)) * 64 + hi * 8; const unsigned short* q1_ = N.Q1 + (size_t)(N.r + N.dil * (32 * N.qt1 + q)) * 64 + hi * 8;
            _Pragma("unroll") for (int d0 = 0; d0 < 4; ++d0) { qx[0][d0] = *(const bf16x8*)(q0_ + d0 * 16); qx[1][d0] = *(const bf16x8*)(q1_ + d0 * 16); } } }
        ATT_EPI_PROC(D.qt0, o00, o01, ls0, g0, a0, b0, la0, lb0, D.mix0, D.sink0);
        ATT_EPI_PROC(D.qt1, o10, o11, ls1, g0, a0, b0, la0, lb0, D.mix1, D.sink1);
    } else {
        ATT_EPI_LOAD(D.qt0, g0, a0, b0, la0, lb0, D.gate0);
        __builtin_amdgcn_sched_barrier(0);
        ATT_EPI_TOUCH(g0, a0, b0, la0, lb0);
        __builtin_amdgcn_sched_barrier(0);
        ATT_EPI_PROC(D.qt0, o00, o01, ls0, g0, a0, b0, la0, lb0, D.mix0, D.sink0);
        __builtin_amdgcn_sched_barrier(0);
        ATT_EPI_LOAD(D.qt1, g0, a0, b0, la0, lb0, D.gate1);
        __builtin_amdgcn_sched_barrier(0);
        if (has_next) { if (!ext) prefetch(N, ring0, qx, lane, 0); else { const unsigned short* q0_ = N.Q0 + (size_t)(N.r + N.dil * (32 * N.qt0 + q)) * 64 + hi * 8; const unsigned short* q1_ = N.Q1 + (size_t)(N.r + N.dil * (32 * N.qt1 + q)) * 64 + hi * 8;
            _Pragma("unroll") for (int d0 = 0; d0 < 4; ++d0) { qx[0][d0] = *(const bf16x8*)(q0_ + d0 * 16); qx[1][d0] = *(const bf16x8*)(q1_ + d0 * 16); } } }
        __builtin_amdgcn_sched_barrier(0);
        ATT_EPI_TOUCH(g0, a0, b0, la0, lb0);
        __builtin_amdgcn_sched_barrier(0);
        ATT_EPI_PROC(D.qt1, o10, o11, ls1, g0, a0, b0, la0, lb0, D.mix1, D.sink1);
    }
#undef ATT_EPI_T
#undef ATT_EPI_LOAD
#undef ATT_EPI_TOUCH
#undef ATT_EPI_PROC
    }
    par = ext ? ((par + nt) & 1) : 0;
}
#undef ATT_DMA_K
#undef ATT_DMA_V
#undef ATT_WAITV
#undef ATT_GLDS
}
#ifndef PG8_SP2
#define PG8_SP2 true
#endif
#ifndef PG8_ALIGN
#define PG8_ALIGN true
#endif
constexpr int NWAVES = 8;
constexpr int BATCH = 8, SEQ = 4096, DM = 1024, M = BATCH * SEQ, NIN = 3328, HD = 64;
constexpr float LOG2E = 1.4426950408889634f;
constexpr size_t MiB = 1u << 20;
constexpr size_t WS_CTL = 0, CTL_ZERO_BYTES = 64 * 1024;
constexpr size_t WS_COS = 1 * MiB, WS_SIN = WS_COS + 512 * 1024;
constexpr size_t WS_WIT = 2 * MiB, WS_WOT = 9 * MiB;
constexpr size_t WS_XN = 16 * MiB;
constexpr size_t WS_QA = 80 * MiB, WS_QB = 112 * MiB, WS_KA = 144 * MiB, WS_VA = 152 * MiB, WS_KB = 160 * MiB, WS_VB = 192 * MiB;
constexpr size_t WS_GA = 224 * MiB, WS_GB = 256 * MiB, WS_MIX = 288 * MiB, WS_PO16 = 352 * MiB, WS_PO4 = 384 * MiB, WS_PL16 = 416 * MiB, WS_PL4 = 417 * MiB, WS_END = 418 * MiB;
constexpr int CW_BAR = 1024;
constexpr int RING_OFF = 0, RING_BYTES = 131072;
constexpr int LDSCTL_OFF = RING_BYTES + 16384, MISC_OFF = LDSCTL_OFF + 320;
constexpr int LDS_BYTES = 149504;
static_assert(MISC_OFF + 128 <= LDS_BYTES, "LDS map");
#define GAS __attribute__((address_space(1)))
#define LAS __attribute__((address_space(3)))
typedef unsigned short bf16;
typedef unsigned v4u __attribute__((ext_vector_type(4)));
typedef float f32x4 __attribute__((ext_vector_type(4)));
typedef short bf16x8 __attribute__((ext_vector_type(8)));
typedef GAS unsigned gu32;
typedef GAS unsigned long long gu64;
#define RLX_AGENT __ATOMIC_RELAXED, __HIP_MEMORY_SCOPE_AGENT
#define LDS_WAIT() asm volatile("s_waitcnt lgkmcnt(0)" ::: "memory")
#define VM_WAIT() asm volatile("s_waitcnt vmcnt(0)" ::: "memory")
__device__ __forceinline__ unsigned long long rt() { return __builtin_amdgcn_s_memrealtime(); }
__device__ __forceinline__ unsigned f2bf(float f) { unsigned u = __builtin_bit_cast(unsigned, f); return (u + 0x7fffu + ((u >> 16) & 1u)) >> 16; }
__device__ __forceinline__ unsigned pk2(float lo, float hi) { return f2bf(lo) | (f2bf(hi) << 16); }

#define XB_TMO      128
#define XB_XCNT(j)  (256  + 64 * (j))
#define XB_XSUB(j)  (1280 + 64 * (j))
#define XB_XGEN(j)  (2304 + 64 * (j))
#define XB_TOP      3328
#define XB_TOPGEN   3392
#define XCD_BAR_WORDS 3456
#define XB_SPIN_CAP (1u << 18)

__device__ __forceinline__ unsigned xb_ld(unsigned* p)              { return __hip_atomic_load(p, __ATOMIC_RELAXED, __HIP_MEMORY_SCOPE_AGENT); }
__device__ __forceinline__ unsigned xb_add(unsigned* p, unsigned v) { return __hip_atomic_fetch_add(p, v, __ATOMIC_RELAXED, __HIP_MEMORY_SCOPE_AGENT); }
__device__ __forceinline__ unsigned xb_xcc_id() { return (unsigned)__builtin_amdgcn_s_getreg((3 << 11) | 20) & 0xFu; }
#define XB_SPIN(cond, bar) do { unsigned _sp = 0; while (cond) { __builtin_amdgcn_s_sleep(1); \
    if ((++_sp & 255u) == 0u) { if (xb_ld(&(bar)[XB_TMO])) break; if (_sp > XB_SPIN_CAP) { atomicAdd(&(bar)[XB_TMO], 1u); break; } } } } while (0)

struct XcdBarrier {
    unsigned* bar; unsigned x;
    volatile LAS unsigned* st;
};

__device__ __forceinline__ XcdBarrier xcd_barrier_post(unsigned* bar, volatile LAS unsigned* st) {
    XcdBarrier b; b.bar = bar; b.x = xb_xcc_id(); b.st = st;
    if (threadIdx.x == 0) (void)xb_add(&bar[XB_XCNT(b.x)], 1u);
    return b;
}
__device__ __forceinline__ void xcd_barrier_complete(unsigned* bar, unsigned x, unsigned& nloc, unsigned& nx) {
    const unsigned G = gridDim.x * gridDim.y * gridDim.z;
    unsigned sum, cnt, mine, sp = 0u;
    for (;;) {
        sum = 0u; cnt = 0u; mine = 0u;
#pragma unroll
        for (unsigned j = 0; j < 16; ++j) { const unsigned c = xb_ld(&bar[XB_XCNT(j)]); sum += c; cnt += (c > 0u) ? 1u : 0u; mine = (j == x) ? c : mine; }
        if (sum == G) break;
        __builtin_amdgcn_s_sleep(1);
        if ((++sp & 255u) == 0u) { if (xb_ld(&bar[XB_TMO])) break; if (sp > XB_SPIN_CAP) { atomicAdd(&bar[XB_TMO], 1u); break; } }
    }
    nloc = mine > 0u ? mine : 1u; nx = cnt > 0u ? cnt : 1u;
}

__device__ __forceinline__ void xcd_barrier(const XcdBarrier& b) {
    asm volatile("s_waitcnt vmcnt(0)" ::: "memory");
    __syncthreads();
    if (threadIdx.x == 0) {
        unsigned* bar = b.bar;
        __builtin_amdgcn_s_waitcnt(0);
        unsigned nloc = b.st[0], nx = b.st[1];
        if (nloc == 0u) { xcd_barrier_complete(bar, b.x, nloc, nx); b.st[0] = nloc; b.st[1] = nx; }
        const unsigned old = xb_add(&bar[XB_XSUB(b.x)], 1u);
        const unsigned gen = old / nloc;
        if (old + 1u == (gen + 1u) * nloc) {
            __builtin_amdgcn_fence(__ATOMIC_RELEASE, "agent");
            asm volatile("s_waitcnt vmcnt(0)" ::: "memory");
            const unsigned og = xb_add(&bar[XB_TOP], 1u);
            const unsigned tg = og / nx;
            if (og + 1u == (tg + 1u) * nx) xb_add(&bar[XB_TOPGEN], 1u);
            else XB_SPIN(xb_ld(&bar[XB_TOPGEN]) == tg, bar);
            __builtin_amdgcn_fence(__ATOMIC_ACQUIRE, "agent");
            xb_add(&bar[XB_XGEN(b.x)], 1u);
            asm volatile("s_waitcnt vmcnt(0)" ::: "memory");
        } else {
            XB_SPIN(xb_ld(&bar[XB_XGEN(b.x)]) == gen, bar);
            __builtin_amdgcn_fence(__ATOMIC_ACQUIRE, "agent");
            asm volatile("s_waitcnt vmcnt(0)" ::: "memory");
        }
    }
    __syncthreads();
}
static_assert((CW_BAR + XCD_BAR_WORDS) * 4 <= (int)CTL_ZERO_BYTES, "barrier words inside the memset region");

struct Frame {
    LAS unsigned char* lds;
    volatile LAS unsigned* MISC;
    gu32* ctl;
    int tid, lane, wave;
    int vcu, G;
};
__device__ __forceinline__ float bf2f(bf16 b) { return __uint_as_float(((unsigned)b) << 16); }
__device__ __forceinline__ float wave_sum(float v) {
#pragma unroll
    for (int o = 1; o < 64; o <<= 1) v += __shfl_xor(v, o);
    return v;
}
__device__ __forceinline__ void sincos_d(float ang, float& s, float& c) {
    const double a = (double)ang;
    const double k = rint(a * 0.6366197723675814);
    double y = fma(-k, 1.5707963267948966, a);
    y = fma(-k, 6.123233995736766e-17, y);
    const double y2 = y * y;
    const double sp = y * (1.0 + y2 * (-1.0 / 6 + y2 * (1.0 / 120 + y2 * (-1.0 / 5040 + y2 * (1.0 / 362880 + y2 * (-1.0 / 39916800 + y2 * (1.0 / 6227020800.0)))))));
    const double cp = 1.0 + y2 * (-0.5 + y2 * (1.0 / 24 + y2 * (-1.0 / 720 + y2 * (1.0 / 40320 + y2 * (-1.0 / 3628800 + y2 * (1.0 / 479001600.0 + y2 * (-1.0 / 87178291200.0)))))));
    const int q = ((int)(long long)k) & 3;
    const double ss = (q == 0) ? sp : (q == 1) ? cp : (q == 2) ? -sp : -cp;
    const double cc = (q == 0) ? cp : (q == 1) ? -sp : (q == 2) ? -cp : sp;
    s = (float)ss; c = (float)cc;
}
__device__ __forceinline__ void p0_transpose_item(const float* W, int K, int N, bf16* WT, int k0, int n0, int d0, LAS float* scr, int lane) {
#pragma unroll 8
    for (int i = 0; i < 32; ++i) { const int kk = 2 * i + (lane >> 5); scr[kk * 33 + (lane & 31)] = __builtin_nontemporal_load(W + (size_t)(k0 + kk) * N + n0 + (lane & 31)); }
    LDS_WAIT(); asm volatile("" ::: "memory");
    const int c = lane & 7;
#pragma unroll
    for (int j = 0; j < 4; ++j) { const int n = (lane >> 3) + 8 * j; const LAS float* s = scr + (8 * c) * 33 + n;
        v4u o; o.x = pk2(s[0 * 33], s[1 * 33]); o.y = pk2(s[2 * 33], s[3 * 33]); o.z = pk2(s[4 * 33], s[5 * 33]); o.w = pk2(s[6 * 33], s[7 * 33]);
        *(GAS v4u*)(WT + (size_t)(d0 + n) * K + k0 + 8 * c) = o; }
    LDS_WAIT(); asm volatile("" ::: "memory");
}
struct Ptrs {
    const float *x, *gain, *w_in, *qna, *kna, *sinks, *qnb, *knb, *w_out; float* out;
    bf16 *WIT, *WOT, *XN, *QA, *KA, *VA, *GA, *QB, *KB, *VB, *GB, *MIX, *PO16, *PO4; float *cosT, *sinT, *PL16, *PL4;
};
__device__ __forceinline__ void p0_prologue(Frame& F, const Ptrs& P) {
    LAS float* scr = (LAS float*)(F.lds + RING_OFF + F.wave * 16384);
    const int gw = F.vcu * NWAVES + F.wave, NGW = F.G * NWAVES;
    constexpr int I_IN = (DM / 64) * (NIN / 32), I_OUT = (DM / 64) * (DM / 32);
    for (int it = gw; it < I_IN + I_OUT; it += NGW) {
        if (it < I_IN) { const int nblk = NIN / 32, kb = it / nblk, nb = it % nblk, n0 = 32 * nb;
            const int pn = n0 >> 8, rem = n0 & 255, wc = rem >> 6, bjj = (rem >> 5) & 1;
            p0_transpose_item(P.w_in, DM, NIN, P.WIT, 64 * kb, n0, 256 * pn + 128 * bjj + 32 * wc, scr, F.lane); }
        else { const int r = it - I_IN, nblk = DM / 32, kb = r / nblk, nb = r % nblk; p0_transpose_item(P.w_out, DM, DM, P.WOT, 64 * kb, 32 * nb, 32 * nb, scr, F.lane); }
    }
    for (int e = (F.vcu * NWAVES * 64) + F.tid; e < SEQ * 32; e += F.G * NWAVES * 64) {
        const int t = e >> 5, i = e & 31;
        double r = 1.0; for (int k = 0; k < i; ++k) r *= 0.7498942093324558;
        const float inv = (float)r; const float ang = (float)t * inv;
        float s, c; sincos_d(ang, s, c); P.cosT[e] = c; P.sinT[e] = s;
    }
    for (int m = gw; m < M; m += NGW) {
        const GAS f32x4* xr = (const GAS f32x4*)(P.x + (size_t)m * DM) + F.lane;
        f32x4 v[4]; float ss = 0.f;
#pragma unroll
        for (int j = 0; j < 4; ++j) { v[j] = __builtin_nontemporal_load(xr + 64 * j); ss += (v[j].x * v[j].x + v[j].y * v[j].y) + (v[j].z * v[j].z + v[j].w * v[j].w); }
        const float rstd = rsqrtf(wave_sum(ss) * (1.f / DM) + 1e-6f);
        GAS unsigned long long* o8 = (GAS unsigned long long*)(P.XN + (size_t)m * DM) + F.lane;
#pragma unroll
        for (int j = 0; j < 4; ++j) { const f32x4 g = ((const GAS f32x4*)P.gain)[64 * j + F.lane];
            o8[64 * j] = (unsigned long long)pk2(v[j].x * rstd * g.x, v[j].y * rstd * g.y) | ((unsigned long long)pk2(v[j].z * rstd * g.z, v[j].w * rstd * g.w) << 32); }
    }
}
constexpr int STAGE_OFF = RING_BYTES;
__device__ __forceinline__ att::Desc b_desc(const Ptrs& P, int uid, int mode, int wave, int k) {
    const int b = uid >> 5, h = (uid >> 2) & 7, blk = uid & 3; const size_t hb = (size_t)(b * 8 + h) * SEQ;
    att::Desc D{};
    D.Q0 = P.QB + hb * 64; D.Q1 = D.Q0; D.K = P.KB + hb * 64; D.V = P.VB + hb * 64;
    if (mode == 1) {
        if (wave < 4) { D.dil = 16; D.r = 4 * wave + k; D.qt0 = 2 * blk; D.po = P.PO16 + hb * 64; D.pl = P.PL16 + hb; }
        else { D.dil = 4; D.r = wave - 4; D.qt0 = 8 * blk + 2 * k; D.po = P.PO4 + hb * 64; D.pl = P.PL4 + hb; }
    } else {
        D.dil = 1; D.r = 0; D.qt0 = 32 * blk + 2 * (2 * wave + k);
        D.po_a = P.PO16 + hb * 64; D.po_b = P.PO4 + hb * 64; D.pl_a = P.PL16 + hb; D.pl_b = P.PL4 + hb;
        D.gate0 = P.GB + (size_t)b * SEQ * 512 + h * 64; D.gate1 = D.gate0; D.mix0 = P.MIX + (size_t)b * SEQ * DM + 512 + h * 64; D.mix1 = D.mix0;
    }
    D.qt1 = D.qt0 + 1;
    return D;
}
__device__ __forceinline__ att::Desc a_desc(const Ptrs& P, int b, int hp, int qt) {
    const int kv = hp >> 1, h0 = 2 * hp;
    att::Desc D{};
    D.Q0 = P.QA + (size_t)(b * 8 + h0) * SEQ * 64; D.Q1 = D.Q0 + (size_t)SEQ * 64;
    D.K = P.KA + (size_t)(b * 2 + kv) * SEQ * 64; D.V = P.VA + (size_t)(b * 2 + kv) * SEQ * 64;
    D.dil = 1; D.r = 0; D.qt0 = qt; D.qt1 = qt;
    D.gate0 = P.GA + (size_t)b * SEQ * 512 + h0 * 64; D.gate1 = D.gate0 + 64; D.mix0 = P.MIX + (size_t)b * SEQ * DM + h0 * 64; D.mix1 = D.mix0 + 64;
    D.sink0 = __builtin_amdgcn_exp2f(P.sinks[h0] * LOG2E); D.sink1 = __builtin_amdgcn_exp2f(P.sinks[h0 + 1] * LOG2E);
    return D;
}
#ifndef REP_2A
#define REP_2A 1
#define REP_2B 1
#define REP_2C 1
#endif
__device__ __forceinline__ void p2_attention(Frame& F, const Ptrs& P, const XcdBarrier& bar) {
    att::lds_ptr ring = (att::lds_ptr)(F.lds + RING_OFF + F.wave * 16384), stage = (att::lds_ptr)(F.lds + STAGE_OFF + F.wave * 2048);
    int lane_ = F.lane; asm volatile("" : "+v"(lane_));
    const int lane = lane_, wave = F.wave, uid = F.vcu;
    const unsigned ring0 = (unsigned)(uintptr_t)ring;
    att::bf16x8 qr[2][4];
    att::Desc D, N; int par = 0;
#ifdef DRY_PASS
    D = b_desc(P, uid, 1, wave, 0);
    att::prefetch<DRY_PASS>(D, ring0, qr, lane);
    for (int k = 0; k < 4; ++k) {
        N = b_desc(P, uid, 1, wave, (k + 1) & 3);
        att::attn_item<1, DRY_PASS>(ring, stage, D, k < 3, N, qr, par, lane); D = N;
    }
    asm volatile("s_waitcnt vmcnt(0) lgkmcnt(0)" ::: "memory");
#endif
#pragma unroll
    for (int rep = 0; rep < REP_2A; ++rep) {
    D = b_desc(P, uid, 1, wave, 0);
    par = 0; att::prefetch(D, ring0, qr, lane, 0);
    for (int k = 0; k < 4; ++k) {
        N = b_desc(P, uid, 1, wave, (k + 1) & 3);
        att::attn_item<1>(ring, stage, D, k < 3, N, qr, par, lane); D = N;
    }
    }
    asm volatile("s_waitcnt vmcnt(0) lgkmcnt(0)\n\ts_barrier" ::: "memory");
#pragma unroll
    for (int rep = 0; rep < REP_2B; ++rep) {
    D = b_desc(P, uid, 2, wave, 0);
    par = 0; att::prefetch(D, ring0, qr, lane, 0);
    for (int k = 0; k < 2; ++k) {
        N = b_desc(P, uid, 2, wave, 1);
        att::attn_item<2>(ring, stage, D, k < 1, N, qr, par, lane); D = N;
    }
    }
#pragma unroll
    for (int rep = 0; rep < REP_2C; ++rep) {
    {
        const int aid0 = uid * 16 + wave * 2;
        D = a_desc(P, aid0 >> 9, (aid0 >> 7) & 3, aid0 & 127);
        par = 0; att::prefetch(D, ring0, qr, lane, 0);
        for (int k = 0; k < 2; ++k) {
            N = a_desc(P, aid0 >> 9, (aid0 >> 7) & 3, (aid0 & 127) + 1);
            att::attn_item<0>(ring, stage, D, k < 1, N, qr, par, lane); D = N;
        }
    }
    }
}

struct Args { const float* in[9]; float* out; unsigned char* ws; };
__global__ void __launch_bounds__(NWAVES * 64, 2) mega_fwd(Args args) {
    extern __shared__ __attribute__((aligned(16))) unsigned char lds[];
    Frame F;
    F.lds = (LAS unsigned char*)lds;
    F.MISC = (volatile LAS unsigned*)(F.lds + MISC_OFF);
    F.tid = threadIdx.x; F.lane = F.tid & 63; F.wave = __builtin_amdgcn_readfirstlane(F.tid >> 6);
    F.G = gridDim.x; { const int bx = blockIdx.x; F.vcu = (F.G % 8 == 0) ? (bx % 8) * (F.G / 8) + bx / 8 : bx; }
    unsigned char* ws = args.ws;
    F.ctl = (gu32*)(ws + WS_CTL);
    Ptrs P;
    P.x = args.in[0]; P.gain = args.in[1]; P.w_in = args.in[2]; P.qna = args.in[3]; P.kna = args.in[4]; P.sinks = args.in[5]; P.qnb = args.in[6]; P.knb = args.in[7]; P.w_out = args.in[8]; P.out = args.out;
    P.WIT = (bf16*)(ws + WS_WIT); P.WOT = (bf16*)(ws + WS_WOT); P.XN = (bf16*)(ws + WS_XN);
    P.QA = (bf16*)(ws + WS_QA); P.KA = (bf16*)(ws + WS_KA); P.VA = (bf16*)(ws + WS_VA); P.GA = (bf16*)(ws + WS_GA);
    P.QB = (bf16*)(ws + WS_QB); P.KB = (bf16*)(ws + WS_KB); P.VB = (bf16*)(ws + WS_VB); P.GB = (bf16*)(ws + WS_GB); P.MIX = (bf16*)(ws + WS_MIX);
    P.cosT = (float*)(ws + WS_COS); P.sinT = (float*)(ws + WS_SIN);
    P.PO16 = (bf16*)(ws + WS_PO16); P.PO4 = (bf16*)(ws + WS_PO4); P.PL16 = (float*)(ws + WS_PL16); P.PL4 = (float*)(ws + WS_PL4);
    for (int u = F.tid; u < (LDS_BYTES - LDSCTL_OFF) / 4; u += NWAVES * 64) ((LAS unsigned*)(F.lds + LDSCTL_OFF))[u] = 0u;
    __syncthreads();
    XcdBarrier bar = xcd_barrier_post((unsigned*)(F.ctl + CW_BAR), F.MISC + 8);

#ifndef PROBE_TS
#define PROBE_TS 0
#endif
    unsigned long long ts0 = 0, ts1 = 0, ts2 = 0, ts3 = 0, ts4 = 0;
    if (PROBE_TS) ts0 = rt();
#ifndef REP_P0
#define REP_P0 1
#define REP_P1 1
#define REP_P2 1
#define REP_P3 1
#endif
#pragma unroll
    for (int rep = 0; rep < REP_P0; ++rep) {
    p0_prologue(F, P);
    xcd_barrier(bar);
    }
    if (PROBE_TS) ts1 = rt();
#pragma unroll
    for (int rep = 0; rep < REP_P1; ++rep) {
#ifdef STAGGER_US
        if ((int)blockIdx.x >= F.G / 2) { const unsigned long long t0_ = rt(); while (rt() - t0_ < (unsigned long long)(STAGGER_US * 100)) __builtin_amdgcn_s_sleep(8); }
#endif
        pg8::Gemm g{P.XN, P.WIT, M, NIN, DM}; pg8::StaticOrder S; S.init(M, NIN, F.G, (int)blockIdx.x);
        pg8::EpiIn E{P.QA, P.KA, P.VA, P.GA, P.QB, P.KB, P.VB, P.GB, P.qna, P.kna, P.qnb, P.knb, P.cosT, P.sinT};
        pg8::gemm_phase<pg8::EpiIn, pg8::StaticOrder, PG8_ALIGN, PG8_SP2>(F.lds + RING_OFF, g, S, E);
    xcd_barrier(bar);
    }
    if (PROBE_TS) ts2 = rt();
#ifdef DRY_GEMM
    {
        pg8::Gemm g{P.XN, P.WIT, M, NIN, DM};
#if DRY_GEMM == 1
        pg8::StaticOrder S; S.init(M, NIN, F.G, (int)blockIdx.x); pg8::EpiNone E{};
        pg8::gemm_phase<pg8::EpiNone, pg8::StaticOrder, PG8_ALIGN, PG8_SP2>(F.lds + RING_OFF, g, S, E);
#elif DRY_GEMM == 3
        pg8::StaticOrder S; S.init(M, NIN, F.G, (int)blockIdx.x);
        pg8::EpiInT<true> E{P.QA, P.KA, P.VA, P.GA, P.QB, P.KB, P.VB, P.GB, P.qna, P.kna, P.qnb, P.knb, P.cosT, P.sinT};
        pg8::gemm_phase<pg8::EpiInT<true>, pg8::StaticOrder, PG8_ALIGN, PG8_SP2>(F.lds + RING_OFF, g, S, E);
#else
        pg8::SameTileOrder S; S.init(M, NIN, F.G, (int)blockIdx.x); pg8::EpiNone E{};
        pg8::gemm_phase<pg8::EpiNone, pg8::SameTileOrder, PG8_ALIGN, PG8_SP2>(F.lds + RING_OFF, g, S, E);
#endif
        xcd_barrier(bar);
    }
#endif
#pragma unroll
    for (int rep = 0; rep < REP_P2; ++rep) {
    p2_attention(F, P, bar);
    xcd_barrier(bar);
    }
    if (PROBE_TS) ts3 = rt();
#pragma unroll
    for (int rep = 0; rep < REP_P3; ++rep) {
        pg8::Gemm g{P.MIX, P.WOT, M, DM, DM}; pg8::StaticOrder S; S.init(M, DM, F.G, (int)blockIdx.x);
        pg8::EpiRes E{P.x, P.out};
        pg8::gemm_phase<pg8::EpiRes, pg8::StaticOrder, PG8_ALIGN, PG8_SP2>(F.lds + RING_OFF, g, S, E);
    }
    if (PROBE_TS) {
        ts4 = rt();
        if (blockIdx.x == 0 && F.tid == 0) {
            const float dA = (PROBE_TS == 1) ? (float)(ts2 - ts1) * 0.01f : (float)(ts1 - ts0) * 0.01f;
            const float dB = (PROBE_TS == 1) ? (float)(ts3 - ts2) * 0.01f : (float)(ts4 - ts3) * 0.01f;
            asm volatile("s_waitcnt vmcnt(0)" ::: "memory");
            P.out[0] += dA; P.out[1] += dB;
        }
    }
}

extern "C" void kernel_launch(void* const* d_in, const int* in_sizes, int n_in, void* d_out, int out_size, void* d_ws, size_t ws_size, hipStream_t stream) {
    static int grid = 0;
    if (grid == 0) {
        if (n_in != 9 || out_size != M * DM || ws_size < WS_END) { fprintf(stderr, "kernel_launch: unexpected shapes (n_in %d, out %d, ws %zu); nothing launched\n", n_in, out_size, ws_size); grid = -1; return; }
        int dev = 0, cus = 0;
        if (hipGetDevice(&dev) != hipSuccess || hipDeviceGetAttribute(&cus, hipDeviceAttributeMultiprocessorCount, dev) != hipSuccess) { grid = -1; return; }
        if (hipFuncSetAttribute((const void*)mega_fwd, hipFuncAttributeMaxDynamicSharedMemorySize, LDS_BYTES) != hipSuccess) { fprintf(stderr, "kernel_launch: hipFuncSetAttribute failed\n"); grid = -1; return; }
        (void)hipGetLastError();
        grid = cus;
    }
    if (grid < 0) return;
#ifdef EXTRA_MEMSET
    (void)hipMemsetAsync((char*)d_ws + WS_CTL + 512 * 1024, 0, CTL_ZERO_BYTES, stream);
#endif
    if (hipMemsetAsync((char*)d_ws + WS_CTL, 0, CTL_ZERO_BYTES, stream) != hipSuccess) { fprintf(stderr, "kernel_launch: hipMemsetAsync failed\n"); return; }
    Args a{};
    for (int i = 0; i < 9; ++i) a.in[i] = (const float*)d_in[i];
    a.out = (float*)d_out; a.ws = (unsigned char*)d_ws;
    hipLaunchKernelGGL(mega_fwd, dim3(grid), dim3(NWAVES * 64), LDS_BYTES, stream, a);
}
```

```cpp
#include <hip/hip_runtime.h>
#include <cstdio>
#include <cstdint>
#include <cmath>
#define KSWZ 1
namespace pg8 {
#define PG8_LAS __attribute__((address_space(3)))
typedef unsigned short bf16_t;
typedef short bf16x8 __attribute__((ext_vector_type(8)));
typedef float f32x4 __attribute__((ext_vector_type(4)));
typedef unsigned u32x4 __attribute__((ext_vector_type(4)));
constexpr int BM = 256, BK = 64, HALF = 128, HTB = HALF * BK * 2  , STAGE_BYTES = 8 * HTB, NXCD = 8, WGM = 8;

__host__ __device__ __forceinline__ int lds_byte(int r, int c) { const int st = (r >> 4) * 2 + (c >> 5), rr = r & 15, cc = c & 31, ob = rr * 64 + cc * 2; return st * 1024 + (ob ^ (((ob >> 9) & 1) << 5)); }
__host__ __device__ __forceinline__ void stage_rc(int b, int& R, int& C) { const int st = b / 1024, sb = b % 1024, swz = sb ^ (((sb >> 9) & 1) << 5); R = (st >> 1) * 16 + swz / 64; C = (st & 1) * 32 + (swz % 64) / 2; }
__host__ __device__ __forceinline__ int perm32(int rho) { const int n = rho >> 4, i = rho & 15; return 8 * (i >> 2) + 4 * n + (i & 3); }

struct Unit { int pm, pn; };
struct Gemm { const bf16_t* A; const bf16_t* Bt; int M, N, K; };

struct StaticOrder {
    int nM, nN, nwg, G, c;
    __host__ __device__ void init(int M, int N, int G_, int c_) { nM = M / BM; nN = N / BM; nwg = nM * nN; G = G_; c = c_; }
    __host__ __device__ bool next(int i, Unit& u) const {
        const long L = (long)i * G + c; if (L >= nwg) return false;
        int wgid = (int)L; { const int q = nwg / NXCD, r = nwg % NXCD, xcd = wgid % NXCD, off = wgid / NXCD; wgid = (xcd < r ? xcd * (q + 1) : r * (q + 1) + (xcd - r) * q) + off; }
        const int nig = WGM * nN, gid = wgid / nig, fm = gid * WGM, gsz = (nM - fm) < WGM ? (nM - fm) : WGM;
        u.pm = fm + ((wgid % nig) % gsz); u.pn = (wgid % nig) / gsz; return true;
    }
    __device__ __forceinline__ void a_ready(const Unit&) const {}
    __device__ __forceinline__ void done(const Unit&) const {}
};
__device__ __forceinline__ unsigned cvt_pk_bf16(float lo, float hi) { unsigned r; asm volatile("v_cvt_pk_bf16_f32 %0, %1, %2" : "=v"(r) : "v"(lo), "v"(hi)); return r; }
typedef float f32x2 __attribute__((ext_vector_type(2)));
typedef float f32x2 __attribute__((ext_vector_type(2)));
constexpr int SEQ_ = 4096;
constexpr float C2_ = 0.18033688011112042f, LOG2E_ = 1.4426950408889634f;
__device__ __forceinline__ u32x4 pack8(const f32x4& a, const f32x4& b) { u32x4 w; w.x = cvt_pk_bf16(a[0], a[1]); w.y = cvt_pk_bf16(a[2], a[3]); w.z = cvt_pk_bf16(b[0], b[1]); w.w = cvt_pk_bf16(b[2], b[3]); return w; }
__device__ __forceinline__ void store_row_pair(bf16_t* rowp, size_t pitch, int fr, u32x4 w0, u32x4 w1) {
    const bool odd = fr & 1;
    const u32x4 snd = odd ? w0 : w1;
    u32x4 rcv;
#pragma unroll
    for (int k = 0; k < 4; ++k) rcv[k] = (unsigned)__shfl_xor((int)snd[k], 1);
    const u32x4 A = odd ? rcv : w0, B = odd ? w1 : rcv;
    bf16_t* pa = odd ? rowp - pitch + 32 : rowp;
    bf16_t* pb = odd ? rowp + 32 : rowp + pitch;
    *(u32x4*)pa = A; *(u32x4*)pb = B;
}
template <bool NOSTORE = false> struct EpiInT {
    static constexpr bool PERM = true, AFTER_DRAIN = false, REPME = true; static constexpr int NSTORE = 16;
    bf16_t *QA, *KA, *VA, *GA, *QB, *KB, *VB, *GB;
    const float *qna, *kna, *qnb, *knb, *cosT, *sinT;
    __device__ __forceinline__ void init(f32x4 (&acc)[2][2][4][2], const Unit&, int, int, int, int) const {
#pragma unroll
        for (int a = 0; a < 2; ++a)
#pragma unroll
            for (int b = 0; b < 2; ++b)
#pragma unroll
                for (int m = 0; m < 4; ++m)
#pragma unroll
                    for (int n = 0; n < 2; ++n) acc[a][b][m][n] = (f32x4){0.f, 0.f, 0.f, 0.f};
    }
    __device__ __forceinline__ void operator()(const f32x4 (&acc)[2][2][4][2], const Unit& u, int wr, int wc, int fr, int fq) const {
        const int g = u.pn * 4 + wc;
        int type, head, H = 8; const float* ng = qna; bf16_t* dst; float scale = 1.f;
        if (g < 8) { type = 0; head = g; ng = qna; dst = QA; scale = C2_; }
        else if (g < 10) { type = 0; head = g - 8; ng = kna; dst = KA; H = 2; }
        else if (g < 12) { type = 1; head = g - 10; dst = VA; H = 2; }
        else if (g < 20) { type = 2; head = g - 12; dst = GA; }
        else if (g < 28) { type = 0; head = g - 20; ng = qnb; dst = QB; scale = C2_; }
        else if (g < 36) { type = 0; head = g - 28; ng = knb; dst = KB; }
        else if (g < 44) { type = 1; head = g - 36; dst = VB; }
        else { type = 2; head = g - 44; dst = GB; }
        const int row0 = u.pm * BM + wr * 64 + fr;
        if (type == 0) {
            f32x4 gv[2][2], c16[2], s16[2], cb[2][2], sb[2][2];
            const int tb = (row0 & (SEQ_ - 1));
#pragma unroll
            for (int n = 0; n < 2; ++n) {
                c16[n] = *(const f32x4*)(cosT + 16 * 32 + 8 * fq + 4 * n); s16[n] = *(const f32x4*)(sinT + 16 * 32 + 8 * fq + 4 * n);
#pragma unroll
                for (int ai = 0; ai < 2; ++ai) { cb[ai][n] = *(const f32x4*)(cosT + (tb + ai * HALF) * 32 + 8 * fq + 4 * n); sb[ai][n] = *(const f32x4*)(sinT + (tb + ai * HALF) * 32 + 8 * fq + 4 * n); }
#pragma unroll
                for (int bj = 0; bj < 2; ++bj) gv[bj][n] = *(const f32x4*)(ng + 32 * bj + 8 * fq + 4 * n);
            }
#pragma unroll
            for (int ai = 0; ai < 2; ++ai) {
                f32x4 cs[2] = {cb[ai][0], cb[ai][1]}, sn[2] = {sb[ai][0], sb[ai][1]};
#pragma unroll
                for (int m = 0; m < 4; ++m) {
                    const int row = row0 + ai * HALF + m * 16, b = row >> 12, t = row & (SEQ_ - 1);
                    float ss = 0.f;
#pragma unroll
                    for (int bj = 0; bj < 2; ++bj)
#pragma unroll
                        for (int n = 0; n < 2; ++n) { const f32x4 x = acc[ai][bj][m][n]; ss += (x[0] * x[0] + x[1] * x[1]) + (x[2] * x[2] + x[3] * x[3]); }
                    ss += __shfl_xor(ss, 16); ss += __shfl_xor(ss, 32);
                    const float rs = rsqrtf(ss * (1.f / 64.f) + 1e-6f) * scale;
                    f32x4 o1[2], o2[2];
#pragma unroll
                    for (int n = 0; n < 2; ++n) {
                        const f32x4 n1 = acc[ai][0][m][n] * rs * gv[0][n], n2 = acc[ai][1][m][n] * rs * gv[1][n];
                        o1[n] = n1 * cs[n] - n2 * sn[n]; o2[n] = n2 * cs[n] + n1 * sn[n];
                        const f32x4 cn = cs[n] * c16[n] - sn[n] * s16[n], sn2 = sn[n] * c16[n] + cs[n] * s16[n];
                        cs[n] = cn; sn[n] = sn2;
                    }
                    bf16_t* p = dst + ((size_t)(b * H + head) * SEQ_ + t) * 64 + 8 * fq;
                    { const u32x4 w0_ = pack8(o1[0], o1[1]), w1_ = pack8(o2[0], o2[1]); if (NOSTORE) { asm volatile("" :: "v"(w0_), "v"(w1_)); } else { *(u32x4*)p = w0_; *(u32x4*)(p + 32) = w1_; } }
                }
            }
        } else if (type == 1) {
#pragma unroll
            for (int ai = 0; ai < 2; ++ai)
#pragma unroll
                for (int m = 0; m < 4; ++m) {
                    const int row = row0 + ai * HALF + m * 16, b = row >> 12, t = row & (SEQ_ - 1);
                    bf16_t* p = dst + ((size_t)(b * H + head) * SEQ_ + t) * 64 + 8 * fq;
                    { const u32x4 w0_ = pack8(acc[ai][0][m][0], acc[ai][0][m][1]), w1_ = pack8(acc[ai][1][m][0], acc[ai][1][m][1]); if (NOSTORE) { asm volatile("" :: "v"(w0_), "v"(w1_)); } else { *(u32x4*)p = w0_; *(u32x4*)(p + 32) = w1_; } }
                }
        } else {
#pragma unroll
            for (int ai = 0; ai < 2; ++ai)
#pragma unroll
                for (int m = 0; m < 4; ++m) {
                    const int row = row0 + ai * HALF + m * 16;
                    bf16_t* p = dst + (size_t)row * 512 + head * 64 + 8 * fq;
                    u32x4 wq[2];
#pragma unroll
                    for (int bj = 0; bj < 2; ++bj) {
                        f32x4 s[2];
#pragma unroll
                        for (int n = 0; n < 2; ++n) { const f32x4 v = acc[ai][bj][m][n];
#pragma unroll
                            for (int e = 0; e < 4; ++e) s[n][e] = v[e]; }
                        wq[bj] = pack8(s[0], s[1]);
                    }
                    { const u32x4 w0_ = wq[0], w1_ = wq[1]; if (NOSTORE) { asm volatile("" :: "v"(w0_), "v"(w1_)); } else { *(u32x4*)p = w0_; *(u32x4*)(p + 32) = w1_; } }
                }
        }
    }
};
typedef EpiInT<false> EpiIn;
struct EpiRes {
    static constexpr bool PERM = true, AFTER_DRAIN = false, REPME = false; static constexpr int NSTORE = 32;
    const float* x; float* out;
    __device__ __forceinline__ void init(f32x4 (&acc)[2][2][4][2], const Unit&, int, int, int, int) const {
#pragma unroll
        for (int a = 0; a < 2; ++a)
#pragma unroll
            for (int b = 0; b < 2; ++b)
#pragma unroll
                for (int m = 0; m < 4; ++m)
#pragma unroll
                    for (int n = 0; n < 2; ++n) acc[a][b][m][n] = (f32x4){0.f, 0.f, 0.f, 0.f};
    }
    __device__ __forceinline__ void operator()(const f32x4 (&acc)[2][2][4][2], const Unit& u, int wr, int wc, int fr, int fq) const {
        const int row0 = u.pm * BM + wr * 64 + fr, col0 = u.pn * BM + wc * 32 + 8 * fq;
#pragma unroll
        for (int ai = 0; ai < 2; ++ai) {
            f32x4 xr[4][2][2];
#pragma unroll
            for (int m = 0; m < 4; ++m) {
                const size_t off = (size_t)(row0 + ai * HALF + m * 16) * 1024 + col0;
#pragma unroll
                for (int bj = 0; bj < 2; ++bj) { xr[m][bj][0] = *(const f32x4*)(x + off + bj * HALF); xr[m][bj][1] = *(const f32x4*)(x + off + bj * HALF + 4); }
            }
            asm volatile("" ::: "memory");
#pragma unroll
            for (int m = 0; m < 4; ++m) {
                const size_t off = (size_t)(row0 + ai * HALF + m * 16) * 1024 + col0;
#pragma unroll
                for (int bj = 0; bj < 2; ++bj) { *(f32x4*)(out + off + bj * HALF) = xr[m][bj][0] + acc[ai][bj][m][0]; *(f32x4*)(out + off + bj * HALF + 4) = xr[m][bj][1] + acc[ai][bj][m][1]; }
            }
            asm volatile("" ::: "memory");
        }
    }
};
struct EpiNone {
    static constexpr bool PERM = true, AFTER_DRAIN = false, REPME = false; static constexpr int NSTORE = 0;
    __device__ __forceinline__ void init(f32x4 (&acc)[2][2][4][2], const Unit&, int, int, int, int) const {
#pragma unroll
        for (int a = 0; a < 2; ++a)
#pragma unroll
            for (int b = 0; b < 2; ++b)
#pragma unroll
                for (int m = 0; m < 4; ++m)
#pragma unroll
                    for (int n = 0; n < 2; ++n) acc[a][b][m][n] = (f32x4){0.f, 0.f, 0.f, 0.f};
    }
    __device__ __forceinline__ void operator()(const f32x4 (&acc)[2][2][4][2], const Unit&, int, int, int, int) const {
#pragma unroll
        for (int a = 0; a < 2; ++a)
#pragma unroll
            for (int b = 0; b < 2; ++b)
#pragma unroll
                for (int m = 0; m < 4; ++m)
#pragma unroll
                    for (int n = 0; n < 2; ++n) asm volatile("" :: "v"(acc[a][b][m][n]));
    }
};
struct SameTileOrder : StaticOrder {
    __host__ __device__ bool next(int i, Unit& u) const { if (!StaticOrder::next(i, u)) return false; u.pm = 0; u.pn = 0; return true; }
};
template <class Epi, class Sched, bool ALIGN_EPI = false, bool SP2 = false>
__device__ __forceinline__ void gemm_phase(PG8_LAS unsigned char* lds, const Gemm g, const Sched& S, const Epi& E) {
    int tid_ = threadIdx.x; asm volatile("" : "+v"(tid_));
    const int tid = tid_, wid = __builtin_amdgcn_readfirstlane(tid >> 6), lane = tid & 63, wr = wid >> 2, wc = wid & 3, fr = lane & 15, fq = lane >> 4;
    const int K = g.K, nt = K / BK;
    unsigned voffA[2], voffB[2];
#pragma unroll
    for (int i = 0; i < 2; ++i) { int R, C; stage_rc(tid * 16 + i * 8192, R, C); const int Rb = Epi::PERM ? ((R & ~31) + perm32(R & 31)) : R;
        voffA[i] = (unsigned)(R * K + C) * 2u; voffB[i] = (unsigned)(Rb * K + C) * 2u; }
    const size_t kstep = (size_t)(BK * 2);
    const size_t hstep = (size_t)HALF * K * 2;
    const size_t tstep = 2 * hstep;
    const unsigned ldsw = (unsigned)wid * 1024u;
    const int aoff = lds_byte(wr * 64 + fr, fq * 8), boff = lds_byte(wc * 32 + fr, fq * 8);
#define PG8_SA(b, h) (((b) * 2 + (h)) * HTB)
#define PG8_SB(b, h) ((4 + (b) * 2 + (h)) * HTB)
#define PG8_STAGE(bufoff, gbase, voff) do { _Pragma("unroll") for (int _i = 0; _i < 2; ++_i) \
        __builtin_amdgcn_global_load_lds((const unsigned*)((const char*)(gbase) + (voff)[_i]), (PG8_LAS unsigned*)(lds + (bufoff) + ldsw + _i * 8192), 16, 0, 0); } while (0)
#define PG8_LDA(dst, b, h) do { _Pragma("unroll") for (int m = 0; m < 4; ++m) _Pragma("unroll") for (int k = 0; k < 2; ++k) dst[m][k] = *(const PG8_LAS bf16x8*)(lds + PG8_SA(b, h) + aoff + m * 2048 + k * 1024); } while (0)
#define PG8_LDB(dst, b, h) do { _Pragma("unroll") for (int n = 0; n < 2; ++n) _Pragma("unroll") for (int k = 0; k < 2; ++k) dst[n][k] = *(const PG8_LAS bf16x8*)(lds + PG8_SB(b, h) + boff + n * 2048 + k * 1024); } while (0)
#define PG8_MMA(ai, bj, At, Bt) do { __builtin_amdgcn_s_setprio(1); _Pragma("unroll") for (int m = 0; m < 4; ++m) _Pragma("unroll") for (int n = 0; n < 2; ++n) _Pragma("unroll") for (int k = 0; k < 2; ++k) \
        acc[ai][bj][m][n] = __builtin_amdgcn_mfma_f32_16x16x32_bf16(Bt[n][k], At[m][k], acc[ai][bj][m][n], 0, 0, 0); __builtin_amdgcn_s_setprio(0); } while (0)
#define PG8_WAIT_V(n) asm volatile("s_waitcnt vmcnt(" #n ")" ::: "memory")
#define PG8_WAIT_V8S() do { if (Epi::NSTORE == 16) PG8_WAIT_V(24); else if (Epi::NSTORE == 32) PG8_WAIT_V(40); else PG8_WAIT_V(8); } while (0)
#define PG8_WAIT_L(n) asm volatile("s_waitcnt lgkmcnt(" #n ")" ::: "memory")
#define PG8_BAR __builtin_amdgcn_s_barrier()
#define PG8_SCHED __builtin_amdgcn_sched_barrier(0)
    Unit cur, nxt; int ui = 0;
    if (!S.next(0, cur)) return;
    f32x4 acc[2][2][4][2];
    E.init(acc, cur, wr, wc, fr, fq);
    bf16x8 At[4][2], B0[2][2], B1[2][2];
    const char* cA = (const char*)g.A + (size_t)cur.pm * tstep; const char* cB = (const char*)g.Bt + (size_t)cur.pn * tstep;
    S.a_ready(cur);
    if constexpr (SP2) {
        PG8_STAGE(PG8_SB(0, 0), cB, voffB); PG8_STAGE(PG8_SB(0, 1), cB + hstep, voffB); PG8_STAGE(PG8_SA(0, 0), cA, voffA); PG8_STAGE(PG8_SA(0, 1), cA + hstep, voffA);
        if (wr == 1) PG8_BAR;
        PG8_WAIT_V(2); PG8_BAR;
        PG8_STAGE(PG8_SB(1, 0), cB + kstep, voffB); PG8_STAGE(PG8_SA(1, 0), cA + kstep, voffA); PG8_STAGE(PG8_SB(1, 1), cB + hstep + kstep, voffB);
        PG8_WAIT_V(6); PG8_BAR;
    } else {
        PG8_STAGE(PG8_SB(0, 0), cB, voffB); PG8_STAGE(PG8_SA(0, 0), cA, voffA); PG8_STAGE(PG8_SB(0, 1), cB + hstep, voffB); PG8_STAGE(PG8_SA(0, 1), cA + hstep, voffA);
        if (wr == 1) PG8_BAR;
        PG8_WAIT_V(4); PG8_BAR;
        PG8_STAGE(PG8_SB(1, 0), cB + kstep, voffB); PG8_STAGE(PG8_SA(1, 0), cA + kstep, voffA); PG8_STAGE(PG8_SB(1, 1), cB + hstep + kstep, voffB);
        PG8_WAIT_V(6); PG8_BAR;
    }
    for (;;) {
        const bool has_next = S.next(ui + 1, nxt);
        const char* nA = has_next ? (const char*)g.A + (size_t)nxt.pm * tstep : cA; const char* nB = has_next ? (const char*)g.Bt + (size_t)nxt.pn * tstep : cB;
        for (int t = 0; t < nt; t += 2) {
            const bool last = (t == nt - 2);
            const char* a1 = cA + (size_t)(t + 1) * kstep;
            const char* a2 = last ? nA : cA + (size_t)(t + 2) * kstep; const char* b2 = last ? nB : cB + (size_t)(t + 2) * kstep;
            const char* a3 = a2 + kstep; const char* b3 = b2 + kstep;
            if (last && has_next) S.a_ready(nxt);
            if constexpr (SP2) {
            PG8_LDB(B0, 0, 0); PG8_LDB(B1, 0, 1); PG8_SCHED; PG8_LDA(At, 0, 0); PG8_STAGE(PG8_SA(1, 1), a1 + hstep, voffA);
            PG8_WAIT_V(8); PG8_WAIT_L(0); PG8_BAR; PG8_MMA(0, 0, At, B0); PG8_MMA(0, 1, At, B1); PG8_BAR; PG8_SCHED;
            PG8_LDA(At, 0, 1); PG8_STAGE(PG8_SB(0, 0), b2, voffB); PG8_STAGE(PG8_SB(0, 1), b2 + hstep, voffB); PG8_STAGE(PG8_SA(0, 0), a2, voffA);
            PG8_WAIT_V(8); PG8_WAIT_L(0); PG8_BAR; PG8_MMA(1, 0, At, B0); PG8_MMA(1, 1, At, B1); PG8_BAR; PG8_SCHED;
            PG8_LDB(B0, 1, 0); PG8_LDB(B1, 1, 1); PG8_SCHED; PG8_LDA(At, 1, 0); PG8_STAGE(PG8_SA(0, 1), a2 + hstep, voffA);
            PG8_WAIT_V(8); PG8_WAIT_L(0); PG8_BAR; PG8_MMA(0, 0, At, B0); PG8_MMA(0, 1, At, B1); PG8_BAR; PG8_SCHED;
            PG8_LDA(At, 1, 1); PG8_STAGE(PG8_SB(1, 0), b3, voffB); PG8_STAGE(PG8_SB(1, 1), b3 + hstep, voffB); PG8_STAGE(PG8_SA(1, 0), a3, voffA);
            PG8_WAIT_V(8); PG8_WAIT_L(0); PG8_BAR; PG8_MMA(1, 0, At, B0); PG8_MMA(1, 1, At, B1); PG8_BAR; PG8_SCHED;
            } else {
            PG8_LDB(B0, 0, 0); PG8_SCHED; PG8_LDA(At, 0, 0); PG8_STAGE(PG8_SA(1, 1), a1 + hstep, voffA);
            PG8_WAIT_L(8); PG8_BAR; PG8_WAIT_L(0); PG8_MMA(0, 0, At, B0); PG8_BAR; PG8_SCHED;
            PG8_LDB(B1, 0, 1); PG8_STAGE(PG8_SB(0, 0), b2, voffB);
            PG8_BAR; PG8_WAIT_L(0); PG8_MMA(0, 1, At, B1); PG8_BAR;
            PG8_LDA(At, 0, 1); PG8_STAGE(PG8_SA(0, 0), a2, voffA);
            PG8_BAR; PG8_WAIT_L(0); PG8_MMA(1, 0, At, B0); PG8_BAR; PG8_SCHED;
            PG8_STAGE(PG8_SB(0, 1), b2 + hstep, voffB);
            PG8_WAIT_V(6); PG8_BAR; PG8_MMA(1, 1, At, B1); PG8_BAR;
            PG8_LDB(B0, 1, 0); PG8_SCHED; PG8_LDA(At, 1, 0); PG8_STAGE(PG8_SA(0, 1), a2 + hstep, voffA);
            PG8_WAIT_L(8); PG8_BAR; PG8_WAIT_L(0); PG8_MMA(0, 0, At, B0); PG8_BAR; PG8_SCHED;
            PG8_LDB(B1, 1, 1); PG8_STAGE(PG8_SB(1, 0), b3, voffB);
            PG8_BAR; PG8_WAIT_L(0); PG8_MMA(0, 1, At, B1); PG8_BAR;
            PG8_LDA(At, 1, 1); PG8_STAGE(PG8_SA(1, 0), a3, voffA);
            PG8_BAR; PG8_WAIT_L(0); PG8_MMA(1, 0, At, B0); PG8_BAR; PG8_SCHED;
            PG8_STAGE(PG8_SB(1, 1), b3 + hstep, voffB);
            PG8_WAIT_V(6); PG8_BAR; PG8_MMA(1, 1, At, B1); PG8_BAR;
            }
        }
        if constexpr (ALIGN_EPI) { if (wr == 0) PG8_BAR; }
        if constexpr (!Epi::AFTER_DRAIN) { E(acc, cur, wr, wc, fr, fq); S.done(cur); }
        if (!has_next) break;
        E.init(acc, nxt, wr, wc, fr, fq);
        cur = nxt; cA = nA; cB = nB; ++ui;
        if constexpr (ALIGN_EPI) { if (wr == 1) PG8_BAR; }
    }
    PG8_WAIT_V(0);
    if constexpr (!ALIGN_EPI) { if (wr == 0) PG8_BAR; }
    PG8_BAR;
    if constexpr (Epi::AFTER_DRAIN) { E.fused(acc, cur, wr, wc, fr, fq, lds, wid, lane); S.done(cur); }
#undef PG8_SA
#undef PG8_SB
#undef PG8_STAGE
#undef PG8_LDA
#undef PG8_LDB
#undef PG8_MMA
#undef PG8_WAIT_V
#undef PG8_WAIT_V8S
#undef PG8_WAIT_L
#undef PG8_BAR
#undef PG8_SCHED
}
}
namespace att {
#ifndef KSWZ
#define KSWZ 0
#endif
typedef short bf16x8 __attribute__((ext_vector_type(8)));
typedef short s16x4 __attribute__((ext_vector_type(4)));
typedef short v4i16_t __attribute__((ext_vector_type(4)));
typedef float f32x16 __attribute__((ext_vector_type(16)));
typedef float f32x4 __attribute__((ext_vector_type(4)));
typedef unsigned u32x4 __attribute__((ext_vector_type(4)));
typedef float f32x2_t __attribute__((ext_vector_type(2))); typedef __bf16 bf16x2_t __attribute__((ext_vector_type(2)));
typedef __attribute__((address_space(3))) unsigned char* lds_ptr;
__device__ __forceinline__ unsigned cvtpk_s(float lo, float hi) { f32x2_t v = {lo, hi}; bf16x2_t b = __builtin_convertvector(v, bf16x2_t); return __builtin_bit_cast(unsigned, b); }
__device__ __forceinline__ int crow(int r, int hi) { return (r & 3) + 8 * (r >> 2) + 4 * hi; }
__device__ __forceinline__ s16x4 vtr(lds_ptr p) { return __builtin_bit_cast(s16x4, __builtin_amdgcn_ds_read_tr16_b64_v4i16((__attribute__((address_space(3))) v4i16_t*)p)); }
#define ATT_WAITV(n) asm volatile("s_waitcnt vmcnt(" #n ")" ::: "memory")
__device__ __forceinline__ void glds16(const void* gsrc, unsigned lds_dst) { unsigned keep;
    asm volatile("s_mov_b32 %0, m0\n\ts_mov_b32 m0, %2\n\ts_nop 0\n\tglobal_load_lds_dwordx4 %1, off\n\ts_mov_b32 m0, %0" : "=&s"(keep) : "v"(gsrc), "s"(lds_dst) : "memory"); }
#define ATT_GLDS(src, dst) glds16((src), (unsigned)__builtin_amdgcn_readfirstlane((int)(dst)))

struct Desc {
    const unsigned short *Q0, *Q1, *K, *V;
    int dil, r, qt0, qt1;
    unsigned short* po; float* pl;
    const unsigned short *po_a, *po_b; const float *pl_a, *pl_b;
    const unsigned short *gate0, *gate1; unsigned short *mix0, *mix1;
    float sink0, sink1;
};
struct LaneK { unsigned koff[4], voff[4]; };
__device__ __forceinline__ LaneK lane_offsets(int dil, int lane) {
    LaneK L;
#pragma unroll
    for (int i = 0; i < 4; ++i) {
        const int row = 8 * i + (lane >> 3), chunk = (lane & 7) ^ (KSWZ ? ((row >> 1) & 7) : 0);
        L.koff[i] = (unsigned)(dil * row) * 128u + (unsigned)chunk * 16u;
        const int vchunk = (lane & 7) ^ (4 * ((row >> 1) & 1));
        L.voff[i] = (unsigned)(dil * row) * 128u + (unsigned)vchunk * 16u;
    }
    return L;
}
#define ATT_DMA_K(D, L, ktlo, j, sl) do { const char* s_ = (const char*)(D).K + (size_t)(D).r * 128 + (size_t)((ktlo) + (j)) * ((size_t)(D).dil * 4096); const unsigned d_ = ring0 + ((sl) & 1) * 8192; \
        ATT_GLDS(s_ + (L).koff[0], d_); ATT_GLDS(s_ + (L).koff[1], d_ + 1024); ATT_GLDS(s_ + (L).koff[2], d_ + 2048); ATT_GLDS(s_ + (L).koff[3], d_ + 3072); } while (0)
#define ATT_DMA_V(D, L, ktlo, j, sl) do { const char* s_ = (const char*)(D).V + (size_t)(D).r * 128 + (size_t)((ktlo) + (j)) * ((size_t)(D).dil * 4096); const unsigned d_ = ring0 + ((sl) & 1) * 8192 + 4096; \
        ATT_GLDS(s_ + (L).voff[0], d_); ATT_GLDS(s_ + (L).voff[1], d_ + 1024); ATT_GLDS(s_ + (L).voff[2], d_ + 2048); ATT_GLDS(s_ + (L).voff[3], d_ + 3072); } while (0)
template <int DRY = 0>
__device__ __forceinline__ void prefetch(const Desc& D, unsigned ring0, bf16x8 (&qr)[2][4], int lane, int par = 0) {
    const int q = lane & 31, hi = lane >> 5;
    const int ktlo = D.qt0 >= 4 ? D.qt0 - 4 : 0, nt = D.qt1 - ktlo + 1;
    const LaneK L = lane_offsets(D.dil, lane);
    { const unsigned short* q0 = D.Q0 + (size_t)(D.r + D.dil * (32 * D.qt0 + q)) * 64 + hi * 8; const unsigned short* q1 = D.Q1 + (size_t)(D.r + D.dil * (32 * D.qt1 + q)) * 64 + hi * 8;
#pragma unroll
      for (int d0 = 0; d0 < 4; ++d0) { qr[0][d0] = *(const bf16x8*)(q0 + d0 * 16); qr[1][d0] = *(const bf16x8*)(q1 + d0 * 16); } }
    asm volatile("s_waitcnt lgkmcnt(0)" ::: "memory");
    if (DRY != 2) { ATT_DMA_K(D, L, ktlo, 0, par); ATT_DMA_V(D, L, ktlo, 0, par);
    if (nt > 1) { ATT_DMA_K(D, L, ktlo, 1, par + 1); ATT_DMA_V(D, L, ktlo, 1, par + 1); }
    if (DRY == 3) { if (nt > 2) { ATT_DMA_K(D, L, ktlo, 2, par); ATT_DMA_V(D, L, ktlo, 2, par); } if (nt > 3) { ATT_DMA_K(D, L, ktlo, 3, par + 1); ATT_DMA_V(D, L, ktlo, 3, par + 1); } } }
}
template <int MODE, int DRY = 0>
__device__ __forceinline__ void attn_item(lds_ptr ring, lds_ptr stage, const Desc& D, bool has_next, const Desc& N, bf16x8 (&qx)[2][4], int& par, int lane) {
    const int q = lane & 31, hi = lane >> 5;
    const int ktlo = D.qt0 >= 4 ? D.qt0 - 4 : 0, nt = D.qt1 - ktlo + 1;
    constexpr int DMIN = (MODE == 0) ? 1 : 0;
    const unsigned ring0 = (unsigned)(uintptr_t)ring;
    const LaneK L = lane_offsets(D.dil, lane);
    const int krow = q * 128, ksw = KSWZ ? ((q >> 1) & 7) : 0;
    const int vsw = ((lane & 15) >> 3) & 1;
    const int vb = ((lane >> 4) & 1) * 32 + (lane & 3) * 8 + (4 * hi + ((lane & 15) >> 2)) * 128;
    f32x16 o00 = {}, o01 = {}, o10 = {}, o11 = {}; float ls0 = 0.f, ls1 = 0.f;
    asm volatile("s_waitcnt vmcnt(0)" ::: "memory");
    bf16x8 qr[2][4];
#pragma unroll
    for (int s_ = 0; s_ < 2; ++s_)
#pragma unroll
        for (int d0 = 0; d0 < 4; ++d0) qr[s_][d0] = qx[s_][d0];
    asm volatile("" : "+v"(qr[0][0]), "+v"(qr[0][1]), "+v"(qr[0][2]), "+v"(qr[0][3]), "+v"(qr[1][0]), "+v"(qr[1][1]), "+v"(qr[1][2]), "+v"(qr[1][3]));
    const int Nktlo = N.qt0 >= 4 ? N.qt0 - 4 : 0, Nnt = N.qt1 - Nktlo + 1;
    const bool ext = (DRY == 0) && has_next && nt >= 2 && N.dil == D.dil;
    const int nx = ext ? (Nnt < 2 ? Nnt : 2) : 0;
    for (int j = 0; j < nt; ++j) {
        const int e = nt - 1 - j + nx, kt = ktlo + j; lds_ptr slot = ring + ((j + par) & 1) * 8192;
        const bool act0 = (kt <= D.qt0), act1 = (kt >= D.qt1 - 4);
        if (DRY == 3) { if (e >= 3) ATT_WAITV(28); else if (e == 2) ATT_WAITV(20); else if (e == 1) ATT_WAITV(12); else ATT_WAITV(4); }
        else if (DRY != 2) { if (e >= 1) ATT_WAITV(12); else ATT_WAITV(4); }
        bf16x8 kf[4];
        if (DRY != 1 && DRY != 3) {
#pragma unroll
        for (int ks = 0; ks < 4; ++ks) kf[ks] = *(const __attribute__((address_space(3))) bf16x8*)(slot + krow + (((2 * ks + hi) ^ ksw) * 16));
        asm volatile("s_waitcnt lgkmcnt(0)" ::: "memory");
        asm volatile("" : "+v"(kf[0]), "+v"(kf[1]), "+v"(kf[2]), "+v"(kf[3]));
        }
        if (DRY == 3) { if (e >= 4) ATT_DMA_K(D, L, ktlo, j + 4, j + par); }
        else if (DRY != 2 && e >= 2) { if (j + 2 < nt) ATT_DMA_K(D, L, ktlo, j + 2, j + par); else ATT_DMA_K(N, L, Nktlo, j + 2 - nt, j + par); }
        u32x4 pa0 = {}, pa1 = {}, pb0 = {}, pb1 = {};
#define ATT_SCORE(S, QT, ACT, LS, PW0, PW1) if (ACT) { f32x16 p = {}; \
            _Pragma("unroll") for (int ks = 0; ks < 4; ++ks) p = __builtin_amdgcn_mfma_f32_32x32x16_bf16(kf[ks], qr[S][ks], p, 0, 0, 0); \
            const bool first = (kt == (QT) - 4), last = (kt == (QT)); \
            if (first || last) { _Pragma("unroll") for (int rr = 0; rr < 16; ++rr) { const int kk = crow(rr, hi); const bool bad = (first && kk < q + DMIN) || (last && kk > q); if (bad) p[rr] = -INFINITY; } } \
            float s_ = 0.f; \
            _Pragma("unroll") for (int rr = 0; rr < 16; ++rr) { p[rr] = __builtin_amdgcn_exp2f(p[rr]); s_ += p[rr]; } \
            LS += s_; \
            PW0[0] = cvtpk_s(p[0], p[1]); PW0[1] = cvtpk_s(p[2], p[3]); PW0[2] = cvtpk_s(p[4], p[5]); PW0[3] = cvtpk_s(p[6], p[7]); \
            PW1[0] = cvtpk_s(p[8], p[9]); PW1[1] = cvtpk_s(p[10], p[11]); PW1[2] = cvtpk_s(p[12], p[13]); PW1[3] = cvtpk_s(p[14], p[15]); }
        if (DRY != 1 && DRY != 3) {
        ATT_SCORE(0, D.qt0, act0, ls0, pa0, pa1)
        ATT_SCORE(1, D.qt1, act1, ls1, pb0, pb1)
        }
#undef ATT_SCORE
        if (DRY == 3) { if (e >= 4) ATT_WAITV(28); else if (e == 3) ATT_WAITV(24); else if (e == 2) ATT_WAITV(16); else if (e == 1) ATT_WAITV(8); else ATT_WAITV(0); }
        else if (DRY != 2) { if (e >= 2) ATT_WAITV(12); else if (e == 1) ATT_WAITV(8); else ATT_WAITV(0); }
        if (DRY != 1 && DRY != 3) {
        lds_ptr vp = slot + 4096 + vb;
        s16x4 lo[4], hh[4];
#pragma unroll
        for (int i = 0; i < 4; ++i) { const int o_ = (i & 1) * 2048 + (((i >> 1) ^ vsw) * 64); lo[i] = vtr(vp + o_); hh[i] = vtr(vp + o_ + 1024); }
#define ATT_VFR(i) (bf16x8){lo[i][0], lo[i][1], lo[i][2], lo[i][3], hh[i][0], hh[i][1], hh[i][2], hh[i][3]}
        if (act0) {
            o00 = __builtin_amdgcn_mfma_f32_32x32x16_bf16(__builtin_bit_cast(bf16x8, pa0), ATT_VFR(0), o00, 0, 0, 0);
            o00 = __builtin_amdgcn_mfma_f32_32x32x16_bf16(__builtin_bit_cast(bf16x8, pa1), ATT_VFR(1), o00, 0, 0, 0);
            o01 = __builtin_amdgcn_mfma_f32_32x32x16_bf16(__builtin_bit_cast(bf16x8, pa0), ATT_VFR(2), o01, 0, 0, 0);
            o01 = __builtin_amdgcn_mfma_f32_32x32x16_bf16(__builtin_bit_cast(bf16x8, pa1), ATT_VFR(3), o01, 0, 0, 0);
        }
        if (act1) {
            o10 = __builtin_amdgcn_mfma_f32_32x32x16_bf16(__builtin_bit_cast(bf16x8, pb0), ATT_VFR(0), o10, 0, 0, 0);
            o10 = __builtin_amdgcn_mfma_f32_32x32x16_bf16(__builtin_bit_cast(bf16x8, pb1), ATT_VFR(1), o10, 0, 0, 0);
            o11 = __builtin_amdgcn_mfma_f32_32x32x16_bf16(__builtin_bit_cast(bf16x8, pb0), ATT_VFR(2), o11, 0, 0, 0);
            o11 = __builtin_amdgcn_mfma_f32_32x32x16_bf16(__builtin_bit_cast(bf16x8, pb1), ATT_VFR(3), o11, 0, 0, 0);
        }
#undef ATT_VFR
        }
        asm volatile("s_waitcnt lgkmcnt(0)" ::: "memory");
        if (DRY == 3) { if (e >= 4) ATT_DMA_V(D, L, ktlo, j + 4, j + par); }
        else if (DRY != 2 && e >= 2) { if (j + 2 < nt) ATT_DMA_V(D, L, ktlo, j + 2, j + par); else ATT_DMA_V(N, L, Nktlo, j + 2 - nt, j + par); }
    }
    int lane_s = lane; asm volatile("" : "+v"(lane_s));
    {
    const int lane = lane_s, q = lane & 31, hi = lane >> 5;
    __attribute__((address_space(3))) unsigned short* st = (__attribute__((address_space(3))) unsigned short*)stage;
    u32x4 g0[4], a0[4], b0[4]; float la0[4], lb0[4];
#define ATT_EPI_T(QT, pp) ((size_t)(D.r + D.dil * (32 * (QT) + 16 * ((pp) >> 1) + 8 * ((pp) & 1) + (lane >> 3))))
#define ATT_EPI_LOAD(QT, G, A, B, LA, LB, GATE) do { _Pragma("unroll") for (int pp = 0; pp < 4; ++pp) { const size_t t = ATT_EPI_T(QT, pp); const int ch = lane & 7; \
        G[pp] = *(const u32x4*)((GATE) + t * 512 + ch * 8); \
        if (MODE == 2) { A[pp] = __builtin_nontemporal_load((const u32x4*)(D.po_a + t * 64 + ch * 8)); B[pp] = __builtin_nontemporal_load((const u32x4*)(D.po_b + t * 64 + ch * 8)); \
                         LA[pp] = __builtin_nontemporal_load(D.pl_a + t); LB[pp] = __builtin_nontemporal_load(D.pl_b + t); } } } while (0)
#define ATT_EPI_TOUCH(G, A, B, LA, LB) do { asm volatile("" : "+v"(G[0]), "+v"(G[1]), "+v"(G[2]), "+v"(G[3])); \
        if (MODE == 2) { asm volatile("" : "+v"(A[0]), "+v"(A[1]), "+v"(A[2]), "+v"(A[3]), "+v"(B[0]), "+v"(B[1]), "+v"(B[2]), "+v"(B[3])); \
                         asm volatile("" : "+v"(LA[0]), "+v"(LA[1]), "+v"(LA[2]), "+v"(LA[3]), "+v"(LB[0]), "+v"(LB[1]), "+v"(LB[2]), "+v"(LB[3])); } } while (0)
#define ATT_EPI_PROC(QT, OA, OB, LS, G, A, B, LA, LB, MIX, SINK) do { \
        { auto sw_ = __builtin_amdgcn_permlane32_swap(__float_as_uint(LS), __float_as_uint(LS), false, false); LS = __uint_as_float(sw_[0]) + __uint_as_float(sw_[1]); } \
        _Pragma("unroll") for (int hf = 0; hf < 2; ++hf) { \
            _Pragma("unroll") for (int i8 = 0; i8 < 8; ++i8) { const int rl = crow(i8, hi); \
                st[rl * 64 + q] = (unsigned short)(cvtpk_s(OA[8 * hf + i8], 0.f) & 0xffffu); st[rl * 64 + 32 + q] = (unsigned short)(cvtpk_s(OB[8 * hf + i8], 0.f) & 0xffffu); } \
            _Pragma("unroll") for (int i2 = 0; i2 < 2; ++i2) { \
                const int pp = 2 * hf + i2, rl = 8 * i2 + (lane >> 3), ch = lane & 7, row = 16 * hf + rl; \
                const u32x4 ow = *(const __attribute__((address_space(3))) u32x4*)(st + rl * 64 + ch * 8); \
                float l = __shfl(LS, row); \
                const size_t t = ATT_EPI_T(QT, pp); \
                if (MODE == 1) { *(u32x4*)(D.po + t * 64 + ch * 8) = ow; if (ch == 0) D.pl[t] = l; } \
                else { \
                    float v[8]; \
                    _Pragma("unroll") for (int k = 0; k < 4; ++k) { v[2 * k] = __uint_as_float(ow[k] << 16); v[2 * k + 1] = __uint_as_float(ow[k] & 0xffff0000u); } \
                    if (MODE == 2) { \
                        l += LA[pp] + LB[pp]; \
                        _Pragma("unroll") for (int k = 0; k < 4; ++k) { v[2 * k] += __uint_as_float(A[pp][k] << 16) + __uint_as_float(B[pp][k] << 16); v[2 * k + 1] += __uint_as_float(A[pp][k] & 0xffff0000u) + __uint_as_float(B[pp][k] & 0xffff0000u); } \
                    } else l += (SINK); \
                    const float rl_ = 1.0f / l; \
                    u32x4 w; \
                    _Pragma("unroll") for (int k = 0; k < 4; ++k) { const float ga_ = __uint_as_float(G[pp][k] << 16), gb_ = __uint_as_float(G[pp][k] & 0xffff0000u); \
                        const float sa_ = ga_ * __builtin_amdgcn_rcpf(1.f + __builtin_amdgcn_exp2f(-1.4426950408889634f * ga_)), sb_ = gb_ * __builtin_amdgcn_rcpf(1.f + __builtin_amdgcn_exp2f(-1.4426950408889634f * gb_)); \
                        w[k] = cvtpk_s(v[2 * k] * rl_ * sa_, v[2 * k + 1] * rl_ * sb_); } \
                    *(u32x4*)((MIX) + t * 1024 + ch * 8) = w; \
                } \
            } \
        } } while (0)
    if (DRY != 0) {
        asm volatile("" :: "v"(o00), "v"(o01), "v"(o10), "v"(o11), "v"(ls0), "v"(ls1));
        if (has_next) prefetch<DRY>(N, ring0, qx, lane, 0);
    } else if (MODE == 1) {
        if (has_next) { if (!ext) prefetch(N, ring0, qx, lane, 0); else { const unsigned short* q0_ = N.Q0 + (size_t)(N.r + N.dil * (32 * N.qt0 + q)) * 64 + hi * 8; const unsigned short* q1_ = N.Q1 + (size_t)(N.r + N.dil * (32 * N.qt1 + q)) * 64 + hi * 8;
            _Pragma("unroll") for (int d0 = 0; d0 < 4; ++d0) { qx[0][d0] = *(const bf16x8*)(q0_ + d0 * 16); qx[1][d0] = *(const bf16x8*)(q1_ + d0 * 16); } } }
        ATT_EPI_PROC(D.qt0, o00, o01, ls0, g0, a0, b0, la0, lb0, D.mix0, D.sink0);
        ATT_EPI_PROC(D.qt1, o10, o11, ls1, g0, a0, b0, la0, lb0, D.mix1, D.sink1);
    } else {
        ATT_EPI_LOAD(D.qt0, g0, a0, b0, la0, lb0, D.gate0);
        __builtin_amdgcn_sched_barrier(0);
        ATT_EPI_TOUCH(g0, a0, b0, la0, lb0);
        __builtin_amdgcn_sched_barrier(0);
        ATT_EPI_PROC(D.qt0, o00, o01, ls0, g0, a0, b0, la0, lb0, D.mix0, D.sink0);
        __builtin_amdgcn_sched_barrier(0);
        ATT_EPI_LOAD(D.qt1, g0, a0, b0, la0, lb0, D.gate1);
        __builtin_amdgcn_sched_barrier(0);
        if (has_next) { if (!ext) prefetch(N, ring0, qx, lane, 0); else { const unsigned short* q0_ = N.Q0 + (size_t)(N.r + N.dil * (32 * N.qt0 + q)) * 64 + hi * 8; const unsigned short* q1_ = N.Q1 + (size_t)(N.r + N.dil * (32 * N.qt1 + q)) * 64 + hi * 8;
            _Pragma("unroll") for (int d0 = 0; d0 < 4; ++d0) { qx[0][d0] = *(const bf16x8*)(q0_ + d0 * 16); qx[1][d0] = *(const bf16x8*)(q1_ + d0 * 16); } } }
        __builtin_amdgcn_sched_barrier(0);
        ATT_EPI_TOUCH(g0, a0, b0, la0, lb0);
        __builtin_amdgcn_sched_barrier(0);
        ATT_EPI_PROC(D.qt1, o10, o11, ls1, g0, a0, b0, la0, lb0, D.mix1, D.sink1);
    }
#undef ATT_EPI_T
#undef ATT_EPI_LOAD
#undef ATT_EPI_TOUCH
#undef ATT_EPI_PROC
    }
    par = ext ? ((par + nt) & 1) : 0;
}
#undef ATT_DMA_K
#undef ATT_DMA_V
#undef ATT_WAITV
#undef ATT_GLDS
}
#ifndef PG8_SP2
#define PG8_SP2 true
#endif
#ifndef PG8_ALIGN
#define PG8_ALIGN true
#endif
constexpr int NWAVES = 8;
constexpr int BATCH = 8, SEQ = 4096, DM = 1024, M = BATCH * SEQ, NIN = 3328, HD = 64;
constexpr float LOG2E = 1.4426950408889634f;
constexpr size_t MiB = 1u << 20;
constexpr size_t WS_CTL = 0, CTL_ZERO_BYTES = 64 * 1024;
constexpr size_t WS_COS = 1 * MiB, WS_SIN = WS_COS + 512 * 1024;
constexpr size_t WS_WIT = 2 * MiB, WS_WOT = 9 * MiB;
constexpr size_t WS_XN = 16 * MiB;
constexpr size_t WS_QA = 80 * MiB, WS_QB = 112 * MiB, WS_KA = 144 * MiB, WS_VA = 152 * MiB, WS_KB = 160 * MiB, WS_VB = 192 * MiB;
constexpr size_t WS_GA = 224 * MiB, WS_GB = 256 * MiB, WS_MIX = 288 * MiB, WS_PO16 = 352 * MiB, WS_PO4 = 384 * MiB, WS_PL16 = 416 * MiB, WS_PL4 = 417 * MiB, WS_END = 418 * MiB;
constexpr int CW_BAR = 1024;
constexpr int RING_OFF = 0, RING_BYTES = 131072;
constexpr int LDSCTL_OFF = RING_BYTES + 16384, MISC_OFF = LDSCTL_OFF + 320;
constexpr int LDS_BYTES = 149504;
static_assert(MISC_OFF + 128 <= LDS_BYTES, "LDS map");
#define GAS __attribute__((address_space(1)))
#define LAS __attribute__((address_space(3)))
typedef unsigned short bf16;
typedef unsigned v4u __attribute__((ext_vector_type(4)));
typedef float f32x4 __attribute__((ext_vector_type(4)));
typedef short bf16x8 __attribute__((ext_vector_type(8)));
typedef GAS unsigned gu32;
typedef GAS unsigned long long gu64;
#define RLX_AGENT __ATOMIC_RELAXED, __HIP_MEMORY_SCOPE_AGENT
#define LDS_WAIT() asm volatile("s_waitcnt lgkmcnt(0)" ::: "memory")
#define VM_WAIT() asm volatile("s_waitcnt vmcnt(0)" ::: "memory")
__device__ __forceinline__ unsigned long long rt() { return __builtin_amdgcn_s_memrealtime(); }
__device__ __forceinline__ unsigned f2bf(float f) { unsigned u = __builtin_bit_cast(unsigned, f); return (u + 0x7fffu + ((u >> 16) & 1u)) >> 16; }
__device__ __forceinline__ unsigned pk2(float lo, float hi) { return f2bf(lo) | (f2bf(hi) << 16); }

#define XB_TMO      128
#define XB_XCNT(j)  (256  + 64 * (j))
#define XB_XSUB(j)  (1280 + 64 * (j))
#define XB_XGEN(j)  (2304 + 64 * (j))
#define XB_TOP      3328
#define XB_TOPGEN   3392
#define XCD_BAR_WORDS 3456
#define XB_SPIN_CAP (1u << 18)

__device__ __forceinline__ unsigned xb_ld(unsigned* p)              { return __hip_atomic_load(p, __ATOMIC_RELAXED, __HIP_MEMORY_SCOPE_AGENT); }
__device__ __forceinline__ unsigned xb_add(unsigned* p, unsigned v) { return __hip_atomic_fetch_add(p, v, __ATOMIC_RELAXED, __HIP_MEMORY_SCOPE_AGENT); }
__device__ __forceinline__ unsigned xb_xcc_id() { return (unsigned)__builtin_amdgcn_s_getreg((3 << 11) | 20) & 0xFu; }
#define XB_SPIN(cond, bar) do { unsigned _sp = 0; while (cond) { __builtin_amdgcn_s_sleep(1); \
    if ((++_sp & 255u) == 0u) { if (xb_ld(&(bar)[XB_TMO])) break; if (_sp > XB_SPIN_CAP) { atomicAdd(&(bar)[XB_TMO], 1u); break; } } } } while (0)

struct XcdBarrier {
    unsigned* bar; unsigned x;
    volatile LAS unsigned* st;
};

__device__ __forceinline__ XcdBarrier xcd_barrier_post(unsigned* bar, volatile LAS unsigned* st) {
    XcdBarrier b; b.bar = bar; b.x = xb_xcc_id(); b.st = st;
    if (threadIdx.x == 0) (void)xb_add(&bar[XB_XCNT(b.x)], 1u);
    return b;
}
__device__ __forceinline__ void xcd_barrier_complete(unsigned* bar, unsigned x, unsigned& nloc, unsigned& nx) {
    const unsigned G = gridDim.x * gridDim.y * gridDim.z;
    unsigned sum, cnt, mine, sp = 0u;
    for (;;) {
        sum = 0u; cnt = 0u; mine = 0u;
#pragma unroll
        for (unsigned j = 0; j < 16; ++j) { const unsigned c = xb_ld(&bar[XB_XCNT(j)]); sum += c; cnt += (c > 0u) ? 1u : 0u; mine = (j == x) ? c : mine; }
        if (sum == G) break;
        __builtin_amdgcn_s_sleep(1);
        if ((++sp & 255u) == 0u) { if (xb_ld(&bar[XB_TMO])) break; if (sp > XB_SPIN_CAP) { atomicAdd(&bar[XB_TMO], 1u); break; } }
    }
    nloc = mine > 0u ? mine : 1u; nx = cnt > 0u ? cnt : 1u;
}

__device__ __forceinline__ void xcd_barrier(const XcdBarrier& b) {
    asm volatile("s_waitcnt vmcnt(0)" ::: "memory");
    __syncthreads();
    if (threadIdx.x == 0) {
        unsigned* bar = b.bar;
        __builtin_amdgcn_s_waitcnt(0);
        unsigned nloc = b.st[0], nx = b.st[1];
        if (nloc == 0u) { xcd_barrier_complete(bar, b.x, nloc, nx); b.st[0] = nloc; b.st[1] = nx; }
        const unsigned old = xb_add(&bar[XB_XSUB(b.x)], 1u);
        const unsigned gen = old / nloc;
        if (old + 1u == (gen + 1u) * nloc) {
            __builtin_amdgcn_fence(__ATOMIC_RELEASE, "agent");
            asm volatile("s_waitcnt vmcnt(0)" ::: "memory");
            const unsigned og = xb_add(&bar[XB_TOP], 1u);
            const unsigned tg = og / nx;
            if (og + 1u == (tg + 1u) * nx) xb_add(&bar[XB_TOPGEN], 1u);
            else XB_SPIN(xb_ld(&bar[XB_TOPGEN]) == tg, bar);
            __builtin_amdgcn_fence(__ATOMIC_ACQUIRE, "agent");
            xb_add(&bar[XB_XGEN(b.x)], 1u);
            asm volatile("s_waitcnt vmcnt(0)" ::: "memory");
        } else {
            XB_SPIN(xb_ld(&bar[XB_XGEN(b.x)]) == gen, bar);
            __builtin_amdgcn_fence(__ATOMIC_ACQUIRE, "agent");
            asm volatile("s_waitcnt vmcnt(0)" ::: "memory");
        }
    }
    __syncthreads();
}
static_assert((CW_BAR + XCD_BAR_WORDS) * 4 <= (int)CTL_ZERO_BYTES, "barrier words inside the memset region");

struct Frame {
    LAS unsigned char* lds;
    volatile LAS unsigned* MISC;
    gu32* ctl;
    int tid, lane, wave;
    int vcu, G;
};
__device__ __forceinline__ float bf2f(bf16 b) { return __uint_as_float(((unsigned)b) << 16); }
__device__ __forceinline__ float wave_sum(float v) {
#pragma unroll
    for (int o = 1; o < 64; o <<= 1) v += __shfl_xor(v, o);
    return v;
}
__device__ __forceinline__ void sincos_d(float ang, float& s, float& c) {
    const double a = (double)ang;
    const double k = rint(a * 0.6366197723675814);
    double y = fma(-k, 1.5707963267948966, a);
    y = fma(-k, 6.123233995736766e-17, y);
    const double y2 = y * y;
    const double sp = y * (1.0 + y2 * (-1.0 / 6 + y2 * (1.0 / 120 + y2 * (-1.0 / 5040 + y2 * (1.0 / 362880 + y2 * (-1.0 / 39916800 + y2 * (1.0 / 6227020800.0)))))));
    const double cp = 1.0 + y2 * (-0.5 + y2 * (1.0 / 24 + y2 * (-1.0 / 720 + y2 * (1.0 / 40320 + y2 * (-1.0 / 3628800 + y2 * (1.0 / 479001600.0 + y2 * (-1.0 / 87178291200.0)))))));
    const int q = ((int)(long long)k) & 3;
    const double ss = (q == 0) ? sp : (q == 1) ? cp : (q == 2) ? -sp : -cp;
    const double cc = (q == 0) ? cp : (q == 1) ? -sp : (q == 2) ? -cp : sp;
    s = (float)ss; c = (float)cc;
}
__device__ __forceinline__ void p0_transpose_item(const float* W, int K, int N, bf16* WT, int k0, int n0, int d0, LAS float* scr, int lane) {
#pragma unroll 8
    for (int i = 0; i < 32; ++i) { const int kk = 2 * i + (lane >> 5); scr[kk * 33 + (lane & 31)] = __builtin_nontemporal_load(W + (size_t)(k0 + kk) * N + n0 + (lane & 31)); }
    LDS_WAIT(); asm volatile("" ::: "memory");
    const int c = lane & 7;
#pragma unroll
    for (int j = 0; j < 4; ++j) { const int n = (lane >> 3) + 8 * j; const LAS float* s = scr + (8 * c) * 33 + n;
        v4u o; o.x = pk2(s[0 * 33], s[1 * 33]); o.y = pk2(s[2 * 33], s[3 * 33]); o.z = pk2(s[4 * 33], s[5 * 33]); o.w = pk2(s[6 * 33], s[7 * 33]);
        *(GAS v4u*)(WT + (size_t)(d0 + n) * K + k0 + 8 * c) = o; }
    LDS_WAIT(); asm volatile("" ::: "memory");
}
struct Ptrs {
    const float *x, *gain, *w_in, *qna, *kna, *sinks, *qnb, *knb, *w_out; float* out;
    bf16 *WIT, *WOT, *XN, *QA, *KA, *VA, *GA, *QB, *KB, *VB, *GB, *MIX, *PO16, *PO4; float *cosT, *sinT, *PL16, *PL4;
};
__device__ __forceinline__ void p0_prologue(Frame& F, const Ptrs& P) {
    LAS float* scr = (LAS float*)(F.lds + RING_OFF + F.wave * 16384);
    const int gw = F.vcu * NWAVES + F.wave, NGW = F.G * NWAVES;
    constexpr int I_IN = (DM / 64) * (NIN / 32), I_OUT = (DM / 64) * (DM / 32);
    for (int it = gw; it < I_IN + I_OUT; it += NGW) {
        if (it < I_IN) { const int nblk = NIN / 32, kb = it / nblk, nb = it % nblk, n0 = 32 * nb;
            const int pn = n0 >> 8, rem = n0 & 255, wc = rem >> 6, bjj = (rem >> 5) & 1;
            p0_transpose_item(P.w_in, DM, NIN, P.WIT, 64 * kb, n0, 256 * pn + 128 * bjj + 32 * wc, scr, F.lane); }
        else { const int r = it - I_IN, nblk = DM / 32, kb = r / nblk, nb = r % nblk; p0_transpose_item(P.w_out, DM, DM, P.WOT, 64 * kb, 32 * nb, 32 * nb, scr, F.lane); }
    }
    for (int e = (F.vcu * NWAVES * 64) + F.tid; e < SEQ * 32; e += F.G * NWAVES * 64) {
        const int t = e >> 5, i = e & 31;
        double r = 1.0; for (int k = 0; k < i; ++k) r *= 0.7498942093324558;
        const float inv = (float)r; const float ang = (float)t * inv;
        float s, c; sincos_d(ang, s, c); P.cosT[e] = c; P.sinT[e] = s;
    }
    for (int m = gw; m < M; m += NGW) {
        const GAS f32x4* xr = (const GAS f32x4*)(P.x + (size_t)m * DM) + F.lane;
        f32x4 v[4]; float ss = 0.f;
#pragma unroll
        for (int j = 0; j < 4; ++j) { v[j] = __builtin_nontemporal_load(xr + 64 * j); ss += (v[j].x * v[j].x + v[j].y * v[j].y) + (v[j].z * v[j].z + v[j].w * v[j].w); }
        const float rstd = rsqrtf(wave_sum(ss) * (1.f / DM) + 1e-6f);
        GAS unsigned long long* o8 = (GAS unsigned long long*)(P.XN + (size_t)m * DM) + F.lane;
#pragma unroll
        for (int j = 0; j < 4; ++j) { const f32x4 g = ((const GAS f32x4*)P.gain)[64 * j + F.lane];
            o8[64 * j] = (unsigned long long)pk2(v[j].x * rstd * g.x, v[j].y * rstd * g.y) | ((unsigned long long)pk2(v[j].z * rstd * g.z, v[j].w * rstd * g.w) << 32); }
    }
}
constexpr int STAGE_OFF = RING_BYTES;
__device__ __forceinline__ att::Desc b_desc(const Ptrs& P, int uid, int mode, int wave, int k) {
    const int b = uid >> 5, h = (uid >> 2) & 7, blk = uid & 3; const size_t hb = (size_t)(b * 8 + h) * SEQ;
    att::Desc D{};
    D.Q0 = P.QB + hb * 64; D.Q1 = D.Q0; D.K = P.KB + hb * 64; D.V = P.VB + hb * 64;
    if (mode == 1) {
        if (wave < 4) { D.dil = 16; D.r = 4 * wave + k; D.qt0 = 2 * blk; D.po = P.PO16 + hb * 64; D.pl = P.PL16 + hb; }
        else { D.dil = 4; D.r = k; D.qt0 = 8 * blk + 2 * (wave - 4); D.po = P.PO4 + hb * 64; D.pl = P.PL4 + hb; }
    } else {
        D.dil = 1; D.r = 0; D.qt0 = 32 * blk + 2 * (8 * k + wave);
        D.po_a = P.PO16 + hb * 64; D.po_b = P.PO4 + hb * 64; D.pl_a = P.PL16 + hb; D.pl_b = P.PL4 + hb;
        D.gate0 = P.GB + (size_t)b * SEQ * 512 + h * 64; D.gate1 = D.gate0; D.mix0 = P.MIX + (size_t)b * SEQ * DM + 512 + h * 64; D.mix1 = D.mix0;
    }
    D.qt1 = D.qt0 + 1;
    return D;
}
__device__ __forceinline__ att::Desc a_desc(const Ptrs& P, int b, int hp, int qt) {
    const int kv = hp >> 1, h0 = 2 * hp;
    att::Desc D{};
    D.Q0 = P.QA + (size_t)(b * 8 + h0) * SEQ * 64; D.Q1 = D.Q0 + (size_t)SEQ * 64;
    D.K = P.KA + (size_t)(b * 2 + kv) * SEQ * 64; D.V = P.VA + (size_t)(b * 2 + kv) * SEQ * 64;
    D.dil = 1; D.r = 0; D.qt0 = qt; D.qt1 = qt;
    D.gate0 = P.GA + (size_t)b * SEQ * 512 + h0 * 64; D.gate1 = D.gate0 + 64; D.mix0 = P.MIX + (size_t)b * SEQ * DM + h0 * 64; D.mix1 = D.mix0 + 64;
    D.sink0 = __builtin_amdgcn_exp2f(P.sinks[h0] * LOG2E); D.sink1 = __builtin_amdgcn_exp2f(P.sinks[h0 + 1] * LOG2E);
    return D;
}
#ifndef REP_2A
#define REP_2A 1
#define REP_2B 1
#define REP_2C 1
#endif
__device__ __forceinline__ void p2_attention(Frame& F, const Ptrs& P, const XcdBarrier& bar) {
    att::lds_ptr ring = (att::lds_ptr)(F.lds + RING_OFF + F.wave * 16384), stage = (att::lds_ptr)(F.lds + STAGE_OFF + F.wave * 2048);
    int lane_ = F.lane; asm volatile("" : "+v"(lane_));
    const int lane = lane_, wave = F.wave, uid = F.vcu;
    const unsigned ring0 = (unsigned)(uintptr_t)ring;
    att::bf16x8 qr[2][4];
    att::Desc D, N; int par = 0;
#ifdef DRY_PASS
    D = b_desc(P, uid, 1, wave, 0);
    att::prefetch<DRY_PASS>(D, ring0, qr, lane);
    for (int k = 0; k < 4; ++k) {
        N = b_desc(P, uid, 1, wave, (k + 1) & 3);
        att::attn_item<1, DRY_PASS>(ring, stage, D, k < 3, N, qr, par, lane); D = N;
    }
    asm volatile("s_waitcnt vmcnt(0) lgkmcnt(0)" ::: "memory");
#endif
#pragma unroll
    for (int rep = 0; rep < REP_2A; ++rep) {
    D = b_desc(P, uid, 1, wave, 0);
    par = 0; att::prefetch(D, ring0, qr, lane, 0);
    for (int k = 0; k < 4; ++k) {
        N = b_desc(P, uid, 1, wave, (k + 1) & 3);
        att::attn_item<1>(ring, stage, D, k < 3, N, qr, par, lane); D = N;
    }
    }
    asm volatile("s_waitcnt vmcnt(0) lgkmcnt(0)\n\ts_barrier" ::: "memory");
#pragma unroll
    for (int rep = 0; rep < REP_2B; ++rep) {
    D = b_desc(P, uid, 2, wave, 0);
    par = 0; att::prefetch(D, ring0, qr, lane, 0);
    for (int k = 0; k < 2; ++k) {
        N = b_desc(P, uid, 2, wave, 1);
        att::attn_item<2>(ring, stage, D, k < 1, N, qr, par, lane); D = N;
    }
    }
#pragma unroll
    for (int rep = 0; rep < REP_2C; ++rep) {
    {
        const int aid0 = uid * 16 + wave;
        D = a_desc(P, aid0 >> 9, (aid0 >> 7) & 3, aid0 & 127);
        par = 0; att::prefetch(D, ring0, qr, lane, 0);
        for (int k = 0; k < 2; ++k) {
            N = a_desc(P, aid0 >> 9, (aid0 >> 7) & 3, (aid0 & 127) + 8);
            att::attn_item<0>(ring, stage, D, k < 1, N, qr, par, lane); D = N;
        }
    }
    }
}

struct Args { const float* in[9]; float* out; unsigned char* ws; };
__global__ void __launch_bounds__(NWAVES * 64, 2) mega_fwd(Args args) {
    extern __shared__ __attribute__((aligned(16))) unsigned char lds[];
    Frame F;
    F.lds = (LAS unsigned char*)lds;
    F.MISC = (volatile LAS unsigned*)(F.lds + MISC_OFF);
    F.tid = threadIdx.x; F.lane = F.tid & 63; F.wave = __builtin_amdgcn_readfirstlane(F.tid >> 6);
    F.G = gridDim.x; { const int bx = blockIdx.x; F.vcu = (F.G % 8 == 0) ? (bx % 8) * (F.G / 8) + bx / 8 : bx; }
    unsigned char* ws = args.ws;
    F.ctl = (gu32*)(ws + WS_CTL);
    Ptrs P;
    P.x = args.in[0]; P.gain = args.in[1]; P.w_in = args.in[2]; P.qna = args.in[3]; P.kna = args.in[4]; P.sinks = args.in[5]; P.qnb = args.in[6]; P.knb = args.in[7]; P.w_out = args.in[8]; P.out = args.out;
    P.WIT = (bf16*)(ws + WS_WIT); P.WOT = (bf16*)(ws + WS_WOT); P.XN = (bf16*)(ws + WS_XN);
    P.QA = (bf16*)(ws + WS_QA); P.KA = (bf16*)(ws + WS_KA); P.VA = (bf16*)(ws + WS_VA); P.GA = (bf16*)(ws + WS_GA);
    P.QB = (bf16*)(ws + WS_QB); P.KB = (bf16*)(ws + WS_KB); P.VB = (bf16*)(ws + WS_VB); P.GB = (bf16*)(ws + WS_GB); P.MIX = (bf16*)(ws + WS_MIX);
    P.cosT = (float*)(ws + WS_COS); P.sinT = (float*)(ws + WS_SIN);
    P.PO16 = (bf16*)(ws + WS_PO16); P.PO4 = (bf16*)(ws + WS_PO4); P.PL16 = (float*)(ws + WS_PL16); P.PL4 = (float*)(ws + WS_PL4);
    for (int u = F.tid; u < (LDS_BYTES - LDSCTL_OFF) / 4; u += NWAVES * 64) ((LAS unsigned*)(F.lds + LDSCTL_OFF))[u] = 0u;
    __syncthreads();
    XcdBarrier bar = xcd_barrier_post((unsigned*)(F.ctl + CW_BAR), F.MISC + 8);

#ifndef PROBE_TS
#define PROBE_TS 0
#endif
    unsigned long long ts0 = 0, ts1 = 0, ts2 = 0, ts3 = 0, ts4 = 0;
    if (PROBE_TS) ts0 = rt();
#ifndef REP_P0
#define REP_P0 1
#define REP_P1 1
#define REP_P2 1
#define REP_P3 1
#endif
#pragma unroll
    for (int rep = 0; rep < REP_P0; ++rep) {
    p0_prologue(F, P);
    xcd_barrier(bar);
    }
    if (PROBE_TS) ts1 = rt();
#pragma unroll
    for (int rep = 0; rep < REP_P1; ++rep) {
#ifdef STAGGER_US
        if ((int)blockIdx.x >= F.G / 2) { const unsigned long long t0_ = rt(); while (rt() - t0_ < (unsigned long long)(STAGGER_US * 100)) __builtin_amdgcn_s_sleep(8); }
#endif
        pg8::Gemm g{P.XN, P.WIT, M, NIN, DM}; pg8::StaticOrder S; S.init(M, NIN, F.G, (int)blockIdx.x);
        pg8::EpiIn E{P.QA, P.KA, P.VA, P.GA, P.QB, P.KB, P.VB, P.GB, P.qna, P.kna, P.qnb, P.knb, P.cosT, P.sinT};
        pg8::gemm_phase<pg8::EpiIn, pg8::StaticOrder, PG8_ALIGN, PG8_SP2>(F.lds + RING_OFF, g, S, E);
    xcd_barrier(bar);
    }
    if (PROBE_TS) ts2 = rt();
#ifdef DRY_GEMM
    {
        pg8::Gemm g{P.XN, P.WIT, M, NIN, DM};
#if DRY_GEMM == 1
        pg8::StaticOrder S; S.init(M, NIN, F.G, (int)blockIdx.x); pg8::EpiNone E{};
        pg8::gemm_phase<pg8::EpiNone, pg8::StaticOrder, PG8_ALIGN, PG8_SP2>(F.lds + RING_OFF, g, S, E);
#elif DRY_GEMM == 3
        pg8::StaticOrder S; S.init(M, NIN, F.G, (int)blockIdx.x);
        pg8::EpiInT<true> E{P.QA, P.KA, P.VA, P.GA, P.QB, P.KB, P.VB, P.GB, P.qna, P.kna, P.qnb, P.knb, P.cosT, P.sinT};
        pg8::gemm_phase<pg8::EpiInT<true>, pg8::StaticOrder, PG8_ALIGN, PG8_SP2>(F.lds + RING_OFF, g, S, E);
#else
        pg8::SameTileOrder S; S.init(M, NIN, F.G, (int)blockIdx.x); pg8::EpiNone E{};
        pg8::gemm_phase<pg8::EpiNone, pg8::SameTileOrder, PG8_ALIGN, PG8_SP2>(F.lds + RING_OFF, g, S, E);
#endif
        xcd_barrier(bar);
    }
#endif
#pragma unroll
    for (int rep = 0; rep < REP_P2; ++rep) {
    p2_attention(F, P, bar);
    xcd_barrier(bar);
    }
    if (PROBE_TS) ts3 = rt();
#pragma unroll
    for (int rep = 0; rep < REP_P3; ++rep) {
        pg8::Gemm g{P.MIX, P.WOT, M, DM, DM}; pg8::StaticOrder S; S.init(M, DM, F.G, (int)blockIdx.x);
        pg8::EpiRes E{P.x, P.out};
        pg8::gemm_phase<pg8::EpiRes, pg8::StaticOrder, PG8_ALIGN, PG8_SP2>(F.lds + RING_OFF, g, S, E);
    }
    if (PROBE_TS) {
        ts4 = rt();
        if (blockIdx.x == 0 && F.tid == 0) {
            const float dA = (PROBE_TS == 1) ? (float)(ts2 - ts1) * 0.01f : (float)(ts1 - ts0) * 0.01f;
            const float dB = (PROBE_TS == 1) ? (float)(ts3 - ts2) * 0.01f : (float)(ts4 - ts3) * 0.01f;
            asm volatile("s_waitcnt vmcnt(0)" ::: "memory");
            P.out[0] += dA; P.out[1] += dB;
        }
    }
}

extern "C" void kernel_launch(void* const* d_in, const int* in_sizes, int n_in, void* d_out, int out_size, void* d_ws, size_t ws_size, hipStream_t stream) {
    static int grid = 0;
    if (grid == 0) {
        if (n_in != 9 || out_size != M * DM || ws_size < WS_END) { fprintf(stderr, "kernel_launch: unexpected shapes (n_in %d, out %d, ws %zu); nothing launched\n", n_in, out_size, ws_size); grid = -1; return; }
        int dev = 0, cus = 0;
        if (hipGetDevice(&dev) != hipSuccess || hipDeviceGetAttribute(&cus, hipDeviceAttributeMultiprocessorCount, dev) != hipSuccess) { grid = -1; return; }
        if (hipFuncSetAttribute((const void*)mega_fwd, hipFuncAttributeMaxDynamicSharedMemorySize, LDS_BYTES) != hipSuccess) { fprintf(stderr, "kernel_launch: hipFuncSetAttribute failed\n"); grid = -1; return; }
        (void)hipGetLastError();
        grid = cus;
    }
    if (grid < 0) return;
#ifdef EXTRA_MEMSET
    (void)hipMemsetAsync((char*)d_ws + WS_CTL + 512 * 1024, 0, CTL_ZERO_BYTES, stream);
#endif
    if (hipMemsetAsync((char*)d_ws + WS_CTL, 0, CTL_ZERO_BYTES, stream) != hipSuccess) { fprintf(stderr, "kernel_launch: hipMemsetAsync failed\n"); return; }
    Args a{};
    for (int i = 0; i < 9; ++i) a.in[i] = (const float*)d_in[i];
    a.out = (float*)d_out; a.ws = (unsigned char*)d_ws;
    hipLaunchKernelGGL(mega_fwd, dim3(grid), dim3(NWAVES * 64), LDS_BYTES, stream, a);
}
```

```cpp
#include <hip/hip_runtime.h>
#include <cstdio>
#include <cstdint>
#include <cmath>
#define KSWZ 1
namespace pg8 {
#define PG8_LAS __attribute__((address_space(3)))
typedef unsigned short bf16_t;
typedef short bf16x8 __attribute__((ext_vector_type(8)));
typedef float f32x4 __attribute__((ext_vector_type(4)));
typedef unsigned u32x4 __attribute__((ext_vector_type(4)));
constexpr int BM = 256, BK = 64, HALF = 128, HTB = HALF * BK * 2  , STAGE_BYTES = 8 * HTB, NXCD = 8, WGM = 8;

__host__ __device__ __forceinline__ int lds_byte(int r, int c) { const int st = (r >> 4) * 2 + (c >> 5), rr = r & 15, cc = c & 31, ob = rr * 64 + cc * 2; return st * 1024 + (ob ^ (((ob >> 9) & 1) << 5)); }
__host__ __device__ __forceinline__ void stage_rc(int b, int& R, int& C) { const int st = b / 1024, sb = b % 1024, swz = sb ^ (((sb >> 9) & 1) << 5); R = (st >> 1) * 16 + swz / 64; C = (st & 1) * 32 + (swz % 64) / 2; }
__host__ __device__ __forceinline__ int perm32(int rho) { const int n = rho >> 4, i = rho & 15; return 8 * (i >> 2) + 4 * n + (i & 3); }

struct Unit { int pm, pn; };
struct Gemm { const bf16_t* A; const bf16_t* Bt; int M, N, K; };

struct StaticOrder {
    int nM, nN, nwg, G, c;
    __host__ __device__ void init(int M, int N, int G_, int c_) { nM = M / BM; nN = N / BM; nwg = nM * nN; G = G_; c = c_; }
    __host__ __device__ bool next(int i, Unit& u) const {
        const long L = (long)i * G + c; if (L >= nwg) return false;
        int wgid = (int)L; { const int q = nwg / NXCD, r = nwg % NXCD, xcd = wgid % NXCD, off = wgid / NXCD; wgid = (xcd < r ? xcd * (q + 1) : r * (q + 1) + (xcd - r) * q) + off; }
        const int nig = WGM * nN, gid = wgid / nig, fm = gid * WGM, gsz = (nM - fm) < WGM ? (nM - fm) : WGM;
        u.pm = fm + ((wgid % nig) % gsz); u.pn = (wgid % nig) / gsz; return true;
    }
    __device__ __forceinline__ void a_ready(const Unit&) const {}
    __device__ __forceinline__ void done(const Unit&) const {}
};
__device__ __forceinline__ unsigned cvt_pk_bf16(float lo, float hi) { unsigned r; asm volatile("v_cvt_pk_bf16_f32 %0, %1, %2" : "=v"(r) : "v"(lo), "v"(hi)); return r; }
typedef float f32x2 __attribute__((ext_vector_type(2)));
typedef _Float16 f16x8 __attribute__((ext_vector_type(8)));
typedef _Float16 f16x2 __attribute__((ext_vector_type(2)));
constexpr int SEQ_ = 4096;
constexpr float C2_ = 0.18033688011112042f, LOG2E_ = 1.4426950408889634f;
__device__ __forceinline__ u32x4 pack8(const f32x4& a, const f32x4& b) { u32x4 w; w.x = cvt_pk_bf16(a[0], a[1]); w.y = cvt_pk_bf16(a[2], a[3]); w.z = cvt_pk_bf16(b[0], b[1]); w.w = cvt_pk_bf16(b[2], b[3]); return w; }
__device__ __forceinline__ void store_row_pair(bf16_t* rowp, size_t pitch, int fr, u32x4 w0, u32x4 w1) {
    const bool odd = fr & 1;
    const u32x4 snd = odd ? w0 : w1;
    u32x4 rcv;
#pragma unroll
    for (int k = 0; k < 4; ++k) rcv[k] = (unsigned)__shfl_xor((int)snd[k], 1);
    const u32x4 A = odd ? rcv : w0, B = odd ? w1 : rcv;
    bf16_t* pa = odd ? rowp - pitch + 32 : rowp;
    bf16_t* pb = odd ? rowp + 32 : rowp + pitch;
    *(u32x4*)pa = A; *(u32x4*)pb = B;
}
template <bool NOSTORE = false> struct EpiInT {
    static constexpr bool PERM = true, AFTER_DRAIN = false, REPME = true, F16 = true; static constexpr int NSTORE = 16;
    bf16_t *QA, *KA, *VA, *GA, *QB, *KB, *VB, *GB;
    const float *qna, *kna, *qnb, *knb, *cosT, *sinT;
    __device__ __forceinline__ void init(f32x4 (&acc)[2][2][4][2], const Unit&, int, int, int, int) const {
#pragma unroll
        for (int a = 0; a < 2; ++a)
#pragma unroll
            for (int b = 0; b < 2; ++b)
#pragma unroll
                for (int m = 0; m < 4; ++m)
#pragma unroll
                    for (int n = 0; n < 2; ++n) acc[a][b][m][n] = (f32x4){0.f, 0.f, 0.f, 0.f};
    }
    __device__ __forceinline__ void operator()(const f32x4 (&acc)[2][2][4][2], const Unit& u, int wr, int wc, int fr, int fq) const {
        const int g = u.pn * 4 + wc;
        int type, head, H = 8; const float* ng = qna; bf16_t* dst; float scale = 1.f;
        if (g < 8) { type = 0; head = g; ng = qna; dst = QA; scale = C2_; }
        else if (g < 10) { type = 0; head = g - 8; ng = kna; dst = KA; H = 2; }
        else if (g < 12) { type = 1; head = g - 10; dst = VA; H = 2; }
        else if (g < 20) { type = 2; head = g - 12; dst = GA; }
        else if (g < 28) { type = 0; head = g - 20; ng = qnb; dst = QB; scale = C2_; }
        else if (g < 36) { type = 0; head = g - 28; ng = knb; dst = KB; }
        else if (g < 44) { type = 1; head = g - 36; dst = VB; }
        else { type = 2; head = g - 44; dst = GB; }
        const int row0 = u.pm * BM + wr * 64 + fr;
        if (type == 0) {
            f32x4 gv[2][2], c16[2], s16[2], cb[2][2], sb[2][2];
            const int tb = (row0 & (SEQ_ - 1));
#pragma unroll
            for (int n = 0; n < 2; ++n) {
                c16[n] = *(const f32x4*)(cosT + 16 * 32 + 8 * fq + 4 * n); s16[n] = *(const f32x4*)(sinT + 16 * 32 + 8 * fq + 4 * n);
#pragma unroll
                for (int ai = 0; ai < 2; ++ai) { cb[ai][n] = *(const f32x4*)(cosT + (tb + ai * HALF) * 32 + 8 * fq + 4 * n); sb[ai][n] = *(const f32x4*)(sinT + (tb + ai * HALF) * 32 + 8 * fq + 4 * n); }
#pragma unroll
                for (int bj = 0; bj < 2; ++bj) gv[bj][n] = *(const f32x4*)(ng + 32 * bj + 8 * fq + 4 * n);
            }
#pragma unroll
            for (int ai = 0; ai < 2; ++ai) {
                f32x4 cs[2] = {cb[ai][0], cb[ai][1]}, sn[2] = {sb[ai][0], sb[ai][1]};
#pragma unroll
                for (int m = 0; m < 4; ++m) {
                    const int row = row0 + ai * HALF + m * 16, b = row >> 12, t = row & (SEQ_ - 1);
                    float ss = 0.f;
#pragma unroll
                    for (int bj = 0; bj < 2; ++bj)
#pragma unroll
                        for (int n = 0; n < 2; ++n) { const f32x4 x = acc[ai][bj][m][n]; ss += (x[0] * x[0] + x[1] * x[1]) + (x[2] * x[2] + x[3] * x[3]); }
                    ss += __shfl_xor(ss, 16); ss += __shfl_xor(ss, 32);
                    const float rs = rsqrtf(ss * (1.f / 64.f) + 1e-6f) * scale;
                    f32x4 o1[2], o2[2];
#pragma unroll
                    for (int n = 0; n < 2; ++n) {
                        const f32x4 n1 = acc[ai][0][m][n] * rs * gv[0][n], n2 = acc[ai][1][m][n] * rs * gv[1][n];
                        o1[n] = n1 * cs[n] - n2 * sn[n]; o2[n] = n2 * cs[n] + n1 * sn[n];
                        const f32x4 cn = cs[n] * c16[n] - sn[n] * s16[n], sn2 = sn[n] * c16[n] + cs[n] * s16[n];
                        cs[n] = cn; sn[n] = sn2;
                    }
                    bf16_t* p = dst + ((size_t)(b * H + head) * SEQ_ + t) * 64 + 8 * fq;
                    { const u32x4 w0_ = pack8(o1[0], o1[1]), w1_ = pack8(o2[0], o2[1]); if (NOSTORE) { asm volatile("" :: "v"(w0_), "v"(w1_)); } else { *(u32x4*)p = w0_; *(u32x4*)(p + 32) = w1_; } }
                }
            }
        } else if (type == 1) {
#pragma unroll
            for (int ai = 0; ai < 2; ++ai)
#pragma unroll
                for (int m = 0; m < 4; ++m) {
                    const int row = row0 + ai * HALF + m * 16, b = row >> 12, t = row & (SEQ_ - 1);
                    bf16_t* p = dst + ((size_t)(b * H + head) * SEQ_ + t) * 64 + 8 * fq;
                    { const u32x4 w0_ = pack8(acc[ai][0][m][0], acc[ai][0][m][1]), w1_ = pack8(acc[ai][1][m][0], acc[ai][1][m][1]); if (NOSTORE) { asm volatile("" :: "v"(w0_), "v"(w1_)); } else { *(u32x4*)p = w0_; *(u32x4*)(p + 32) = w1_; } }
                }
        } else {
#pragma unroll
            for (int ai = 0; ai < 2; ++ai)
#pragma unroll
                for (int m = 0; m < 4; ++m) {
                    const int row = row0 + ai * HALF + m * 16;
                    bf16_t* p = dst + (size_t)row * 512 + head * 64 + 8 * fq;
                    u32x4 wq[2];
#pragma unroll
                    for (int bj = 0; bj < 2; ++bj) {
                        f32x4 s[2];
#pragma unroll
                        for (int n = 0; n < 2; ++n) { const f32x4 v = acc[ai][bj][m][n];
#pragma unroll
                            for (int e = 0; e < 4; ++e) s[n][e] = v[e]; }
                        wq[bj] = pack8(s[0], s[1]);
                    }
                    { const u32x4 w0_ = wq[0], w1_ = wq[1]; if (NOSTORE) { asm volatile("" :: "v"(w0_), "v"(w1_)); } else { *(u32x4*)p = w0_; *(u32x4*)(p + 32) = w1_; } }
                }
        }
    }
};
typedef EpiInT<false> EpiIn;
struct EpiRes {
    static constexpr bool PERM = true, AFTER_DRAIN = false, REPME = false, F16 = false; static constexpr int NSTORE = 32;
    const unsigned short* xn; const float* rs; float* out;
    __device__ __forceinline__ void init(f32x4 (&acc)[2][2][4][2], const Unit&, int, int, int, int) const {
#pragma unroll
        for (int a = 0; a < 2; ++a)
#pragma unroll
            for (int b = 0; b < 2; ++b)
#pragma unroll
                for (int m = 0; m < 4; ++m)
#pragma unroll
                    for (int n = 0; n < 2; ++n) acc[a][b][m][n] = (f32x4){0.f, 0.f, 0.f, 0.f};
    }
    __device__ __forceinline__ void operator()(const f32x4 (&acc)[2][2][4][2], const Unit& u, int wr, int wc, int fr, int fq) const {
        const int row0 = u.pm * BM + wr * 64 + fr, col0 = u.pn * BM + wc * 32 + 8 * fq;
        u32x4 xr[2][4][2]; float rsv[2][4];
#pragma unroll
        for (int ai = 0; ai < 2; ++ai)
#pragma unroll
            for (int m = 0; m < 4; ++m) {
                const int row = row0 + ai * HALF + m * 16; const size_t off = (size_t)row * 1024 + col0;
                rsv[ai][m] = rs[row];
#pragma unroll
                for (int bj = 0; bj < 2; ++bj) xr[ai][m][bj] = *(const u32x4*)(xn + off + bj * HALF);
            }
        asm volatile("" ::: "memory");
#pragma unroll
        for (int ai = 0; ai < 2; ++ai)
#pragma unroll
            for (int m = 0; m < 4; ++m) {
                const size_t off = (size_t)(row0 + ai * HALF + m * 16) * 1024 + col0; const float r = rsv[ai][m];
#pragma unroll
                for (int bj = 0; bj < 2; ++bj) {
                    const u32x4 w = xr[ai][m][bj];
                    const unsigned w0 = w[0], w1 = w[1], w2 = w[2], w3 = w[3];
                    const f16x2 h0 = __builtin_bit_cast(f16x2, w0), h1 = __builtin_bit_cast(f16x2, w1), h2 = __builtin_bit_cast(f16x2, w2), h3 = __builtin_bit_cast(f16x2, w3);
                    const f32x4 x0 = {(float)h0[0] * r, (float)h0[1] * r, (float)h1[0] * r, (float)h1[1] * r}, x1 = {(float)h2[0] * r, (float)h2[1] * r, (float)h3[0] * r, (float)h3[1] * r};
                    *(f32x4*)(out + off + bj * HALF) = x0 + acc[ai][bj][m][0]; *(f32x4*)(out + off + bj * HALF + 4) = x1 + acc[ai][bj][m][1];
                }
            }
        asm volatile("" ::: "memory");
    }
};
struct EpiNone {
    static constexpr bool PERM = true, AFTER_DRAIN = false, REPME = false, F16 = false; static constexpr int NSTORE = 0;
    __device__ __forceinline__ void init(f32x4 (&acc)[2][2][4][2], const Unit&, int, int, int, int) const {
#pragma unroll
        for (int a = 0; a < 2; ++a)
#pragma unroll
            for (int b = 0; b < 2; ++b)
#pragma unroll
                for (int m = 0; m < 4; ++m)
#pragma unroll
                    for (int n = 0; n < 2; ++n) acc[a][b][m][n] = (f32x4){0.f, 0.f, 0.f, 0.f};
    }
    __device__ __forceinline__ void operator()(const f32x4 (&acc)[2][2][4][2], const Unit&, int, int, int, int) const {
#pragma unroll
        for (int a = 0; a < 2; ++a)
#pragma unroll
            for (int b = 0; b < 2; ++b)
#pragma unroll
                for (int m = 0; m < 4; ++m)
#pragma unroll
                    for (int n = 0; n < 2; ++n) asm volatile("" :: "v"(acc[a][b][m][n]));
    }
};
struct SameTileOrder : StaticOrder {
    __host__ __device__ bool next(int i, Unit& u) const { if (!StaticOrder::next(i, u)) return false; u.pm = 0; u.pn = 0; return true; }
};
template <class Epi, class Sched, bool ALIGN_EPI = false, bool SP2 = false>
__device__ __forceinline__ void gemm_phase(PG8_LAS unsigned char* lds, const Gemm g, const Sched& S, const Epi& E) {
    int tid_ = threadIdx.x; asm volatile("" : "+v"(tid_));
    const int tid = tid_, wid = __builtin_amdgcn_readfirstlane(tid >> 6), lane = tid & 63, wr = wid >> 2, wc = wid & 3, fr = lane & 15, fq = lane >> 4;
    const int K = g.K, nt = K / BK;
    unsigned voffA[2], voffB[2];
#pragma unroll
    for (int i = 0; i < 2; ++i) { int R, C; stage_rc(tid * 16 + i * 8192, R, C); const int Rb = Epi::PERM ? ((R & ~31) + perm32(R & 31)) : R;
        voffA[i] = (unsigned)(R * K + C) * 2u; voffB[i] = (unsigned)(Rb * K + C) * 2u; }
    const size_t kstep = (size_t)(BK * 2);
    const size_t hstep = (size_t)HALF * K * 2;
    const size_t tstep = 2 * hstep;
    const unsigned ldsw = (unsigned)wid * 1024u;
    const int aoff = lds_byte(wr * 64 + fr, fq * 8), boff = lds_byte(wc * 32 + fr, fq * 8);
#define PG8_SA(b, h) (((b) * 2 + (h)) * HTB)
#define PG8_SB(b, h) ((4 + (b) * 2 + (h)) * HTB)
#define PG8_STAGE(bufoff, gbase, voff) do { _Pragma("unroll") for (int _i = 0; _i < 2; ++_i) \
        __builtin_amdgcn_global_load_lds((const unsigned*)((const char*)(gbase) + (voff)[_i]), (PG8_LAS unsigned*)(lds + (bufoff) + ldsw + _i * 8192), 16, 0, 0); } while (0)
#define PG8_LDA(dst, b, h) do { _Pragma("unroll") for (int m = 0; m < 4; ++m) _Pragma("unroll") for (int k = 0; k < 2; ++k) dst[m][k] = *(const PG8_LAS bf16x8*)(lds + PG8_SA(b, h) + aoff + m * 2048 + k * 1024); } while (0)
#define PG8_LDB(dst, b, h) do { _Pragma("unroll") for (int n = 0; n < 2; ++n) _Pragma("unroll") for (int k = 0; k < 2; ++k) dst[n][k] = *(const PG8_LAS bf16x8*)(lds + PG8_SB(b, h) + boff + n * 2048 + k * 1024); } while (0)
#define PG8_MFMA(b_, a_, c_) (Epi::F16 ? __builtin_amdgcn_mfma_f32_16x16x32_f16(__builtin_bit_cast(f16x8, b_), __builtin_bit_cast(f16x8, a_), c_, 0, 0, 0) : __builtin_amdgcn_mfma_f32_16x16x32_bf16(b_, a_, c_, 0, 0, 0))
#define PG8_MMA(ai, bj, At, Bt) do { __builtin_amdgcn_s_setprio(1); _Pragma("unroll") for (int m = 0; m < 4; ++m) _Pragma("unroll") for (int n = 0; n < 2; ++n) _Pragma("unroll") for (int k = 0; k < 2; ++k) \
        acc[ai][bj][m][n] = PG8_MFMA(Bt[n][k], At[m][k], acc[ai][bj][m][n]); __builtin_amdgcn_s_setprio(0); } while (0)
#define PG8_WAIT_V(n) asm volatile("s_waitcnt vmcnt(" #n ")" ::: "memory")
#define PG8_WAIT_V8S() do { if (Epi::NSTORE == 16) PG8_WAIT_V(24); else if (Epi::NSTORE == 32) PG8_WAIT_V(40); else PG8_WAIT_V(8); } while (0)
#define PG8_WAIT_L(n) asm volatile("s_waitcnt lgkmcnt(" #n ")" ::: "memory")
#define PG8_BAR __builtin_amdgcn_s_barrier()
#define PG8_SCHED __builtin_amdgcn_sched_barrier(0)
    Unit cur, nxt; int ui = 0;
    if (!S.next(0, cur)) return;
    f32x4 acc[2][2][4][2];
    E.init(acc, cur, wr, wc, fr, fq);
    bf16x8 At[4][2], B0[2][2], B1[2][2];
    const char* cA = (const char*)g.A + (size_t)cur.pm * tstep; const char* cB = (const char*)g.Bt + (size_t)cur.pn * tstep;
    S.a_ready(cur);
    if constexpr (SP2) {
        PG8_STAGE(PG8_SB(0, 0), cB, voffB); PG8_STAGE(PG8_SB(0, 1), cB + hstep, voffB); PG8_STAGE(PG8_SA(0, 0), cA, voffA); PG8_STAGE(PG8_SA(0, 1), cA + hstep, voffA);
        if (wr == 1) PG8_BAR;
        PG8_WAIT_V(2); PG8_BAR;
        PG8_STAGE(PG8_SB(1, 0), cB + kstep, voffB); PG8_STAGE(PG8_SA(1, 0), cA + kstep, voffA); PG8_STAGE(PG8_SB(1, 1), cB + hstep + kstep, voffB);
        PG8_WAIT_V(6); PG8_BAR;
    } else {
        PG8_STAGE(PG8_SB(0, 0), cB, voffB); PG8_STAGE(PG8_SA(0, 0), cA, voffA); PG8_STAGE(PG8_SB(0, 1), cB + hstep, voffB); PG8_STAGE(PG8_SA(0, 1), cA + hstep, voffA);
        if (wr == 1) PG8_BAR;
        PG8_WAIT_V(4); PG8_BAR;
        PG8_STAGE(PG8_SB(1, 0), cB + kstep, voffB); PG8_STAGE(PG8_SA(1, 0), cA + kstep, voffA); PG8_STAGE(PG8_SB(1, 1), cB + hstep + kstep, voffB);
        PG8_WAIT_V(6); PG8_BAR;
    }
    for (;;) {
        const bool has_next = S.next(ui + 1, nxt);
        const char* nA = has_next ? (const char*)g.A + (size_t)nxt.pm * tstep : cA; const char* nB = has_next ? (const char*)g.Bt + (size_t)nxt.pn * tstep : cB;
        for (int t = 0; t < nt; t += 2) {
            const bool last = (t == nt - 2);
            const char* a1 = cA + (size_t)(t + 1) * kstep;
            const char* a2 = last ? nA : cA + (size_t)(t + 2) * kstep; const char* b2 = last ? nB : cB + (size_t)(t + 2) * kstep;
            const char* a3 = a2 + kstep; const char* b3 = b2 + kstep;
            if (last && has_next) S.a_ready(nxt);
            if constexpr (SP2) {
            PG8_LDB(B0, 0, 0); PG8_LDB(B1, 0, 1); PG8_SCHED; PG8_LDA(At, 0, 0); PG8_STAGE(PG8_SA(1, 1), a1 + hstep, voffA);
            PG8_WAIT_V(8); PG8_WAIT_L(0); PG8_BAR; PG8_MMA(0, 0, At, B0); PG8_MMA(0, 1, At, B1); PG8_BAR; PG8_SCHED;
            PG8_LDA(At, 0, 1); PG8_STAGE(PG8_SB(0, 0), b2, voffB); PG8_STAGE(PG8_SB(0, 1), b2 + hstep, voffB); PG8_STAGE(PG8_SA(0, 0), a2, voffA);
            PG8_WAIT_V(8); PG8_WAIT_L(0); PG8_BAR; PG8_MMA(1, 0, At, B0); PG8_MMA(1, 1, At, B1); PG8_BAR; PG8_SCHED;
            PG8_LDB(B0, 1, 0); PG8_LDB(B1, 1, 1); PG8_SCHED; PG8_LDA(At, 1, 0); PG8_STAGE(PG8_SA(0, 1), a2 + hstep, voffA);
            PG8_WAIT_V(8); PG8_WAIT_L(0); PG8_BAR; PG8_MMA(0, 0, At, B0); PG8_MMA(0, 1, At, B1); PG8_BAR; PG8_SCHED;
            PG8_LDA(At, 1, 1); PG8_STAGE(PG8_SB(1, 0), b3, voffB); PG8_STAGE(PG8_SB(1, 1), b3 + hstep, voffB); PG8_STAGE(PG8_SA(1, 0), a3, voffA);
            PG8_WAIT_V(8); PG8_WAIT_L(0); PG8_BAR; PG8_MMA(1, 0, At, B0); PG8_MMA(1, 1, At, B1); PG8_BAR; PG8_SCHED;
            } else {
            PG8_LDB(B0, 0, 0); PG8_SCHED; PG8_LDA(At, 0, 0); PG8_STAGE(PG8_SA(1, 1), a1 + hstep, voffA);
            PG8_WAIT_L(8); PG8_BAR; PG8_WAIT_L(0); PG8_MMA(0, 0, At, B0); PG8_BAR; PG8_SCHED;
            PG8_LDB(B1, 0, 1); PG8_STAGE(PG8_SB(0, 0), b2, voffB);
            PG8_BAR; PG8_WAIT_L(0); PG8_MMA(0, 1, At, B1); PG8_BAR;
            PG8_LDA(At, 0, 1); PG8_STAGE(PG8_SA(0, 0), a2, voffA);
            PG8_BAR; PG8_WAIT_L(0); PG8_MMA(1, 0, At, B0); PG8_BAR; PG8_SCHED;
            PG8_STAGE(PG8_SB(0, 1), b2 + hstep, voffB);
            PG8_WAIT_V(6); PG8_BAR; PG8_MMA(1, 1, At, B1); PG8_BAR;
            PG8_LDB(B0, 1, 0); PG8_SCHED; PG8_LDA(At, 1, 0); PG8_STAGE(PG8_SA(0, 1), a2 + hstep, voffA);
            PG8_WAIT_L(8); PG8_BAR; PG8_WAIT_L(0); PG8_MMA(0, 0, At, B0); PG8_BAR; PG8_SCHED;
            PG8_LDB(B1, 1, 1); PG8_STAGE(PG8_SB(1, 0), b3, voffB);
            PG8_BAR; PG8_WAIT_L(0); PG8_MMA(0, 1, At, B1); PG8_BAR;
            PG8_LDA(At, 1, 1); PG8_STAGE(PG8_SA(1, 0), a3, voffA);
            PG8_BAR; PG8_WAIT_L(0); PG8_MMA(1, 0, At, B0); PG8_BAR; PG8_SCHED;
            PG8_STAGE(PG8_SB(1, 1), b3 + hstep, voffB);
            PG8_WAIT_V(6); PG8_BAR; PG8_MMA(1, 1, At, B1); PG8_BAR;
            }
        }
        if constexpr (ALIGN_EPI) { if (wr == 0) PG8_BAR; }
        if constexpr (!Epi::AFTER_DRAIN) { E(acc, cur, wr, wc, fr, fq); S.done(cur); }
        if (!has_next) break;
        E.init(acc, nxt, wr, wc, fr, fq);
        cur = nxt; cA = nA; cB = nB; ++ui;
        if constexpr (ALIGN_EPI) { if (wr == 1) PG8_BAR; }
    }
    PG8_WAIT_V(0);
    if constexpr (!ALIGN_EPI) { if (wr == 0) PG8_BAR; }
    PG8_BAR;
    if constexpr (Epi::AFTER_DRAIN) { E.fused(acc, cur, wr, wc, fr, fq, lds, wid, lane); S.done(cur); }
#undef PG8_SA
#undef PG8_SB
#undef PG8_STAGE
#undef PG8_LDA
#undef PG8_LDB
#undef PG8_MMA
#undef PG8_WAIT_V
#undef PG8_WAIT_V8S
#undef PG8_WAIT_L
#undef PG8_BAR
#undef PG8_SCHED
}
}
namespace att {
#ifndef KSWZ
#define KSWZ 0
#endif
typedef short bf16x8 __attribute__((ext_vector_type(8)));
typedef short s16x4 __attribute__((ext_vector_type(4)));
typedef short v4i16_t __attribute__((ext_vector_type(4)));
typedef float f32x16 __attribute__((ext_vector_type(16)));
typedef float f32x4 __attribute__((ext_vector_type(4)));
typedef unsigned u32x4 __attribute__((ext_vector_type(4)));
typedef float f32x2_t __attribute__((ext_vector_type(2))); typedef __bf16 bf16x2_t __attribute__((ext_vector_type(2)));
typedef __attribute__((address_space(3))) unsigned char* lds_ptr;
__device__ __forceinline__ unsigned cvtpk_s(float lo, float hi) { f32x2_t v = {lo, hi}; bf16x2_t b = __builtin_convertvector(v, bf16x2_t); return __builtin_bit_cast(unsigned, b); }
__device__ __forceinline__ int crow(int r, int hi) { return (r & 3) + 8 * (r >> 2) + 4 * hi; }
__device__ __forceinline__ s16x4 vtr(lds_ptr p) { return __builtin_bit_cast(s16x4, __builtin_amdgcn_ds_read_tr16_b64_v4i16((__attribute__((address_space(3))) v4i16_t*)p)); }
#define ATT_WAITV(n) asm volatile("s_waitcnt vmcnt(" #n ")" ::: "memory")
__device__ __forceinline__ void glds16(const void* gsrc, unsigned lds_dst) { unsigned keep;
    asm volatile("s_mov_b32 %0, m0\n\ts_mov_b32 m0, %2\n\ts_nop 0\n\tglobal_load_lds_dwordx4 %1, off\n\ts_mov_b32 m0, %0" : "=&s"(keep) : "v"(gsrc), "s"(lds_dst) : "memory"); }
#define ATT_GLDS(src, dst) glds16((src), (unsigned)__builtin_amdgcn_readfirstlane((int)(dst)))

struct Desc {
    const unsigned short *Q0, *Q1, *K, *V;
    int dil, r, qt0, qt1;
    unsigned short* po; float* pl;
    const unsigned short *po_a, *po_b; const float *pl_a, *pl_b;
    const unsigned short *gate0, *gate1; unsigned short *mix0, *mix1;
    float sink0, sink1;
};
struct LaneK { unsigned koff[4], voff[4]; };
__device__ __forceinline__ LaneK lane_offsets(int dil, int lane) {
    LaneK L;
#pragma unroll
    for (int i = 0; i < 4; ++i) {
        const int row = 8 * i + (lane >> 3), chunk = (lane & 7) ^ (KSWZ ? ((row >> 1) & 7) : 0);
        L.koff[i] = (unsigned)(dil * row) * 128u + (unsigned)chunk * 16u;
        const int vchunk = (lane & 7) ^ (4 * ((row >> 1) & 1));
        L.voff[i] = (unsigned)(dil * row) * 128u + (unsigned)vchunk * 16u;
    }
    return L;
}
#define ATT_DMA_K(D, L, ktlo, j, sl) do { const char* s_ = (const char*)(D).K + (size_t)(D).r * 128 + (size_t)((ktlo) + (j)) * ((size_t)(D).dil * 4096); const unsigned d_ = ring0 + ((sl) & 1) * 8192; \
        ATT_GLDS(s_ + (L).koff[0], d_); ATT_GLDS(s_ + (L).koff[1], d_ + 1024); ATT_GLDS(s_ + (L).koff[2], d_ + 2048); ATT_GLDS(s_ + (L).koff[3], d_ + 3072); } while (0)
#define ATT_DMA_V(D, L, ktlo, j, sl) do { const char* s_ = (const char*)(D).V + (size_t)(D).r * 128 + (size_t)((ktlo) + (j)) * ((size_t)(D).dil * 4096); const unsigned d_ = ring0 + ((sl) & 1) * 8192 + 4096; \
        ATT_GLDS(s_ + (L).voff[0], d_); ATT_GLDS(s_ + (L).voff[1], d_ + 1024); ATT_GLDS(s_ + (L).voff[2], d_ + 2048); ATT_GLDS(s_ + (L).voff[3], d_ + 3072); } while (0)
template <int DRY = 0>
__device__ __forceinline__ void prefetch(const Desc& D, unsigned ring0, bf16x8 (&qr)[2][4], int lane, int par = 0) {
    const int q = lane & 31, hi = lane >> 5;
    const int ktlo = D.qt0 >= 4 ? D.qt0 - 4 : 0, nt = D.qt1 - ktlo + 1;
    const LaneK L = lane_offsets(D.dil, lane);
    { const unsigned short* q0 = D.Q0 + (size_t)(D.r + D.dil * (32 * D.qt0 + q)) * 64 + hi * 8; const unsigned short* q1 = D.Q1 + (size_t)(D.r + D.dil * (32 * D.qt1 + q)) * 64 + hi * 8;
#pragma unroll
      for (int d0 = 0; d0 < 4; ++d0) { qr[0][d0] = *(const bf16x8*)(q0 + d0 * 16); qr[1][d0] = *(const bf16x8*)(q1 + d0 * 16); } }
    asm volatile("s_waitcnt lgkmcnt(0)" ::: "memory");
    if (DRY != 2) { ATT_DMA_K(D, L, ktlo, 0, par); ATT_DMA_V(D, L, ktlo, 0, par);
    if (nt > 1) { ATT_DMA_K(D, L, ktlo, 1, par + 1); ATT_DMA_V(D, L, ktlo, 1, par + 1); }
    if (DRY == 3) { if (nt > 2) { ATT_DMA_K(D, L, ktlo, 2, par); ATT_DMA_V(D, L, ktlo, 2, par); } if (nt > 3) { ATT_DMA_K(D, L, ktlo, 3, par + 1); ATT_DMA_V(D, L, ktlo, 3, par + 1); } } }
}
template <int MODE, int DRY = 0>
__device__ __forceinline__ void attn_item(lds_ptr ring, lds_ptr stage, const Desc& D, bool has_next, const Desc& N, bf16x8 (&qx)[2][4], int& par, int lane) {
    const int q = lane & 31, hi = lane >> 5;
    const int ktlo = D.qt0 >= 4 ? D.qt0 - 4 : 0, nt = D.qt1 - ktlo + 1;
    constexpr int DMIN = (MODE == 0) ? 1 : 0;
    const unsigned ring0 = (unsigned)(uintptr_t)ring;
    const LaneK L = lane_offsets(D.dil, lane);
    const int krow = q * 128, ksw = KSWZ ? ((q >> 1) & 7) : 0;
    const int vsw = ((lane & 15) >> 3) & 1;
    const int vb = ((lane >> 4) & 1) * 32 + (lane & 3) * 8 + (4 * hi + ((lane & 15) >> 2)) * 128;
    f32x16 o00 = {}, o01 = {}, o10 = {}, o11 = {}; float ls0 = 0.f, ls1 = 0.f;
    asm volatile("s_waitcnt vmcnt(0)" ::: "memory");
    bf16x8 qr[2][4];
#pragma unroll
    for (int s_ = 0; s_ < 2; ++s_)
#pragma unroll
        for (int d0 = 0; d0 < 4; ++d0) qr[s_][d0] = qx[s_][d0];
    asm volatile("" : "+v"(qr[0][0]), "+v"(qr[0][1]), "+v"(qr[0][2]), "+v"(qr[0][3]), "+v"(qr[1][0]), "+v"(qr[1][1]), "+v"(qr[1][2]), "+v"(qr[1][3]));
    const int Nktlo = N.qt0 >= 4 ? N.qt0 - 4 : 0, Nnt = N.qt1 - Nktlo + 1;
    const bool ext = (DRY == 0) && has_next && nt >= 2 && N.dil == D.dil;
    const int nx = ext ? (Nnt < 2 ? Nnt : 2) : 0;
    for (int j = 0; j < nt; ++j) {
        const int e = nt - 1 - j + nx, kt = ktlo + j; lds_ptr slot = ring + ((j + par) & 1) * 8192;
        const bool act0 = (kt <= D.qt0), act1 = (kt >= D.qt1 - 4);
        if (DRY == 3) { if (e >= 3) ATT_WAITV(28); else if (e == 2) ATT_WAITV(20); else if (e == 1) ATT_WAITV(12); else ATT_WAITV(4); }
        else if (DRY != 2) { if (e >= 1) ATT_WAITV(12); else ATT_WAITV(4); }
        bf16x8 kf[4];
        if (DRY != 1 && DRY != 3) {
#pragma unroll
        for (int ks = 0; ks < 4; ++ks) kf[ks] = *(const __attribute__((address_space(3))) bf16x8*)(slot + krow + (((2 * ks + hi) ^ ksw) * 16));
        asm volatile("s_waitcnt lgkmcnt(0)" ::: "memory");
        asm volatile("" : "+v"(kf[0]), "+v"(kf[1]), "+v"(kf[2]), "+v"(kf[3]));
        }
        if (DRY == 3) { if (e >= 4) ATT_DMA_K(D, L, ktlo, j + 4, j + par); }
        else if (DRY != 2 && e >= 2) { if (j + 2 < nt) ATT_DMA_K(D, L, ktlo, j + 2, j + par); else ATT_DMA_K(N, L, Nktlo, j + 2 - nt, j + par); }
        u32x4 pa0 = {}, pa1 = {}, pb0 = {}, pb1 = {};
#define ATT_SCORE(S, QT, ACT, LS, PW0, PW1) if (ACT) { f32x16 p = {}; \
            _Pragma("unroll") for (int ks = 0; ks < 4; ++ks) p = __builtin_amdgcn_mfma_f32_32x32x16_bf16(kf[ks], qr[S][ks], p, 0, 0, 0); \
            const bool first = (kt == (QT) - 4), last = (kt == (QT)); \
            if (first || last) { _Pragma("unroll") for (int rr = 0; rr < 16; ++rr) { const int kk = crow(rr, hi); const bool bad = (first && kk < q + DMIN) || (last && kk > q); if (bad) p[rr] = -INFINITY; } } \
            float s_ = 0.f; \
            _Pragma("unroll") for (int rr = 0; rr < 16; ++rr) { p[rr] = __builtin_amdgcn_exp2f(p[rr]); s_ += p[rr]; } \
            LS += s_; \
            PW0[0] = cvtpk_s(p[0], p[1]); PW0[1] = cvtpk_s(p[2], p[3]); PW0[2] = cvtpk_s(p[4], p[5]); PW0[3] = cvtpk_s(p[6], p[7]); \
            PW1[0] = cvtpk_s(p[8], p[9]); PW1[1] = cvtpk_s(p[10], p[11]); PW1[2] = cvtpk_s(p[12], p[13]); PW1[3] = cvtpk_s(p[14], p[15]); }
        if (DRY != 1 && DRY != 3) {
        ATT_SCORE(0, D.qt0, act0, ls0, pa0, pa1)
        ATT_SCORE(1, D.qt1, act1, ls1, pb0, pb1)
        }
#undef ATT_SCORE
        if (DRY == 3) { if (e >= 4) ATT_WAITV(28); else if (e == 3) ATT_WAITV(24); else if (e == 2) ATT_WAITV(16); else if (e == 1) ATT_WAITV(8); else ATT_WAITV(0); }
        else if (DRY != 2) { if (e >= 2) ATT_WAITV(12); else if (e == 1) ATT_WAITV(8); else ATT_WAITV(0); }
        if (DRY != 1 && DRY != 3) {
        lds_ptr vp = slot + 4096 + vb;
        s16x4 lo[4], hh[4];
#pragma unroll
        for (int i = 0; i < 4; ++i) { const int o_ = (i & 1) * 2048 + (((i >> 1) ^ vsw) * 64); lo[i] = vtr(vp + o_); hh[i] = vtr(vp + o_ + 1024); }
#define ATT_VFR(i) (bf16x8){lo[i][0], lo[i][1], lo[i][2], lo[i][3], hh[i][0], hh[i][1], hh[i][2], hh[i][3]}
        if (act0) {
            o00 = __builtin_amdgcn_mfma_f32_32x32x16_bf16(__builtin_bit_cast(bf16x8, pa0), ATT_VFR(0), o00, 0, 0, 0);
            o00 = __builtin_amdgcn_mfma_f32_32x32x16_bf16(__builtin_bit_cast(bf16x8, pa1), ATT_VFR(1), o00, 0, 0, 0);
            o01 = __builtin_amdgcn_mfma_f32_32x32x16_bf16(__builtin_bit_cast(bf16x8, pa0), ATT_VFR(2), o01, 0, 0, 0);
            o01 = __builtin_amdgcn_mfma_f32_32x32x16_bf16(__builtin_bit_cast(bf16x8, pa1), ATT_VFR(3), o01, 0, 0, 0);
        }
        if (act1) {
            o10 = __builtin_amdgcn_mfma_f32_32x32x16_bf16(__builtin_bit_cast(bf16x8, pb0), ATT_VFR(0), o10, 0, 0, 0);
            o10 = __builtin_amdgcn_mfma_f32_32x32x16_bf16(__builtin_bit_cast(bf16x8, pb1), ATT_VFR(1), o10, 0, 0, 0);
            o11 = __builtin_amdgcn_mfma_f32_32x32x16_bf16(__builtin_bit_cast(bf16x8, pb0), ATT_VFR(2), o11, 0, 0, 0);
            o11 = __builtin_amdgcn_mfma_f32_32x32x16_bf16(__builtin_bit_cast(bf16x8, pb1), ATT_VFR(3), o11, 0, 0, 0);
        }
#undef ATT_VFR
        }
        asm volatile("s_waitcnt lgkmcnt(0)" ::: "memory");
        if (DRY == 3) { if (e >= 4) ATT_DMA_V(D, L, ktlo, j + 4, j + par); }
        else if (DRY != 2 && e >= 2) { if (j + 2 < nt) ATT_DMA_V(D, L, ktlo, j + 2, j + par); else ATT_DMA_V(N, L, Nktlo, j + 2 - nt, j + par); }
    }
    int lane_s = lane; asm volatile("" : "+v"(lane_s));
    {
    const int lane = lane_s, q = lane & 31, hi = lane >> 5;
    __attribute__((address_space(3))) unsigned short* st = (__attribute__((address_space(3))) unsigned short*)stage;
    u32x4 g0[4], a0[4], b0[4]; float la0[4], lb0[4];
#define ATT_EPI_T(QT, pp) ((size_t)(D.r + D.dil * (32 * (QT) + 16 * ((pp) >> 1) + 8 * ((pp) & 1) + (lane >> 3))))
#define ATT_EPI_LOAD(QT, G, A, B, LA, LB, GATE) do { _Pragma("unroll") for (int pp = 0; pp < 4; ++pp) { const size_t t = ATT_EPI_T(QT, pp); const int ch = lane & 7; \
        G[pp] = *(const u32x4*)((GATE) + t * 512 + ch * 8); \
        if (MODE == 2) { A[pp] = __builtin_nontemporal_load((const u32x4*)(D.po_a + t * 64 + ch * 8)); B[pp] = __builtin_nontemporal_load((const u32x4*)(D.po_b + t * 64 + ch * 8)); \
                         LA[pp] = __builtin_nontemporal_load(D.pl_a + t); LB[pp] = __builtin_nontemporal_load(D.pl_b + t); } } } while (0)
#define ATT_EPI_TOUCH(G, A, B, LA, LB) do { asm volatile("" : "+v"(G[0]), "+v"(G[1]), "+v"(G[2]), "+v"(G[3])); \
        if (MODE == 2) { asm volatile("" : "+v"(A[0]), "+v"(A[1]), "+v"(A[2]), "+v"(A[3]), "+v"(B[0]), "+v"(B[1]), "+v"(B[2]), "+v"(B[3])); \
                         asm volatile("" : "+v"(LA[0]), "+v"(LA[1]), "+v"(LA[2]), "+v"(LA[3]), "+v"(LB[0]), "+v"(LB[1]), "+v"(LB[2]), "+v"(LB[3])); } } while (0)
#define ATT_EPI_PROC(QT, OA, OB, LS, G, A, B, LA, LB, MIX, SINK) do { \
        { auto sw_ = __builtin_amdgcn_permlane32_swap(__float_as_uint(LS), __float_as_uint(LS), false, false); LS = __uint_as_float(sw_[0]) + __uint_as_float(sw_[1]); } \
        _Pragma("unroll") for (int hf = 0; hf < 2; ++hf) { \
            _Pragma("unroll") for (int i8 = 0; i8 < 8; ++i8) { const int rl = crow(i8, hi); \
                st[rl * 64 + q] = (unsigned short)(cvtpk_s(OA[8 * hf + i8], 0.f) & 0xffffu); st[rl * 64 + 32 + q] = (unsigned short)(cvtpk_s(OB[8 * hf + i8], 0.f) & 0xffffu); } \
            _Pragma("unroll") for (int i2 = 0; i2 < 2; ++i2) { \
                const int pp = 2 * hf + i2, rl = 8 * i2 + (lane >> 3), ch = lane & 7, row = 16 * hf + rl; \
                const u32x4 ow = *(const __attribute__((address_space(3))) u32x4*)(st + rl * 64 + ch * 8); \
                float l = __shfl(LS, row); \
                const size_t t = ATT_EPI_T(QT, pp); \
                if (MODE == 1) { *(u32x4*)(D.po + t * 64 + ch * 8) = ow; if (ch == 0) D.pl[t] = l; } \
                else { \
                    float v[8]; \
                    _Pragma("unroll") for (int k = 0; k < 4; ++k) { v[2 * k] = __uint_as_float(ow[k] << 16); v[2 * k + 1] = __uint_as_float(ow[k] & 0xffff0000u); } \
                    if (MODE == 2) { \
                        l += LA[pp] + LB[pp]; \
                        _Pragma("unroll") for (int k = 0; k < 4; ++k) { v[2 * k] += __uint_as_float(A[pp][k] << 16) + __uint_as_float(B[pp][k] << 16); v[2 * k + 1] += __uint_as_float(A[pp][k] & 0xffff0000u) + __uint_as_float(B[pp][k] & 0xffff0000u); } \
                    } else l += (SINK); \
                    const float rl_ = 1.0f / l; \
                    u32x4 w; \
                    _Pragma("unroll") for (int k = 0; k < 4; ++k) { const float ga_ = __uint_as_float(G[pp][k] << 16), gb_ = __uint_as_float(G[pp][k] & 0xffff0000u); \
                        const float sa_ = ga_ * __builtin_amdgcn_rcpf(1.f + __builtin_amdgcn_exp2f(-1.4426950408889634f * ga_)), sb_ = gb_ * __builtin_amdgcn_rcpf(1.f + __builtin_amdgcn_exp2f(-1.4426950408889634f * gb_)); \
                        w[k] = cvtpk_s(v[2 * k] * rl_ * sa_, v[2 * k + 1] * rl_ * sb_); } \
                    *(u32x4*)((MIX) + t * 1024 + ch * 8) = w; \
                } \
            } \
        } } while (0)
    if (DRY != 0) {
        asm volatile("" :: "v"(o00), "v"(o01), "v"(o10), "v"(o11), "v"(ls0), "v"(ls1));
        if (has_next) prefetch<DRY>(N, ring0, qx, lane, 0);
    } else if (MODE == 1) {
        if (has_next) { if (!ext) prefetch(N, ring0, qx, lane, 0); else { const unsigned short* q0_ = N.Q0 + (size_t)(N.r + N.dil * (32 * N.qt0 + q)) * 64 + hi * 8; const unsigned short* q1_ = N.Q1 + (size_t)(N.r + N.dil * (32 * N.qt1 + q)) * 64 + hi * 8;
            _Pragma("unroll") for (int d0 = 0; d0 < 4; ++d0) { qx[0][d0] = *(const bf16x8*)(q0_ + d0 * 16); qx[1][d0] = *(const bf16x8*)(q1_ + d0 * 16); } } }
        ATT_EPI_PROC(D.qt0, o00, o01, ls0, g0, a0, b0, la0, lb0, D.mix0, D.sink0);
        ATT_EPI_PROC(D.qt1, o10, o11, ls1, g0, a0, b0, la0, lb0, D.mix1, D.sink1);
    } else {
        ATT_EPI_LOAD(D.qt0, g0, a0, b0, la0, lb0, D.gate0);
        __builtin_amdgcn_sched_barrier(0);
        ATT_EPI_TOUCH(g0, a0, b0, la0, lb0);
        __builtin_amdgcn_sched_barrier(0);
        ATT_EPI_PROC(D.qt0, o00, o01, ls0, g0, a0, b0, la0, lb0, D.mix0, D.sink0);
        __builtin_amdgcn_sched_barrier(0);
        ATT_EPI_LOAD(D.qt1, g0, a0, b0, la0, lb0, D.gate1);
        __builtin_amdgcn_sched_barrier(0);
        if (has_next) { if (!ext) prefetch(N, ring0, qx, lane, 0); else { const unsigned short* q0_ = N.Q0 + (size_t)(N.r + N.dil * (32 * N.qt0 + q)) * 64 + hi * 8; const unsigned short* q1_ = N.Q1 + (size_t)(N.r + N.dil * (32 * N.qt1 + q)) * 64 + hi * 8;
            _Pragma("unroll") for (int d0 = 0; d0 < 4; ++d0) { qx[0][d0] = *(const bf16x8*)(q0_ + d0 * 16); qx[1][d0] = *(const bf16x8*)(q1_ + d0 * 16); } } }
        __builtin_amdgcn_sched_barrier(0);
        ATT_EPI_TOUCH(g0, a0, b0, la0, lb0);
        __builtin_amdgcn_sched_barrier(0);
        ATT_EPI_PROC(D.qt1, o10, o11, ls1, g0, a0, b0, la0, lb0, D.mix1, D.sink1);
    }
#undef ATT_EPI_T
#undef ATT_EPI_LOAD
#undef ATT_EPI_TOUCH
#undef ATT_EPI_PROC
    }
    par = ext ? ((par + nt) & 1) : 0;
}
#undef ATT_DMA_K
#undef ATT_DMA_V
#undef ATT_WAITV
#undef ATT_GLDS
}
#ifndef PG8_SP2
#define PG8_SP2 true
#endif
#ifndef PG8_ALIGN
#define PG8_ALIGN true
#endif
constexpr int NWAVES = 8;
constexpr int BATCH = 8, SEQ = 4096, DM = 1024, M = BATCH * SEQ, NIN = 3328, HD = 64;
constexpr float LOG2E = 1.4426950408889634f;
constexpr size_t MiB = 1u << 20;
constexpr size_t WS_CTL = 0, CTL_ZERO_BYTES = 64 * 1024;
constexpr size_t WS_COS = 1 * MiB, WS_SIN = WS_COS + 512 * 1024;
constexpr size_t WS_WIT = 2 * MiB, WS_WOT = 9 * MiB;
constexpr size_t WS_XN = 16 * MiB, WS_RS = 12 * MiB;
constexpr size_t WS_QA = 80 * MiB, WS_QB = 112 * MiB, WS_KA = 144 * MiB, WS_VA = 152 * MiB, WS_KB = 160 * MiB, WS_VB = 192 * MiB;
constexpr size_t WS_GA = 224 * MiB, WS_GB = 256 * MiB, WS_MIX = 288 * MiB, WS_PO16 = 352 * MiB, WS_PO4 = 384 * MiB, WS_PL16 = 416 * MiB, WS_PL4 = 417 * MiB, WS_END = 418 * MiB;
constexpr int CW_BAR = 1024;
constexpr int RING_OFF = 0, RING_BYTES = 131072;
constexpr int LDSCTL_OFF = RING_BYTES + 16384, MISC_OFF = LDSCTL_OFF + 320;
constexpr int LDS_BYTES = 149504;
static_assert(MISC_OFF + 128 <= LDS_BYTES, "LDS map");
#define GAS __attribute__((address_space(1)))
#define LAS __attribute__((address_space(3)))
typedef unsigned short bf16;
typedef unsigned v4u __attribute__((ext_vector_type(4)));
typedef float f32x4 __attribute__((ext_vector_type(4)));
typedef short bf16x8 __attribute__((ext_vector_type(8)));
typedef GAS unsigned gu32;
typedef GAS unsigned long long gu64;
#define RLX_AGENT __ATOMIC_RELAXED, __HIP_MEMORY_SCOPE_AGENT
#define LDS_WAIT() asm volatile("s_waitcnt lgkmcnt(0)" ::: "memory")
#define VM_WAIT() asm volatile("s_waitcnt vmcnt(0)" ::: "memory")
__device__ __forceinline__ unsigned long long rt() { return __builtin_amdgcn_s_memrealtime(); }
__device__ __forceinline__ unsigned f2bf(float f) { unsigned u = __builtin_bit_cast(unsigned, f); return (u + 0x7fffu + ((u >> 16) & 1u)) >> 16; }
__device__ __forceinline__ unsigned pk2(float lo, float hi) { return f2bf(lo) | (f2bf(hi) << 16); }
__device__ __forceinline__ unsigned pkh2(float lo, float hi) { const pg8::f16x2 h = {(_Float16)lo, (_Float16)hi}; return __builtin_bit_cast(unsigned, h); }

#define XB_TMO      128
#define XB_XCNT(j)  (256  + 64 * (j))
#define XB_XSUB(j)  (1280 + 64 * (j))
#define XB_XGEN(j)  (2304 + 64 * (j))
#define XB_TOP      3328
#define XB_TOPGEN   3392
#define XCD_BAR_WORDS 3456
#define XB_SPIN_CAP (1u << 18)

__device__ __forceinline__ unsigned xb_ld(unsigned* p)              { return __hip_atomic_load(p, __ATOMIC_RELAXED, __HIP_MEMORY_SCOPE_AGENT); }
__device__ __forceinline__ unsigned xb_add(unsigned* p, unsigned v) { return __hip_atomic_fetch_add(p, v, __ATOMIC_RELAXED, __HIP_MEMORY_SCOPE_AGENT); }
__device__ __forceinline__ unsigned xb_xcc_id() { return (unsigned)__builtin_amdgcn_s_getreg((3 << 11) | 20) & 0xFu; }
#define XB_SPIN(cond, bar) do { unsigned _sp = 0; while (cond) { __builtin_amdgcn_s_sleep(1); \
    if ((++_sp & 255u) == 0u) { if (xb_ld(&(bar)[XB_TMO])) break; if (_sp > XB_SPIN_CAP) { atomicAdd(&(bar)[XB_TMO], 1u); break; } } } } while (0)

struct XcdBarrier {
    unsigned* bar; unsigned x;
    volatile LAS unsigned* st;
};

__device__ __forceinline__ XcdBarrier xcd_barrier_post(unsigned* bar, volatile LAS unsigned* st) {
    XcdBarrier b; b.bar = bar; b.x = xb_xcc_id(); b.st = st;
    if (threadIdx.x == 0) (void)xb_add(&bar[XB_XCNT(b.x)], 1u);
    return b;
}
__device__ __forceinline__ void xcd_barrier_complete(unsigned* bar, unsigned x, unsigned& nloc, unsigned& nx) {
    const unsigned G = gridDim.x * gridDim.y * gridDim.z;
    unsigned sum, cnt, mine, sp = 0u;
    for (;;) {
        sum = 0u; cnt = 0u; mine = 0u;
#pragma unroll
        for (unsigned j = 0; j < 16; ++j) { const unsigned c = xb_ld(&bar[XB_XCNT(j)]); sum += c; cnt += (c > 0u) ? 1u : 0u; mine = (j == x) ? c : mine; }
        if (sum == G) break;
        __builtin_amdgcn_s_sleep(1);
        if ((++sp & 255u) == 0u) { if (xb_ld(&bar[XB_TMO])) break; if (sp > XB_SPIN_CAP) { atomicAdd(&bar[XB_TMO], 1u); break; } }
    }
    nloc = mine > 0u ? mine : 1u; nx = cnt > 0u ? cnt : 1u;
}

__device__ __forceinline__ void xcd_barrier(const XcdBarrier& b) {
    asm volatile("s_waitcnt vmcnt(0)" ::: "memory");
    __syncthreads();
    if (threadIdx.x == 0) {
        unsigned* bar = b.bar;
        __builtin_amdgcn_s_waitcnt(0);
        unsigned nloc = b.st[0], nx = b.st[1];
        if (nloc == 0u) { xcd_barrier_complete(bar, b.x, nloc, nx); b.st[0] = nloc; b.st[1] = nx; }
        const unsigned old = xb_add(&bar[XB_XSUB(b.x)], 1u);
        const unsigned gen = old / nloc;
        if (old + 1u == (gen + 1u) * nloc) {
            __builtin_amdgcn_fence(__ATOMIC_RELEASE, "agent");
            asm volatile("s_waitcnt vmcnt(0)" ::: "memory");
            const unsigned og = xb_add(&bar[XB_TOP], 1u);
            const unsigned tg = og / nx;
            if (og + 1u == (tg + 1u) * nx) xb_add(&bar[XB_TOPGEN], 1u);
            else XB_SPIN(xb_ld(&bar[XB_TOPGEN]) == tg, bar);
            __builtin_amdgcn_fence(__ATOMIC_ACQUIRE, "agent");
            xb_add(&bar[XB_XGEN(b.x)], 1u);
            asm volatile("s_waitcnt vmcnt(0)" ::: "memory");
        } else {
            XB_SPIN(xb_ld(&bar[XB_XGEN(b.x)]) == gen, bar);
            __builtin_amdgcn_fence(__ATOMIC_ACQUIRE, "agent");
            asm volatile("s_waitcnt vmcnt(0)" ::: "memory");
        }
    }
    __syncthreads();
}
static_assert((CW_BAR + XCD_BAR_WORDS) * 4 <= (int)CTL_ZERO_BYTES, "barrier words inside the memset region");

struct Frame {
    LAS unsigned char* lds;
    volatile LAS unsigned* MISC;
    gu32* ctl;
    int tid, lane, wave;
    int vcu, G;
};
__device__ __forceinline__ float bf2f(bf16 b) { return __uint_as_float(((unsigned)b) << 16); }
__device__ __forceinline__ float wave_sum(float v) {
#pragma unroll
    for (int o = 1; o < 64; o <<= 1) v += __shfl_xor(v, o);
    return v;
}
__device__ __forceinline__ void sincos_d(float ang, float& s, float& c) {
    const double a = (double)ang;
    const double k = rint(a * 0.6366197723675814);
    double y = fma(-k, 1.5707963267948966, a);
    y = fma(-k, 6.123233995736766e-17, y);
    const double y2 = y * y;
    const double sp = y * (1.0 + y2 * (-1.0 / 6 + y2 * (1.0 / 120 + y2 * (-1.0 / 5040 + y2 * (1.0 / 362880 + y2 * (-1.0 / 39916800 + y2 * (1.0 / 6227020800.0)))))));
    const double cp = 1.0 + y2 * (-0.5 + y2 * (1.0 / 24 + y2 * (-1.0 / 720 + y2 * (1.0 / 40320 + y2 * (-1.0 / 3628800 + y2 * (1.0 / 479001600.0 + y2 * (-1.0 / 87178291200.0)))))));
    const int q = ((int)(long long)k) & 3;
    const double ss = (q == 0) ? sp : (q == 1) ? cp : (q == 2) ? -sp : -cp;
    const double cc = (q == 0) ? cp : (q == 1) ? -sp : (q == 2) ? -cp : sp;
    s = (float)ss; c = (float)cc;
}
__device__ __forceinline__ void p0_transpose_item(const float* W, int K, int N, bf16* WT, int k0, int n0, int d0, LAS float* scr, int lane, const float* G) {
#pragma unroll 8
    for (int i = 0; i < 32; ++i) { const int kk = 2 * i + (lane >> 5); scr[kk * 33 + (lane & 31)] = __builtin_nontemporal_load(W + (size_t)(k0 + kk) * N + n0 + (lane & 31)); }
    LDS_WAIT(); asm volatile("" ::: "memory");
    const int c = lane & 7;
    f32x4 g0 = {1.f, 1.f, 1.f, 1.f}, g1 = g0;
    if (G) { g0 = *(const GAS f32x4*)(G + k0 + 8 * c); g1 = *(const GAS f32x4*)(G + k0 + 8 * c + 4); }
#pragma unroll
    for (int j = 0; j < 4; ++j) { const int n = (lane >> 3) + 8 * j; const LAS float* s = scr + (8 * c) * 33 + n;
        v4u o;
        if (G) { o.x = pkh2(s[0 * 33] * g0.x, s[1 * 33] * g0.y); o.y = pkh2(s[2 * 33] * g0.z, s[3 * 33] * g0.w); o.z = pkh2(s[4 * 33] * g1.x, s[5 * 33] * g1.y); o.w = pkh2(s[6 * 33] * g1.z, s[7 * 33] * g1.w); }
        else { o.x = pk2(s[0 * 33], s[1 * 33]); o.y = pk2(s[2 * 33], s[3 * 33]); o.z = pk2(s[4 * 33], s[5 * 33]); o.w = pk2(s[6 * 33], s[7 * 33]); }
        *(GAS v4u*)(WT + (size_t)(d0 + n) * K + k0 + 8 * c) = o; }
    LDS_WAIT(); asm volatile("" ::: "memory");
}
struct Ptrs {
    const float *x, *gain, *w_in, *qna, *kna, *sinks, *qnb, *knb, *w_out; float* out;
    bf16 *WIT, *WOT, *XN, *QA, *KA, *VA, *GA, *QB, *KB, *VB, *GB, *MIX, *PO16, *PO4; float *cosT, *sinT, *PL16, *PL4, *RS;
};
__device__ __forceinline__ void p0_prologue(Frame& F, const Ptrs& P) {
    LAS float* scr = (LAS float*)(F.lds + RING_OFF + F.wave * 16384);
    const int gw = F.vcu * NWAVES + F.wave, NGW = F.G * NWAVES;
    constexpr int I_IN = (DM / 64) * (NIN / 32), I_OUT = (DM / 64) * (DM / 32);
    for (int it = gw; it < I_IN + I_OUT; it += NGW) {
        if (it < I_IN) { const int nblk = NIN / 32, kb = it / nblk, nb = it % nblk, n0 = 32 * nb;
            const int pn = n0 >> 8, rem = n0 & 255, wc = rem >> 6, bjj = (rem >> 5) & 1;
            p0_transpose_item(P.w_in, DM, NIN, P.WIT, 64 * kb, n0, 256 * pn + 128 * bjj + 32 * wc, scr, F.lane, P.gain); }
        else { const int r = it - I_IN, nblk = DM / 32, kb = r / nblk, nb = r % nblk; p0_transpose_item(P.w_out, DM, DM, P.WOT, 64 * kb, 32 * nb, 32 * nb, scr, F.lane, nullptr); }
    }
    for (int e = (F.vcu * NWAVES * 64) + F.tid; e < SEQ * 32; e += F.G * NWAVES * 64) {
        const int t = e >> 5, i = e & 31;
        double r = 1.0; for (int k = 0; k < i; ++k) r *= 0.7498942093324558;
        const float inv = (float)r; const float ang = (float)t * inv;
        float s, c; sincos_d(ang, s, c); P.cosT[e] = c; P.sinT[e] = s;
    }
    for (int m = gw; m < M; m += NGW) {
        const GAS f32x4* xr = (const GAS f32x4*)(P.x + (size_t)m * DM) + F.lane;
        f32x4 v[4]; float ss = 0.f;
#pragma unroll
        for (int j = 0; j < 4; ++j) { v[j] = __builtin_nontemporal_load(xr + 64 * j); ss += (v[j].x * v[j].x + v[j].y * v[j].y) + (v[j].z * v[j].z + v[j].w * v[j].w); }
        const float ms = wave_sum(ss) * (1.f / DM) + 1e-6f, rstd = rsqrtf(ms);
        if (F.lane == 0) P.RS[m] = sqrtf(ms);
        GAS unsigned long long* o8 = (GAS unsigned long long*)(P.XN + (size_t)m * DM) + F.lane;
#pragma unroll
        for (int j = 0; j < 4; ++j)
            o8[64 * j] = (unsigned long long)pkh2(v[j].x * rstd, v[j].y * rstd) | ((unsigned long long)pkh2(v[j].z * rstd, v[j].w * rstd) << 32);
    }
}
constexpr int STAGE_OFF = RING_BYTES;
__device__ __forceinline__ att::Desc b_desc(const Ptrs& P, int uid, int mode, int wave, int k) {
    const int b = uid >> 5, h = (uid >> 2) & 7, blk = uid & 3; const size_t hb = (size_t)(b * 8 + h) * SEQ;
    att::Desc D{};
    D.Q0 = P.QB + hb * 64; D.Q1 = D.Q0; D.K = P.KB + hb * 64; D.V = P.VB + hb * 64;
    if (mode == 1) {
        if (wave < 4) { D.dil = 16; D.r = 4 * wave + k; D.qt0 = 2 * blk; D.po = P.PO16 + hb * 64; D.pl = P.PL16 + hb; }
        else { D.dil = 4; D.r = k; D.qt0 = 8 * blk + 2 * (wave - 4); D.po = P.PO4 + hb * 64; D.pl = P.PL4 + hb; }
    } else {
        D.dil = 1; D.r = 0; D.qt0 = 32 * blk + 2 * (8 * k + wave);
        D.po_a = P.PO16 + hb * 64; D.po_b = P.PO4 + hb * 64; D.pl_a = P.PL16 + hb; D.pl_b = P.PL4 + hb;
        D.gate0 = P.GB + (size_t)b * SEQ * 512 + h * 64; D.gate1 = D.gate0; D.mix0 = P.MIX + (size_t)b * SEQ * DM + 512 + h * 64; D.mix1 = D.mix0;
    }
    D.qt1 = D.qt0 + 1;
    return D;
}
__device__ __forceinline__ att::Desc a_desc(const Ptrs& P, int b, int hp, int qt) {
    const int kv = hp >> 1, h0 = 2 * hp;
    att::Desc D{};
    D.Q0 = P.QA + (size_t)(b * 8 + h0) * SEQ * 64; D.Q1 = D.Q0 + (size_t)SEQ * 64;
    D.K = P.KA + (size_t)(b * 2 + kv) * SEQ * 64; D.V = P.VA + (size_t)(b * 2 + kv) * SEQ * 64;
    D.dil = 1; D.r = 0; D.qt0 = qt; D.qt1 = qt;
    D.gate0 = P.GA + (size_t)b * SEQ * 512 + h0 * 64; D.gate1 = D.gate0 + 64; D.mix0 = P.MIX + (size_t)b * SEQ * DM + h0 * 64; D.mix1 = D.mix0 + 64;
    D.sink0 = __builtin_amdgcn_exp2f(P.sinks[h0] * LOG2E); D.sink1 = __builtin_amdgcn_exp2f(P.sinks[h0 + 1] * LOG2E);
    return D;
}
#ifndef REP_2A
#define REP_2A 1
#define REP_2B 1
#define REP_2C 1
#endif
__device__ __forceinline__ void p2_attention(Frame& F, const Ptrs& P, const XcdBarrier& bar) {
    att::lds_ptr ring = (att::lds_ptr)(F.lds + RING_OFF + F.wave * 16384), stage = (att::lds_ptr)(F.lds + STAGE_OFF + F.wave * 2048);
    int lane_ = F.lane; asm volatile("" : "+v"(lane_));
    const int lane = lane_, wave = F.wave, uid = F.vcu;
    const unsigned ring0 = (unsigned)(uintptr_t)ring;
    att::bf16x8 qr[2][4];
    att::Desc D, N; int par = 0;
#ifdef DRY_PASS
    D = b_desc(P, uid, 1, wave, 0);
    att::prefetch<DRY_PASS>(D, ring0, qr, lane);
    for (int k = 0; k < 4; ++k) {
        N = b_desc(P, uid, 1, wave, (k + 1) & 3);
        att::attn_item<1, DRY_PASS>(ring, stage, D, k < 3, N, qr, par, lane); D = N;
    }
    asm volatile("s_waitcnt vmcnt(0) lgkmcnt(0)" ::: "memory");
#endif
#pragma unroll
    for (int rep = 0; rep < REP_2A; ++rep) {
    D = b_desc(P, uid, 1, wave, 0);
    par = 0; att::prefetch(D, ring0, qr, lane, 0);
    for (int k = 0; k < 4; ++k) {
        N = b_desc(P, uid, 1, wave, (k + 1) & 3);
        att::attn_item<1>(ring, stage, D, k < 3, N, qr, par, lane); D = N;
    }
    }
    asm volatile("s_waitcnt vmcnt(0) lgkmcnt(0)\n\ts_barrier" ::: "memory");
#pragma unroll
    for (int rep = 0; rep < REP_2B; ++rep) {
    D = b_desc(P, uid, 2, wave, 0);
    par = 0; att::prefetch(D, ring0, qr, lane, 0);
    for (int k = 0; k < 2; ++k) {
        N = b_desc(P, uid, 2, wave, 1);
        att::attn_item<2>(ring, stage, D, k < 1, N, qr, par, lane); D = N;
    }
    }
#pragma unroll
    for (int rep = 0; rep < REP_2C; ++rep) {
    {
        const int aid0 = uid * 16 + wave;
        D = a_desc(P, aid0 >> 9, (aid0 >> 7) & 3, aid0 & 127);
        par = 0; att::prefetch(D, ring0, qr, lane, 0);
        for (int k = 0; k < 2; ++k) {
            N = a_desc(P, aid0 >> 9, (aid0 >> 7) & 3, (aid0 & 127) + 8);
            att::attn_item<0>(ring, stage, D, k < 1, N, qr, par, lane); D = N;
        }
    }
    }
}

struct Args { const float* in[9]; float* out; unsigned char* ws; };
__global__ void __launch_bounds__(NWAVES * 64, 2) mega_fwd(Args args) {
    extern __shared__ __attribute__((aligned(16))) unsigned char lds[];
    Frame F;
    F.lds = (LAS unsigned char*)lds;
    F.MISC = (volatile LAS unsigned*)(F.lds + MISC_OFF);
    F.tid = threadIdx.x; F.lane = F.tid & 63; F.wave = __builtin_amdgcn_readfirstlane(F.tid >> 6);
    F.G = gridDim.x; { const int bx = blockIdx.x; F.vcu = (F.G % 8 == 0) ? (bx % 8) * (F.G / 8) + bx / 8 : bx; }
    unsigned char* ws = args.ws;
    F.ctl = (gu32*)(ws + WS_CTL);
    Ptrs P;
    P.x = args.in[0]; P.gain = args.in[1]; P.w_in = args.in[2]; P.qna = args.in[3]; P.kna = args.in[4]; P.sinks = args.in[5]; P.qnb = args.in[6]; P.knb = args.in[7]; P.w_out = args.in[8]; P.out = args.out;
    P.WIT = (bf16*)(ws + WS_WIT); P.WOT = (bf16*)(ws + WS_WOT); P.XN = (bf16*)(ws + WS_XN);
    P.QA = (bf16*)(ws + WS_QA); P.KA = (bf16*)(ws + WS_KA); P.VA = (bf16*)(ws + WS_VA); P.GA = (bf16*)(ws + WS_GA);
    P.QB = (bf16*)(ws + WS_QB); P.KB = (bf16*)(ws + WS_KB); P.VB = (bf16*)(ws + WS_VB); P.GB = (bf16*)(ws + WS_GB); P.MIX = (bf16*)(ws + WS_MIX);
    P.cosT = (float*)(ws + WS_COS); P.sinT = (float*)(ws + WS_SIN); P.RS = (float*)(ws + WS_RS);
    P.PO16 = (bf16*)(ws + WS_PO16); P.PO4 = (bf16*)(ws + WS_PO4); P.PL16 = (float*)(ws + WS_PL16); P.PL4 = (float*)(ws + WS_PL4);
    for (int u = F.tid; u < (LDS_BYTES - LDSCTL_OFF) / 4; u += NWAVES * 64) ((LAS unsigned*)(F.lds + LDSCTL_OFF))[u] = 0u;
    __syncthreads();
    XcdBarrier bar = xcd_barrier_post((unsigned*)(F.ctl + CW_BAR), F.MISC + 8);

#ifndef PROBE_TS
#define PROBE_TS 0
#endif
    unsigned long long ts0 = 0, ts1 = 0, ts2 = 0, ts3 = 0, ts4 = 0;
    if (PROBE_TS) ts0 = rt();
#ifndef REP_P0
#define REP_P0 1
#define REP_P1 1
#define REP_P2 1
#define REP_P3 1
#endif
#pragma unroll
    for (int rep = 0; rep < REP_P0; ++rep) {
    p0_prologue(F, P);
    xcd_barrier(bar);
    }
    if (PROBE_TS) ts1 = rt();
#pragma unroll
    for (int rep = 0; rep < REP_P1; ++rep) {
#ifdef STAGGER_US
        if ((int)blockIdx.x >= F.G / 2) { const unsigned long long t0_ = rt(); while (rt() - t0_ < (unsigned long long)(STAGGER_US * 100)) __builtin_amdgcn_s_sleep(8); }
#endif
        pg8::Gemm g{P.XN, P.WIT, M, NIN, DM}; pg8::StaticOrder S; S.init(M, NIN, F.G, (int)blockIdx.x);
        pg8::EpiIn E{P.QA, P.KA, P.VA, P.GA, P.QB, P.KB, P.VB, P.GB, P.qna, P.kna, P.qnb, P.knb, P.cosT, P.sinT};
        pg8::gemm_phase<pg8::EpiIn, pg8::StaticOrder, PG8_ALIGN, PG8_SP2>(F.lds + RING_OFF, g, S, E);
    xcd_barrier(bar);
    }
    if (PROBE_TS) ts2 = rt();
#ifdef DRY_GEMM
    {
        pg8::Gemm g{P.XN, P.WIT, M, NIN, DM};
#if DRY_GEMM == 1
        pg8::StaticOrder S; S.init(M, NIN, F.G, (int)blockIdx.x); pg8::EpiNone E{};
        pg8::gemm_phase<pg8::EpiNone, pg8::StaticOrder, PG8_ALIGN, PG8_SP2>(F.lds + RING_OFF, g, S, E);
#elif DRY_GEMM == 3
        pg8::StaticOrder S; S.init(M, NIN, F.G, (int)blockIdx.x);
        pg8::EpiInT<true> E{P.QA, P.KA, P.VA, P.GA, P.QB, P.KB, P.VB, P.GB, P.qna, P.kna, P.qnb, P.knb, P.cosT, P.sinT};
        pg8::gemm_phase<pg8::EpiInT<true>, pg8::StaticOrder, PG8_ALIGN, PG8_SP2>(F.lds + RING_OFF, g, S, E);
#else
        pg8::SameTileOrder S; S.init(M, NIN, F.G, (int)blockIdx.x); pg8::EpiNone E{};
        pg8::gemm_phase<pg8::EpiNone, pg8::SameTileOrder, PG8_ALIGN, PG8_SP2>(F.lds + RING_OFF, g, S, E);
#endif
        xcd_barrier(bar);
    }
#endif
#pragma unroll
    for (int rep = 0; rep < REP_P2; ++rep) {
    p2_attention(F, P, bar);
    xcd_barrier(bar);
    }
    if (PROBE_TS) ts3 = rt();
#pragma unroll
    for (int rep = 0; rep < REP_P3; ++rep) {
        pg8::Gemm g{P.MIX, P.WOT, M, DM, DM}; pg8::StaticOrder S; S.init(M, DM, F.G, (int)blockIdx.x);
        pg8::EpiRes E{(const unsigned short*)P.XN, P.RS, P.out};
        pg8::gemm_phase<pg8::EpiRes, pg8::StaticOrder, PG8_ALIGN, PG8_SP2>(F.lds + RING_OFF, g, S, E);
    }
    if (PROBE_TS) {
        ts4 = rt();
        if (blockIdx.x == 0 && F.tid == 0) {
            const float dA = (PROBE_TS == 1) ? (float)(ts2 - ts1) * 0.01f : (float)(ts1 - ts0) * 0.01f;
            const float dB = (PROBE_TS == 1) ? (float)(ts3 - ts2) * 0.01f : (float)(ts4 - ts3) * 0.01f;
            asm volatile("s_waitcnt vmcnt(0)" ::: "memory");
            P.out[0] += dA; P.out[1] += dB;
        }
    }
}

extern "C" void kernel_launch(void* const* d_in, const int* in_sizes, int n_in, void* d_out, int out_size, void* d_ws, size_t ws_size, hipStream_t stream) {
    static int grid = 0;
    if (grid == 0) {
        if (n_in != 9 || out_size != M * DM || ws_size < WS_END) { fprintf(stderr, "kernel_launch: unexpected shapes (n_in %d, out %d, ws %zu); nothing launched\n", n_in, out_size, ws_size); grid = -1; return; }
        int dev = 0, cus = 0;
        if (hipGetDevice(&dev) != hipSuccess || hipDeviceGetAttribute(&cus, hipDeviceAttributeMultiprocessorCount, dev) != hipSuccess) { grid = -1; return; }
        if (hipFuncSetAttribute((const void*)mega_fwd, hipFuncAttributeMaxDynamicSharedMemorySize, LDS_BYTES) != hipSuccess) { fprintf(stderr, "kernel_launch: hipFuncSetAttribute failed\n"); grid = -1; return; }
        (void)hipGetLastError();
        grid = cus;
    }
    if (grid < 0) return;
#ifdef EXTRA_MEMSET
    (void)hipMemsetAsync((char*)d_ws + WS_CTL + 512 * 1024, 0, CTL_ZERO_BYTES, stream);
#endif
    if (hipMemsetAsync((char*)d_ws + WS_CTL, 0, CTL_ZERO_BYTES, stream) != hipSuccess) { fprintf(stderr, "kernel_launch: hipMemsetAsync failed\n"); return; }
    Args a{};
    for (int i = 0; i < 9; ++i) a.in[i] = (const float*)d_in[i];
    a.out = (float*)d_out; a.ws = (unsigned char*)d_ws;
    hipLaunchKernelGGL(mega_fwd, dim3(grid), dim3(NWAVES * 64), LDS_BYTES, stream, a);
}
```
